# Optimizing an MI355X kernel written in HIP

```python
import math, functools
import jax, jax.numpy as jnp
from jax import lax
import numpy as np

D_MODEL = 2048
BATCH = 4
SEQ = 2048
DEPTH = 1
DEC_BATCH = 128
DEC_SEQ = 4
PAST_LEN = 2048
PAGE_SIZE = 128

GDN_HEADS = 8
GDN_DK = 128
GDN_DV = 128
GDN_CONV = 4
GDN_CHUNK = 64
GDN_QK_W = GDN_HEADS * GDN_DK
GDN_V_W = GDN_HEADS * GDN_DV
DSA_HEADS = 8
DSA_KV_HEADS = 2
DSA_HEAD_DIM = 128
IDX_HEADS = 8
IDX_DIM = 64
IDX_SCALE = IDX_HEADS ** -0.5 * IDX_DIM ** -0.5
DSA_TOPK = 256
Q_BLOCK = 128
ROPE_THETA = 500000.0
ROPE_FRACTION = 4
D_FF = 5632
FFN_CONV = 3
NORM_EPS = 1e-6

kernel_name = "hybrid_gdn_dsa_convffn_decode_step"


def _in_sizes():
    return (2 * GDN_QK_W + GDN_V_W, GDN_V_W, GDN_HEADS, GDN_HEADS,
            DSA_HEADS * DSA_HEAD_DIM, DSA_KV_HEADS * DSA_HEAD_DIM, DSA_KV_HEADS * DSA_HEAD_DIM,
            IDX_HEADS * IDX_DIM, IDX_DIM, IDX_HEADS, D_MODEL, D_MODEL)


def _split_cols(y):
    cuts, acc = [], 0
    for s in _in_sizes()[:-1]:
        acc += s
        cuts.append(acc)
    return jnp.split(y, cuts, axis=-1)


def _rmsnorm(x, g):
    xf = x.astype(jnp.float32)
    y = xf * lax.rsqrt(jnp.mean(xf * xf, axis=-1, keepdims=True) + NORM_EPS)
    return (y * g.astype(jnp.float32)).astype(x.dtype)


def _l2norm(x):
    xf = x.astype(jnp.float32)
    return xf * lax.rsqrt(jnp.sum(xf * xf, axis=-1, keepdims=True) + NORM_EPS)


def _partial_rotary(x, pos):
    d = x.shape[-1]
    rot = d // ROPE_FRACTION
    half = rot // 2
    inv_freq = ROPE_THETA ** (-jnp.arange(half, dtype=jnp.float32) * (2.0 / rot))
    ang = pos.astype(jnp.float32)[:, None] * inv_freq[None, :]
    cos = jnp.cos(ang)[:, None, :]
    sin = jnp.sin(ang)[:, None, :]
    xf = x.astype(jnp.float32)
    x1, x2 = xf[..., :half], xf[..., half:rot]
    out = jnp.concatenate([x1 * cos - x2 * sin, x2 * cos + x1 * sin, xf[..., rot:]], axis=-1)
    return out.astype(x.dtype)


def _causal_dwconv(x, buf, w):
    width = w.shape[0]
    t = x.shape[1]
    xx = jnp.concatenate([buf.astype(x.dtype), x], axis=1)
    y = xx[:, 0:t] * w[0]
    for i in range(1, width):
        y = y + xx[:, i:i + t] * w[i]
    return y, xx[:, -(width - 1):]


def _gated_delta_chunked(q, k, v, g, beta, s0):
    f32 = jnp.float32
    B, T, H, DK = q.shape
    DV = v.shape[-1]
    C = min(GDN_CHUNK, T)
    n = -(-T // C)
    pad = n * C - T

    def prep(a):
        a = a.astype(f32)
        a = jnp.pad(a, [(0, 0), (0, pad)] + [(0, 0)] * (a.ndim - 2))
        a = a.reshape((B, n, C) + a.shape[2:])
        a = jnp.moveaxis(a, 3, 2)
        return jnp.moveaxis(a, 1, 0)

    q, k, v, g, beta = prep(q), prep(k), prep(v), prep(g), prep(beta)
    gc = jnp.cumsum(g, axis=-1)
    incl = jnp.tril(jnp.ones((C, C), bool))
    strict = jnp.tril(jnp.ones((C, C), bool), -1)
    decay = jnp.exp(jnp.where(incl, gc[..., :, None] - gc[..., None, :], -jnp.inf))
    kk = jnp.einsum('nbhcd,nbhjd->nbhcj', k, k)
    a_mat = jnp.where(strict, beta[..., :, None] * kk * decay, 0.0)
    lhs = a_mat + jnp.eye(C, dtype=f32)
    rhs = jnp.concatenate([beta[..., None] * v, (beta * jnp.exp(gc))[..., None] * k], axis=-1)
    sol = lax.linalg.triangular_solve(lhs, rhs, left_side=True, lower=True, unit_diagonal=True)
    u_v, w_k = sol[..., :DV], sol[..., DV:]
    qk = jnp.einsum('nbhcd,nbhjd->nbhcj', q, k) * decay
    q_dec = q * jnp.exp(gc)[..., None]
    k_end = k * jnp.exp(gc[..., -1:] - gc)[..., None]
    g_end = jnp.exp(gc[..., -1])

    def step(S, xs):
        u_v_i, w_k_i, qk_i, q_dec_i, k_end_i, g_end_i = xs
        u = u_v_i - jnp.einsum('bhck,bhkv->bhcv', w_k_i, S)
        o = jnp.einsum('bhck,bhkv->bhcv', q_dec_i, S) + jnp.einsum('bhcj,bhjv->bhcv', qk_i, u)
        S = S * g_end_i[..., None, None] + jnp.einsum('bhck,bhcv->bhkv', k_end_i, u)
        return S, o

    s_fin, o = lax.scan(step, s0.astype(f32), (u_v, w_k, qk, q_dec, k_end, g_end))
    o = jnp.moveaxis(o, 0, 1)
    o = jnp.moveaxis(o, 2, 3).reshape(B, n * C, H, DV)[:, :T]
    return o, s_fin


def _gather_rows(x, idx):
    return jax.vmap(lambda xb, ib: xb[ib])(x, idx)


def _indexer_topk(iq, iw, ik, pos_q, pos_k, topk):
    rel = jax.nn.relu(jnp.einsum('bqhd,bkd->bqhk', iq.astype(jnp.float32), ik.astype(jnp.float32)))
    score = jnp.einsum('bqhk,bqh->bqk', rel, iw.astype(jnp.float32) * IDX_SCALE)
    causal = pos_k[None, None, :] <= pos_q[None, :, None]
    score = jnp.where(causal, score, -jnp.inf)
    _, idx = lax.top_k(score, topk)
    valid = jnp.take(pos_k, idx) <= pos_q[None, :, None]
    return idx, valid


def _attend_selected(q, k_sel, v_sel, valid):
    B, Tq, H, HD = q.shape
    KV = k_sel.shape[-2]
    qg = q.reshape(B, Tq, KV, H // KV, HD).astype(jnp.float32)
    s = jnp.einsum('bqkgd,bqjkd->bqkgj', qg, k_sel.astype(jnp.float32)) * (HD ** -0.5)
    s = jnp.where(valid[:, :, None, None, :], s, -jnp.inf)
    p = jax.nn.softmax(s, axis=-1)
    o = jnp.einsum('bqkgj,bqjkd->bqkgd', p.astype(v_sel.dtype), v_sel)
    return o.reshape(B, Tq, H * HD)


def _dsa_prompt(q, k, v, iq, ik, iw, pos):
    B, T = q.shape[:2]
    topk = min(DSA_TOPK, T // 4)

    def block(i):
        s = i * Q_BLOCK
        sl = lambda a: lax.dynamic_slice_in_dim(a, s, Q_BLOCK, axis=1)
        pos_q = lax.dynamic_slice_in_dim(pos, s, Q_BLOCK)
        idx, valid = _indexer_topk(sl(iq), sl(iw), ik, pos_q, pos, topk)
        return _attend_selected(sl(q), _gather_rows(k, idx), _gather_rows(v, idx), valid)

    o = lax.map(block, jnp.arange(T // Q_BLOCK))
    return jnp.moveaxis(o, 0, 1).reshape(B, T, -1)


def _dsa_sample(q, k, v, iq, ik, iw, pos, cache_k, cache_v, cache_idx_k, page_table):
    DB, Ts = q.shape[:2]
    page = cache_k.shape[1]
    past = page_table.shape[1] * page
    ik_past = cache_idx_k[page_table].reshape(DB, past, IDX_DIM)
    ik_all = jnp.concatenate([ik_past.astype(ik.dtype), ik], axis=1)
    L = past + Ts
    topk = min(DSA_TOPK, L // 4)
    idx, valid = _indexer_topk(iq, iw, ik_all, pos, jnp.arange(L), topk)
    in_past = (idx < past)[..., None, None]
    pidx = jnp.minimum(idx, past - 1)
    phys = jax.vmap(lambda pt, ib: pt[ib // page])(page_table, pidx)
    off = pidx % page
    nidx = jnp.clip(idx - past, 0, Ts - 1)
    k_sel = jnp.where(in_past, cache_k[phys, off].astype(k.dtype), _gather_rows(k, nidx))
    v_sel = jnp.where(in_past, cache_v[phys, off].astype(v.dtype), _gather_rows(v, nidx))
    return _attend_selected(q, k_sel, v_sel, valid)


def _layer(x, c, pos, gdn_buf, gdn_s0, ffn_buf, attend, p):
    B, T, _ = x.shape
    ada = jnp.dot(jax.nn.silu(c), p["w_ada"]) + p["b_ada"]
    sh1, sc1, gt1, sh2, sc2, gt2 = jnp.split(ada[:, None, :], 6, axis=-1)
    h = _rmsnorm(x, p["g_norm1"]) * (1.0 + sc1) + sh1
    (qkv_raw, z, a_raw, b_raw, dq, dk, dv, iq, ik, iw, gate_gdn, gate_dsa) = _split_cols(jnp.dot(h, p["w_in"]))

    qkv, gdn_buf_new = _causal_dwconv(qkv_raw, gdn_buf, p["w_gdn_conv"])
    qkv = jax.nn.silu(qkv)
    gq, gk, gv = jnp.split(qkv, [GDN_QK_W, 2 * GDN_QK_W], axis=-1)
    gq = _l2norm(gq.reshape(B, T, GDN_HEADS, GDN_DK)) * (GDN_DK ** -0.5)
    gk = _l2norm(gk.reshape(B, T, GDN_HEADS, GDN_DK))
    gv = gv.reshape(B, T, GDN_HEADS, GDN_DV)
    log_alpha = -jnp.exp(p["a_log"].astype(jnp.float32)) * jax.nn.softplus(
        a_raw.astype(jnp.float32) + p["dt_bias"].astype(jnp.float32))
    beta = jax.nn.sigmoid(b_raw.astype(jnp.float32))
    o_gdn, s_new = _gated_delta_chunked(gq, gk, gv, log_alpha, beta, gdn_s0)
    o_gdn = _rmsnorm(o_gdn.astype(x.dtype), p["g_gdn_norm"]) * jax.nn.silu(z.reshape(B, T, GDN_HEADS, GDN_DV))
    o_gdn = o_gdn.reshape(B, T, GDN_V_W)

    dq = _partial_rotary(dq.reshape(B, T, DSA_HEADS, DSA_HEAD_DIM), pos)
    dk = _partial_rotary(dk.reshape(B, T, DSA_KV_HEADS, DSA_HEAD_DIM), pos)
    dv = dv.reshape(B, T, DSA_KV_HEADS, DSA_HEAD_DIM)
    iq = _partial_rotary(iq.reshape(B, T, IDX_HEADS, IDX_DIM), pos)
    ik = _partial_rotary(ik[:, :, None, :], pos)[:, :, 0, :]
    o_dsa = attend(dq, dk, dv, iq, ik, iw, pos)

    mix = (jax.nn.sigmoid(gate_gdn) * jnp.dot(o_gdn, p["w_gdn_out"])
           + jax.nn.sigmoid(gate_dsa) * jnp.dot(o_dsa, p["w_dsa_out"]))
    x = x + gt1 * jnp.dot(mix, p["w_o"])

    h2 = _rmsnorm(x, p["g_norm2"]) * (1.0 + sc2) + sh2
    u, ffn_buf_new = _causal_dwconv(jnp.dot(h2, p["w_up"]), ffn_buf, p["w_ffn_conv"])
    u_gate, u_val = jnp.split(u + p["b_ffn_conv"], 2, axis=-1)
    x = x + gt2 * jnp.dot(jax.nn.silu(u_gate) * u_val, p["w_down"])
    return x, (dk, dv, ik, s_new.astype(gdn_s0.dtype), gdn_buf_new, ffn_buf_new)


def setup_inputs(seed: int = 0) -> dict:
    key = jax.random.key(seed)
    ks = jax.random.split(key, 40)
    f32 = jnp.float32
    n_pages = PAST_LEN // PAGE_SIZE
    n_used = DEC_BATCH * n_pages
    n_pool = n_used + n_used // 4
    in_cols = sum(_in_sizes())
    conv_w = 2 * GDN_QK_W + GDN_V_W
    L = DEPTH

    def nrm(k, shape, scale):
        return jax.random.normal(k, shape, f32) * scale

    page_table = jax.random.permutation(ks[0], n_pool)[:n_used].reshape(DEC_BATCH, n_pages).astype(jnp.int32)
    dt = jnp.exp(jax.random.uniform(ks[1], (L, GDN_HEADS), f32, math.log(1e-3), math.log(1e-1)))
    dt_bias = dt + jnp.log(-jnp.expm1(-dt))
    a_log = jnp.log(jax.random.uniform(ks[2], (L, GDN_HEADS), f32, 1.0, 16.0))
    return {
        "x_prompt": nrm(ks[3], (BATCH, SEQ, D_MODEL), 1.0),
        "x_sample": nrm(ks[4], (DEC_BATCH, DEC_SEQ, D_MODEL), 1.0),
        "c_prompt": nrm(ks[5], (BATCH, D_MODEL), 1.0),
        "c_sample": nrm(ks[6], (DEC_BATCH, D_MODEL), 1.0),
        "cache_k": nrm(ks[7], (L, n_pool, PAGE_SIZE, DSA_KV_HEADS, DSA_HEAD_DIM), 1.0),
        "cache_v": nrm(ks[8], (L, n_pool, PAGE_SIZE, DSA_KV_HEADS, DSA_HEAD_DIM), 1.0),
        "cache_idx_k": nrm(ks[9], (L, n_pool, PAGE_SIZE, IDX_DIM), 1.0),
        "page_table": page_table,
        "state_gdn": nrm(ks[10], (L, DEC_BATCH, GDN_HEADS, GDN_DK, GDN_DV), 0.1),
        "state_gdn_conv": nrm(ks[11], (L, DEC_BATCH, GDN_CONV - 1, conv_w), 1.0),
        "state_ffn_conv": nrm(ks[12], (L, DEC_BATCH, FFN_CONV - 1, 2 * D_FF), 1.0),
        "w_ada": nrm(ks[13], (L, D_MODEL, 6 * D_MODEL), 0.5 * D_MODEL ** -0.5),
        "b_ada": nrm(ks[14], (L, 6 * D_MODEL), 0.02),
        "g_norm1": 1.0 + nrm(ks[15], (L, D_MODEL), 0.02),
        "w_in": nrm(ks[16], (L, D_MODEL, in_cols), D_MODEL ** -0.5),
        "w_gdn_conv": nrm(ks[17], (L, GDN_CONV, conv_w), GDN_CONV ** -0.5),
        "a_log": a_log,
        "dt_bias": dt_bias,
        "g_gdn_norm": 1.0 + nrm(ks[18], (L, GDN_DV), 0.02),
        "w_gdn_out": nrm(ks[19], (L, GDN_V_W, D_MODEL), GDN_V_W ** -0.5),
        "w_dsa_out": nrm(ks[20], (L, DSA_HEADS * DSA_HEAD_DIM, D_MODEL), (DSA_HEADS * DSA_HEAD_DIM) ** -0.5),
        "w_o": nrm(ks[21], (L, D_MODEL, D_MODEL), D_MODEL ** -0.5),
        "g_norm2": 1.0 + nrm(ks[22], (L, D_MODEL), 0.02),
        "w_up": nrm(ks[23], (L, D_MODEL, 2 * D_FF), D_MODEL ** -0.5),
        "w_ffn_conv": nrm(ks[24], (L, FFN_CONV, 2 * D_FF), FFN_CONV ** -0.5),
        "b_ffn_conv": nrm(ks[25], (L, 2 * D_FF), 0.02),
        "w_down": nrm(ks[26], (L, D_FF, D_MODEL), D_FF ** -0.5),
        "g_final": 1.0 + nrm(ks[27], (D_MODEL,), 0.02),
    }


def reference(x_prompt, x_sample, c_prompt, c_sample, cache_k, cache_v, cache_idx_k, page_table,
              state_gdn, state_gdn_conv, state_ffn_conv, w_ada, b_ada, g_norm1, w_in, w_gdn_conv,
              a_log, dt_bias, g_gdn_norm, w_gdn_out, w_dsa_out, w_o, g_norm2, w_up, w_ffn_conv,
              b_ffn_conv, w_down, g_final):
    layer_params = dict(w_ada=w_ada, b_ada=b_ada, g_norm1=g_norm1, w_in=w_in, w_gdn_conv=w_gdn_conv,
                        a_log=a_log, dt_bias=dt_bias, g_gdn_norm=g_gdn_norm, w_gdn_out=w_gdn_out,
                        w_dsa_out=w_dsa_out, w_o=w_o, g_norm2=g_norm2, w_up=w_up,
                        w_ffn_conv=w_ffn_conv, b_ffn_conv=b_ffn_conv, w_down=w_down)
    B, T, _ = x_prompt.shape
    Ts = x_sample.shape[1]
    dtp = x_prompt.dtype
    past = page_table.shape[1] * cache_k.shape[2]
    pos_p = jnp.arange(T)
    pos_s = past + jnp.arange(Ts)
    conv_w = 2 * GDN_QK_W + GDN_V_W

    h_p, h_s = x_prompt, x_sample
    outs_p, outs_s = [], []
    for l in range(DEPTH):
        p = {name: arr[l] for name, arr in layer_params.items()}
        h_p, st_p = _layer(h_p, c_prompt, pos_p,
                           jnp.zeros((B, GDN_CONV - 1, conv_w), dtp),
                           jnp.zeros((B, GDN_HEADS, GDN_DK, GDN_DV), dtp),
                           jnp.zeros((B, FFN_CONV - 1, 2 * D_FF), dtp),
                           _dsa_prompt, p)
        attend_s = functools.partial(_dsa_sample, cache_k=cache_k[l], cache_v=cache_v[l],
                                     cache_idx_k=cache_idx_k[l], page_table=page_table)
        h_s, st_s = _layer(h_s, c_sample, pos_s, state_gdn_conv[l], state_gdn[l], state_ffn_conv[l],
                           attend_s, p)
        outs_p.append(st_p)
        outs_s.append(st_s)

    y_prompt = _rmsnorm(h_p, g_final)
    y_sample = _rmsnorm(h_s, g_final)
    stk = lambda outs, i: jnp.stack([o[i] for o in outs])
    return (y_prompt, y_sample,
            stk(outs_p, 0), stk(outs_p, 1), stk(outs_p, 2), stk(outs_p, 3), stk(outs_p, 4), stk(outs_p, 5),
            stk(outs_s, 0), stk(outs_s, 1), stk(outs_s, 2), stk(outs_s, 3), stk(outs_s, 4), stk(outs_s, 5))
```

```cpp
#include <hip/hip_runtime.h>
#include <cstdio>
#include <cstdint>
#include <cmath>
namespace pg8 {
#define PG8_LAS __attribute__((address_space(3)))
typedef unsigned short bf16_t;
typedef short bf16x8 __attribute__((ext_vector_type(8)));
typedef float f32x4 __attribute__((ext_vector_type(4)));
typedef unsigned u32x4 __attribute__((ext_vector_type(4)));
constexpr int BM = 256, BK = 64, HALF = 128, HTB = HALF * BK * 2  , STAGE_BYTES = 8 * HTB, NXCD = 8, WGM = 8;

__host__ __device__ __forceinline__ int lds_byte(int r, int c) { const int st = (r >> 4) * 2 + (c >> 5), rr = r & 15, cc = c & 31, ob = rr * 64 + cc * 2; return st * 1024 + (ob ^ (((ob >> 9) & 1) << 5)); }
__host__ __device__ __forceinline__ void stage_rc(int b, int& R, int& C) { const int st = b / 1024, sb = b % 1024, swz = sb ^ (((sb >> 9) & 1) << 5); R = (st >> 1) * 16 + swz / 64; C = (st & 1) * 32 + (swz % 64) / 2; }
__host__ __device__ __forceinline__ int perm32(int rho) { const int n = rho >> 4, i = rho & 15; return 8 * (i >> 2) + 4 * n + (i & 3); }

struct Unit { int pm, pn; };
struct Gemm { const bf16_t* A; const bf16_t* Bt; int M, N, K; };

struct StaticOrder {
    int nM, nN, nwg, G, c;
    __host__ __device__ void init(int M, int N, int G_, int c_) { nM = M / BM; nN = N / BM; nwg = nM * nN; G = G_; c = c_; }
    __host__ __device__ bool next(int i, Unit& u) const {
        const long L = (long)i * G + c; if (L >= nwg) return false;
        int wgid = (int)L; { const int q = nwg / NXCD, r = nwg % NXCD, xcd = wgid % NXCD, off = wgid / NXCD; wgid = (xcd < r ? xcd * (q + 1) : r * (q + 1) + (xcd - r) * q) + off; }
        const int nig = WGM * nN, gid = wgid / nig, fm = gid * WGM, gsz = (nM - fm) < WGM ? (nM - fm) : WGM;
        u.pm = fm + ((wgid % nig) % gsz); u.pn = (wgid % nig) / gsz; return true;
    }
    __device__ __forceinline__ void a_ready(const Unit&) const {}
    __device__ __forceinline__ void done(const Unit&) const {}
};

__device__ __forceinline__ unsigned cvt_pk_bf16(float lo, float hi) { unsigned r; asm volatile("v_cvt_pk_bf16_f32 %0, %1, %2" : "=v"(r) : "v"(lo), "v"(hi)); return r; }
typedef float f32x2 __attribute__((ext_vector_type(2)));
__device__ __forceinline__ f32x2 gelu_pk(f32x2 v) {
    const f32x2 av = __builtin_elementwise_abs(v), d = av * 0.2316418882f + 1.0f;
    f32x2 t; t.x = __builtin_amdgcn_rcpf(d.x); t.y = __builtin_amdgcn_rcpf(d.y);
    f32x2 q = t * 0.5307027145f + (-0.7265760135f); q = q * t + 0.7107068705f; q = q * t + (-0.142248368f); q = q * t + 0.127414796f; q = q * t;
    const f32x2 s = (v * v) * (-0.72134752044f);
    f32x2 e; e.x = __builtin_amdgcn_exp2f(s.x); e.y = __builtin_amdgcn_exp2f(s.y);
    const f32x2 m = v * (q * e), r = v - m;
    f32x2 o; o.x = v.x < 0.f ? m.x : r.x; o.y = v.y < 0.f ? m.y : r.y; return o;
}

template <int ACT  > struct EpiBf16 {
    static constexpr bool PERM = true, AFTER_DRAIN = false; static_assert(ACT == 0 || ACT == 1, "EpiBf16: ACT is 0 (none) or 1 (gelu_pk)");
    bf16_t* O; int ldc; const float* bias; int split_cols; size_t split_stride; float scale0;
    __device__ __forceinline__ void operator()(const f32x4 (&acc)[2][2][4][2], const Unit& u, int wr, int wc, int fr, int fq) const {
        const int row0 = u.pm * BM + wr * 64 + fr; int colt = u.pn * BM; bf16_t* base = O;
        float sc = 1.f; if (split_cols) { const int t = colt / split_cols; base += (size_t)t * split_stride; colt -= t * split_cols; if (t == 0) sc = scale0; }
        const int col0 = colt + wc * 32 + 8 * fq, bcol0 = u.pn * BM + wc * 32 + 8 * fq;
        f32x4 bv[2][2];
#pragma unroll
        for (int bj = 0; bj < 2; ++bj)
#pragma unroll
            for (int n = 0; n < 2; ++n) bv[bj][n] = bias ? *(const f32x4*)(bias + bcol0 + bj * HALF + 4 * n) : (f32x4){0.f, 0.f, 0.f, 0.f};
#pragma unroll
        for (int ai = 0; ai < 2; ++ai)
#pragma unroll
            for (int m = 0; m < 4; ++m) { bf16_t* rowp = base + (size_t)(row0 + ai * HALF + m * 16) * ldc + col0;
#pragma unroll
                for (int bj = 0; bj < 2; ++bj) { f32x4 v0 = acc[ai][bj][m][0] + bv[bj][0], v1 = acc[ai][bj][m][1] + bv[bj][1];
                    if (ACT == 1) { f32x2 a = gelu_pk((f32x2){v0[0], v0[1]}), b = gelu_pk((f32x2){v0[2], v0[3]}), c = gelu_pk((f32x2){v1[0], v1[1]}), d = gelu_pk((f32x2){v1[2], v1[3]});
                        v0 = (f32x4){a.x, a.y, b.x, b.y}; v1 = (f32x4){c.x, c.y, d.x, d.y}; }
                    v0 = v0 * sc; v1 = v1 * sc; u32x4 w; w.x = cvt_pk_bf16(v0[0], v0[1]); w.y = cvt_pk_bf16(v0[2], v0[3]); w.z = cvt_pk_bf16(v1[0], v1[1]); w.w = cvt_pk_bf16(v1[2], v1[3]);
                    *(u32x4*)(rowp + bj * HALF) = w; } }
    }
};
__device__ __forceinline__ float bf2f(unsigned short b) { return __uint_as_float(((unsigned)b) << 16); }
__device__ __forceinline__ float sigmoidf_(float x) { return 1.0f / (1.0f + __expf(-x)); }
template <bool ACCUM> struct EpiGate {
    static constexpr bool PERM = true, AFTER_DRAIN = false;
    bf16_t* O; int ldc; const bf16_t* G; int ldg;
    __device__ __forceinline__ void operator()(const f32x4 (&acc)[2][2][4][2], const Unit& u, int wr, int wc, int fr, int fq) const {
        const int row0 = u.pm * BM + wr * 64 + fr, col0 = u.pn * BM + wc * 32 + 8 * fq;
#pragma unroll
        for (int ai = 0; ai < 2; ++ai)
#pragma unroll
            for (int m = 0; m < 4; ++m) { const size_t row = (size_t)(row0 + ai * HALF + m * 16);
#pragma unroll
                for (int bj = 0; bj < 2; ++bj) {
                    const u32x4 g = *(const u32x4*)(G + row * ldg + col0 + bj * HALF);
                    bf16_t* op = O + row * ldc + col0 + bj * HALF;
                    u32x4 prev = (u32x4){0u, 0u, 0u, 0u}; if (ACCUM) prev = *(const u32x4*)op;
                    const f32x4 v0 = acc[ai][bj][m][0], v1 = acc[ai][bj][m][1];
                    float r[8];
#pragma unroll
                    for (int e = 0; e < 4; ++e) {
                        const unsigned gw = g[e], pw = prev[e];
                        const float a0 = (e < 2) ? v0[2 * e] : v1[2 * e - 4], a1 = (e < 2) ? v0[2 * e + 1] : v1[2 * e - 3];
                        r[2 * e] = __uint_as_float(pw << 16) + sigmoidf_(__uint_as_float(gw << 16)) * a0;
                        r[2 * e + 1] = __uint_as_float(pw & 0xffff0000u) + sigmoidf_(__uint_as_float(gw & 0xffff0000u)) * a1;
                    }
                    u32x4 w; w.x = cvt_pk_bf16(r[0], r[1]); w.y = cvt_pk_bf16(r[2], r[3]); w.z = cvt_pk_bf16(r[4], r[5]); w.w = cvt_pk_bf16(r[6], r[7]);
                    *(u32x4*)op = w; } }
    }
};
struct EpiResid {
    static constexpr bool PERM = false, AFTER_DRAIN = false;
    const float* base; float* out; const float* gate; int gpitch;
    __device__ __forceinline__ void operator()(const f32x4 (&acc)[2][2][4][2], const Unit& u, int wr, int wc, int fr, int fq) const {
        const int row0 = u.pm * BM + wr * 64 + fr, col0 = u.pn * BM + wc * 32 + 4 * fq;
        const float* gp = gate + (size_t)((u.pm * BM) >> 11) * gpitch + col0;
        f32x4 gv[2][2];
#pragma unroll
        for (int bj = 0; bj < 2; ++bj)
#pragma unroll
            for (int n = 0; n < 2; ++n) gv[bj][n] = *(const f32x4*)(gp + bj * HALF + n * 16);
#pragma unroll
        for (int ai = 0; ai < 2; ++ai)
#pragma unroll
            for (int m = 0; m < 4; ++m) { const size_t off = (size_t)(row0 + ai * HALF + m * 16) * 2048 + col0;
#pragma unroll
                for (int bj = 0; bj < 2; ++bj)
#pragma unroll
                    for (int n = 0; n < 2; ++n) { const f32x4 b = *(const f32x4*)(base + off + bj * HALF + n * 16);
                        *(f32x4*)(out + off + bj * HALF + n * 16) = b + gv[bj][n] * acc[ai][bj][m][n]; } }
    }
};
template <class Epi, class Sched, bool ALIGN_EPI = false, bool SP2 = false>
__device__ __forceinline__ void gemm_phase(PG8_LAS unsigned char* lds, const Gemm g, const Sched& S, const Epi& E) {
    const int tid = threadIdx.x, wid = __builtin_amdgcn_readfirstlane(tid >> 6), lane = tid & 63, wr = wid >> 2, wc = wid & 3, fr = lane & 15, fq = lane >> 4;
    const int K = g.K, nt = K / BK;
    unsigned voffA[2], voffB[2];
#pragma unroll
    for (int i = 0; i < 2; ++i) { int R, C; stage_rc(tid * 16 + i * 8192, R, C); const int Rb = Epi::PERM ? ((R & ~31) + perm32(R & 31)) : R;
        voffA[i] = (unsigned)(R * K + C) * 2u; voffB[i] = (unsigned)(Rb * K + C) * 2u; }
    const size_t kstep = (size_t)(BK * 2);
    const size_t hstep = (size_t)HALF * K * 2;
    const size_t tstep = 2 * hstep;
    const unsigned ldsw = (unsigned)wid * 1024u;
    const int aoff = lds_byte(wr * 64 + fr, fq * 8), boff = lds_byte(wc * 32 + fr, fq * 8);
#define PG8_SA(b, h) (((b) * 2 + (h)) * HTB)
#define PG8_SB(b, h) ((4 + (b) * 2 + (h)) * HTB)
#define PG8_STAGE(bufoff, gbase, voff) do { _Pragma("unroll") for (int _i = 0; _i < 2; ++_i) \
        __builtin_amdgcn_global_load_lds((const unsigned*)((const char*)(gbase) + (voff)[_i]), (PG8_LAS unsigned*)(lds + (bufoff) + ldsw + _i * 8192), 16, 0, 0); } while (0)
#define PG8_LDA(dst, b, h) do { _Pragma("unroll") for (int m = 0; m < 4; ++m) _Pragma("unroll") for (int k = 0; k < 2; ++k) dst[m][k] = *(const PG8_LAS bf16x8*)(lds + PG8_SA(b, h) + aoff + m * 2048 + k * 1024); } while (0)
#define PG8_LDB(dst, b, h) do { _Pragma("unroll") for (int n = 0; n < 2; ++n) _Pragma("unroll") for (int k = 0; k < 2; ++k) dst[n][k] = *(const PG8_LAS bf16x8*)(lds + PG8_SB(b, h) + boff + n * 2048 + k * 1024); } while (0)
#define PG8_MMA(ai, bj, At, Bt) do { __builtin_amdgcn_s_setprio(1); _Pragma("unroll") for (int m = 0; m < 4; ++m) _Pragma("unroll") for (int n = 0; n < 2; ++n) _Pragma("unroll") for (int k = 0; k < 2; ++k) \
        acc[ai][bj][m][n] = __builtin_amdgcn_mfma_f32_16x16x32_bf16(Bt[n][k], At[m][k], acc[ai][bj][m][n], 0, 0, 0); __builtin_amdgcn_s_setprio(0); } while (0)
#define PG8_WAIT_V(n) asm volatile("s_waitcnt vmcnt(" #n ")" ::: "memory")
#define PG8_WAIT_L(n) asm volatile("s_waitcnt lgkmcnt(" #n ")" ::: "memory")
#define PG8_BAR __builtin_amdgcn_s_barrier()
#define PG8_SCHED __builtin_amdgcn_sched_barrier(0)
    Unit cur, nxt; int ui = 0;
    if (!S.next(0, cur)) return;
    f32x4 acc[2][2][4][2];
#pragma unroll
    for (int a = 0; a < 2; ++a)
#pragma unroll
        for (int b = 0; b < 2; ++b)
#pragma unroll
            for (int m = 0; m < 4; ++m)
#pragma unroll
                for (int n = 0; n < 2; ++n) acc[a][b][m][n] = (f32x4){0.f, 0.f, 0.f, 0.f};
    bf16x8 At[4][2], B0[2][2], B1[2][2];
    const char* cA = (const char*)g.A + (size_t)cur.pm * tstep; const char* cB = (const char*)g.Bt + (size_t)cur.pn * tstep;
    S.a_ready(cur);
    if constexpr (SP2) {
        PG8_STAGE(PG8_SB(0, 0), cB, voffB); PG8_STAGE(PG8_SB(0, 1), cB + hstep, voffB); PG8_STAGE(PG8_SA(0, 0), cA, voffA); PG8_STAGE(PG8_SA(0, 1), cA + hstep, voffA);
        if (wr == 1) PG8_BAR;
        PG8_WAIT_V(2); PG8_BAR;
        PG8_STAGE(PG8_SB(1, 0), cB + kstep, voffB); PG8_STAGE(PG8_SA(1, 0), cA + kstep, voffA); PG8_STAGE(PG8_SB(1, 1), cB + hstep + kstep, voffB);
        PG8_WAIT_V(6); PG8_BAR;
    } else {
        PG8_STAGE(PG8_SB(0, 0), cB, voffB); PG8_STAGE(PG8_SA(0, 0), cA, voffA); PG8_STAGE(PG8_SB(0, 1), cB + hstep, voffB); PG8_STAGE(PG8_SA(0, 1), cA + hstep, voffA);
        if (wr == 1) PG8_BAR;
        PG8_WAIT_V(4); PG8_BAR;
        PG8_STAGE(PG8_SB(1, 0), cB + kstep, voffB); PG8_STAGE(PG8_SA(1, 0), cA + kstep, voffA); PG8_STAGE(PG8_SB(1, 1), cB + hstep + kstep, voffB);
        PG8_WAIT_V(6); PG8_BAR;
    }
    for (;;) {
        const bool has_next = S.next(ui + 1, nxt);
        const char* nA = has_next ? (const char*)g.A + (size_t)nxt.pm * tstep : cA; const char* nB = has_next ? (const char*)g.Bt + (size_t)nxt.pn * tstep : cB;
        for (int t = 0; t < nt; t += 2) {
            const bool last = (t == nt - 2);
            const char* a1 = cA + (size_t)(t + 1) * kstep;
            const char* a2 = last ? nA : cA + (size_t)(t + 2) * kstep; const char* b2 = last ? nB : cB + (size_t)(t + 2) * kstep;
            const char* a3 = a2 + kstep; const char* b3 = b2 + kstep;
            if (last && has_next) S.a_ready(nxt);
            if constexpr (SP2) {
            PG8_LDB(B0, 0, 0); PG8_LDB(B1, 0, 1); PG8_SCHED; PG8_LDA(At, 0, 0); PG8_STAGE(PG8_SA(1, 1), a1 + hstep, voffA);
            PG8_WAIT_V(8); PG8_WAIT_L(0); PG8_BAR; PG8_MMA(0, 0, At, B0); PG8_MMA(0, 1, At, B1); PG8_BAR; PG8_SCHED;
            PG8_LDA(At, 0, 1); PG8_STAGE(PG8_SB(0, 0), b2, voffB); PG8_STAGE(PG8_SB(0, 1), b2 + hstep, voffB); PG8_STAGE(PG8_SA(0, 0), a2, voffA);
            PG8_WAIT_V(8); PG8_WAIT_L(0); PG8_BAR; PG8_MMA(1, 0, At, B0); PG8_MMA(1, 1, At, B1); PG8_BAR; PG8_SCHED;
            PG8_LDB(B0, 1, 0); PG8_LDB(B1, 1, 1); PG8_SCHED; PG8_LDA(At, 1, 0); PG8_STAGE(PG8_SA(0, 1), a2 + hstep, voffA);
            PG8_WAIT_V(8); PG8_WAIT_L(0); PG8_BAR; PG8_MMA(0, 0, At, B0); PG8_MMA(0, 1, At, B1); PG8_BAR; PG8_SCHED;
            PG8_LDA(At, 1, 1); PG8_STAGE(PG8_SB(1, 0), b3, voffB); PG8_STAGE(PG8_SB(1, 1), b3 + hstep, voffB); PG8_STAGE(PG8_SA(1, 0), a3, voffA);
            PG8_WAIT_V(8); PG8_WAIT_L(0); PG8_BAR; PG8_MMA(1, 0, At, B0); PG8_MMA(1, 1, At, B1); PG8_BAR; PG8_SCHED;
            } else {
            PG8_LDB(B0, 0, 0); PG8_SCHED; PG8_LDA(At, 0, 0); PG8_STAGE(PG8_SA(1, 1), a1 + hstep, voffA);
            PG8_WAIT_L(8); PG8_BAR; PG8_WAIT_L(0); PG8_MMA(0, 0, At, B0); PG8_BAR; PG8_SCHED;
            PG8_LDB(B1, 0, 1); PG8_STAGE(PG8_SB(0, 0), b2, voffB);
            PG8_BAR; PG8_WAIT_L(0); PG8_MMA(0, 1, At, B1); PG8_BAR;
            PG8_LDA(At, 0, 1); PG8_STAGE(PG8_SA(0, 0), a2, voffA);
            PG8_BAR; PG8_WAIT_L(0); PG8_MMA(1, 0, At, B0); PG8_BAR; PG8_SCHED;
            PG8_STAGE(PG8_SB(0, 1), b2 + hstep, voffB);
            PG8_WAIT_V(6); PG8_BAR; PG8_MMA(1, 1, At, B1); PG8_BAR;
            PG8_LDB(B0, 1, 0); PG8_SCHED; PG8_LDA(At, 1, 0); PG8_STAGE(PG8_SA(0, 1), a2 + hstep, voffA);
            PG8_WAIT_L(8); PG8_BAR; PG8_WAIT_L(0); PG8_MMA(0, 0, At, B0); PG8_BAR; PG8_SCHED;
            PG8_LDB(B1, 1, 1); PG8_STAGE(PG8_SB(1, 0), b3, voffB);
            PG8_BAR; PG8_WAIT_L(0); PG8_MMA(0, 1, At, B1); PG8_BAR;
            PG8_LDA(At, 1, 1); PG8_STAGE(PG8_SA(1, 0), a3, voffA);
            PG8_BAR; PG8_WAIT_L(0); PG8_MMA(1, 0, At, B0); PG8_BAR; PG8_SCHED;
            PG8_STAGE(PG8_SB(1, 1), b3 + hstep, voffB);
            PG8_WAIT_V(6); PG8_BAR; PG8_MMA(1, 1, At, B1); PG8_BAR;
            }
        }
        if constexpr (ALIGN_EPI) { if (wr == 0) PG8_BAR; }
        if constexpr (!Epi::AFTER_DRAIN) { E(acc, cur, wr, wc, fr, fq); S.done(cur); }
        if (!has_next) break;
#pragma unroll
        for (int a = 0; a < 2; ++a)
#pragma unroll
            for (int b = 0; b < 2; ++b)
#pragma unroll
                for (int m = 0; m < 4; ++m)
#pragma unroll
                    for (int n = 0; n < 2; ++n) acc[a][b][m][n] = (f32x4){0.f, 0.f, 0.f, 0.f};
        cur = nxt; cA = nA; cB = nB; ++ui;
        if constexpr (ALIGN_EPI) { if (wr == 1) PG8_BAR; }
    }
    PG8_WAIT_V(0);
    if constexpr (!ALIGN_EPI) { if (wr == 0) PG8_BAR; }
    PG8_BAR;
    if constexpr (Epi::AFTER_DRAIN) { E.fused(acc, cur, wr, wc, fr, fq, lds, wid, lane); S.done(cur); }
#undef PG8_SA
#undef PG8_SB
#undef PG8_STAGE
#undef PG8_LDA
#undef PG8_LDB
#undef PG8_MMA
#undef PG8_WAIT_V
#undef PG8_WAIT_L
#undef PG8_BAR
#undef PG8_SCHED
}
}
#define GAS __attribute__((address_space(1)))
#define LAS __attribute__((address_space(3)))
typedef unsigned short bf16;
typedef unsigned v4u __attribute__((ext_vector_type(4)));
typedef float f32x4 __attribute__((ext_vector_type(4)));
typedef short bf16x8 __attribute__((ext_vector_type(8)));
typedef GAS unsigned gu32;
typedef GAS unsigned long long gu64;
#define RLX_AGENT __ATOMIC_RELAXED, __HIP_MEMORY_SCOPE_AGENT
#define LDS_WAIT() asm volatile("s_waitcnt lgkmcnt(0)" ::: "memory")
#define VM_WAIT() asm volatile("s_waitcnt vmcnt(0)" ::: "memory")
__device__ __forceinline__ unsigned long long rt() { return __builtin_amdgcn_s_memrealtime(); }
__device__ __forceinline__ unsigned f2bf(float f) { unsigned u = __builtin_bit_cast(unsigned, f); return (u + 0x7fffu + ((u >> 16) & 1u)) >> 16; }
__device__ __forceinline__ unsigned pk2(float lo, float hi) { return f2bf(lo) | (f2bf(hi) << 16); }

#define XB_TMO      128
#define XB_XCNT(j)  (256  + 64 * (j))
#define XB_XSUB(j)  (1280 + 64 * (j))
#define XB_XGEN(j)  (2304 + 64 * (j))
#define XB_TOP      3328
#define XB_TOPGEN   3392
#define XCD_BAR_WORDS 3456
#define XB_SPIN_CAP (1u << 18)

__device__ __forceinline__ unsigned xb_ld(unsigned* p)              { return __hip_atomic_load(p, __ATOMIC_RELAXED, __HIP_MEMORY_SCOPE_AGENT); }
__device__ __forceinline__ unsigned xb_add(unsigned* p, unsigned v) { return __hip_atomic_fetch_add(p, v, __ATOMIC_RELAXED, __HIP_MEMORY_SCOPE_AGENT); }
__device__ __forceinline__ unsigned xb_xcc_id() { return (unsigned)__builtin_amdgcn_s_getreg((3 << 11) | 20) & 0xFu; }
#define XB_SPIN(cond, bar) do { unsigned _sp = 0; while (cond) { __builtin_amdgcn_s_sleep(1); \
    if ((++_sp & 255u) == 0u) { if (xb_ld(&(bar)[XB_TMO])) break; if (_sp > XB_SPIN_CAP) { atomicAdd(&(bar)[XB_TMO], 1u); break; } } } } while (0)

struct XcdBarrier {
    unsigned* bar; unsigned x;
    volatile LAS unsigned* st;
};

__device__ __forceinline__ XcdBarrier xcd_barrier_post(unsigned* bar, volatile LAS unsigned* st) {
    XcdBarrier b; b.bar = bar; b.x = xb_xcc_id(); b.st = st;
    if (threadIdx.x == 0) (void)xb_add(&bar[XB_XCNT(b.x)], 1u);
    return b;
}
__device__ __forceinline__ void xcd_barrier_complete(unsigned* bar, unsigned x, unsigned& nloc, unsigned& nx) {
    const unsigned G = gridDim.x * gridDim.y * gridDim.z;
    unsigned sum, cnt, mine, sp = 0u;
    for (;;) {
        sum = 0u; cnt = 0u; mine = 0u;
#pragma unroll
        for (unsigned j = 0; j < 16; ++j) { const unsigned c = xb_ld(&bar[XB_XCNT(j)]); sum += c; cnt += (c > 0u) ? 1u : 0u; mine = (j == x) ? c : mine; }
        if (sum == G) break;
        __builtin_amdgcn_s_sleep(1);
        if ((++sp & 255u) == 0u) { if (xb_ld(&bar[XB_TMO])) break; if (sp > XB_SPIN_CAP) { atomicAdd(&bar[XB_TMO], 1u); break; } }
    }
    nloc = mine > 0u ? mine : 1u; nx = cnt > 0u ? cnt : 1u;
}

__device__ __forceinline__ void xcd_barrier(const XcdBarrier& b) {
    asm volatile("s_waitcnt vmcnt(0)" ::: "memory");
    __syncthreads();
    if (threadIdx.x == 0) {
        unsigned* bar = b.bar;
        __builtin_amdgcn_s_waitcnt(0);
        unsigned nloc = b.st[0], nx = b.st[1];
        if (nloc == 0u) { xcd_barrier_complete(bar, b.x, nloc, nx); b.st[0] = nloc; b.st[1] = nx; }
        const unsigned old = xb_add(&bar[XB_XSUB(b.x)], 1u);
        const unsigned gen = old / nloc;
        if (old + 1u == (gen + 1u) * nloc) {
            __builtin_amdgcn_fence(__ATOMIC_RELEASE, "agent");
            asm volatile("s_waitcnt vmcnt(0)" ::: "memory");
            const unsigned og = xb_add(&bar[XB_TOP], 1u);
            const unsigned tg = og / nx;
            if (og + 1u == (tg + 1u) * nx) xb_add(&bar[XB_TOPGEN], 1u);
            else XB_SPIN(xb_ld(&bar[XB_TOPGEN]) == tg, bar);
            __builtin_amdgcn_fence(__ATOMIC_ACQUIRE, "agent");
            xb_add(&bar[XB_XGEN(b.x)], 1u);
            asm volatile("s_waitcnt vmcnt(0)" ::: "memory");
        } else {
            XB_SPIN(xb_ld(&bar[XB_XGEN(b.x)]) == gen, bar);
            __builtin_amdgcn_fence(__ATOMIC_ACQUIRE, "agent");
            asm volatile("s_waitcnt vmcnt(0)" ::: "memory");
        }
    }
    __syncthreads();
}
constexpr int NWAVES = 8;
constexpr int DM = 2048, NPR = 8192, NSM = 512, NTOK = 8704, TP = 2048, NB = 4, NDB = 128, TS = 4;
constexpr int NIN = 10496, FF = 5632, FF2 = 11264, ADAW = 12288, NADA = 132;
constexpr int C_QKV = 0, C_Z = 3072, C_DQ = 4096, C_DK = 5120, C_DV = 5376, C_IQ = 5632, C_IK = 6144, C_A = 6208, C_B = 6216, C_IW = 6224, C_G1 = 6400, C_G2 = 8448;
constexpr float NORM_EPS = 1e-6f;
constexpr float QSCALE = 0.08838834764831845f * 1.4426950408889634f;
constexpr float IDX_SCALE = 0.35355339059327373f * 0.125f;
constexpr size_t O_Y = 0, O_KP = 17825792, O_VP = O_KP + 2097152, O_IKP = O_VP + 2097152, O_GSP = O_IKP + 524288, O_GCP = O_GSP + 524288, O_FCP = O_GCP + 36864,
                 O_KS = O_FCP + 90112, O_VS = O_KS + 131072, O_IKS = O_VS + 131072, O_GSS = O_IKS + 32768, O_GCS = O_GSS + 16777216, O_FCS = O_GCS + 1179648, O_END = O_FCS + 2883584;
constexpr size_t MiB = 1u << 20;
constexpr size_t al(size_t x) { return (x + MiB - 1) / MiB * MiB; }
constexpr size_t WS_CTL = 0, CTL_ZERO_BYTES = 1 * MiB;
constexpr size_t WS_ROPE = 1 * MiB;
constexpr size_t WS_ADA  = WS_ROPE + al(2052 * 24 * 8);
constexpr size_t WS_WIN  = WS_ADA + al((size_t)NADA * ADAW * 4);
constexpr size_t WS_WG   = WS_WIN + al((size_t)NIN * DM * 2);
constexpr size_t WS_WD   = WS_WG + al((size_t)DM * 1024 * 2);
constexpr size_t WS_WO   = WS_WD + al((size_t)DM * 1024 * 2);
constexpr size_t WS_WUP  = WS_WO + al((size_t)DM * DM * 2);
constexpr size_t WS_WDN  = WS_WUP + al((size_t)FF2 * DM * 2);
constexpr size_t WS_H    = WS_WDN + al((size_t)DM * FF * 2);
constexpr size_t WS_Y1   = WS_H + al((size_t)NTOK * DM * 2);
constexpr size_t WS_QB   = WS_Y1 + al((size_t)NTOK * NIN * 2);
constexpr size_t WS_KB   = WS_QB + al((size_t)NTOK * 1024 * 2);
constexpr size_t WS_VT   = WS_KB + al((size_t)NTOK * 256 * 2);
constexpr size_t WS_IQ   = WS_VT + al((size_t)NPR * 256 * 2);
constexpr size_t WS_IK   = WS_IQ + al((size_t)NTOK * 512 * 2);
constexpr size_t WS_IW   = WS_IK + al((size_t)NTOK * 64 * 2);
constexpr size_t WS_GCH  = WS_IW + al((size_t)NTOK * 8 * 4);
constexpr size_t GCH_BYTES = 98304, GCH_MS = 0, GCH_BT = 32768, GCH_QE = 65536, GCH_OLT = 81920;
constexpr size_t WS_GE   = WS_GCH + al((size_t)1024 * GCH_BYTES);
constexpr size_t WS_OG   = WS_GE + MiB;
constexpr size_t WS_OD   = WS_OG + al((size_t)NTOK * 1024 * 2);
constexpr size_t WS_MIX  = WS_OD + al((size_t)NTOK * 1024 * 2);
constexpr size_t WS_X1   = WS_MIX + al((size_t)NTOK * DM * 2);
constexpr size_t WS_U    = WS_X1 + al((size_t)NTOK * DM * 4);
constexpr size_t WS_ACT  = WS_U + al((size_t)NTOK * FF2 * 2);
constexpr size_t WS_SCR  = WS_ACT + al((size_t)NTOK * FF * 2);
constexpr size_t WS_END  = WS_SCR + al((size_t)256 * 32 * 2048 * 4);
constexpr int CW_BAR = 4096;
constexpr int CW_QUEUE = 16384;
constexpr int RING_OFF = 0, RING_BYTES = 131072;
constexpr int LDSCTL_OFF = 149504, MISC_OFF = LDSCTL_OFF + 320;
constexpr int LDS_BYTES = 151552;

struct Args {
    const float* in[28]; float* out; unsigned char* ws;
    double invf[24];
    int ph_lo, ph_hi;
};
struct Frame {
    LAS unsigned char* lds;
    gu32* ctl;
    int tid, lane, wave, G, bid;
};
typedef unsigned short bf16;
typedef unsigned u32x2v __attribute__((ext_vector_type(2)));
typedef float f32x2v __attribute__((ext_vector_type(2)));
__device__ __forceinline__ float wave_sum(float v) {
#pragma unroll
    for (int o = 1; o < 64; o <<= 1) v += __shfl_xor(v, o);
    return v;
}
__device__ __forceinline__ float bf2f(unsigned short b) { return __uint_as_float(((unsigned)b) << 16); }
__device__ __forceinline__ float bflo(unsigned w) { return __uint_as_float(w << 16); }
__device__ __forceinline__ float bfhi(unsigned w) { return __uint_as_float(w & 0xffff0000u); }
__device__ __forceinline__ float silu_f(float x) { return x / (1.0f + __expf(-x)); }
__device__ __forceinline__ float sigm_f(float x) { return 1.0f / (1.0f + __expf(-x)); }
__device__ __forceinline__ f32x4 mfma16(bf16x8 a, bf16x8 b, f32x4 c) { return __builtin_amdgcn_mfma_f32_16x16x32_bf16(a, b, c, 0, 0, 0); }
__device__ __forceinline__ int ada_row(int m) { return m < NPR ? (m >> 11) : 4 + ((m - NPR) >> 2); }

__device__ __forceinline__ void p0_ada(Frame& F, const float* c_prompt, const float* c_sample, const float* w_ada, const float* b_ada, float* ADA) {
    LAS bf16* As = (LAS bf16*)(F.lds);
    LAS bf16* Bs = (LAS bf16*)(F.lds + 144 * 264 * 2);
    const int tid = F.tid, lane = F.lane, w = F.wave;
    for (int j = F.bid; j < 256; j += F.G) {
        const int n0 = 48 * j;
        f32x4 acc[2][3];
#pragma unroll
        for (int a = 0; a < 2; ++a)
#pragma unroll
            for (int b = 0; b < 3; ++b) acc[a][b] = (f32x4){0.f, 0.f, 0.f, 0.f};
        f32x4 vb[6];
#pragma unroll
        for (int i = 0; i < 6; ++i) { const int idx = tid + 512 * i, kk = idx / 12, n4 = idx % 12; vb[i] = *(const f32x4*)(w_ada + (size_t)kk * ADAW + n0 + 4 * n4); }
        for (int kc = 0; kc < 8; ++kc) {
            const int k0 = 256 * kc;
            __syncthreads();
            for (int idx = tid; idx < 144 * 64; idx += 512) {
                const int row = idx >> 6, c4 = idx & 63;
                f32x4 v = (f32x4){0.f, 0.f, 0.f, 0.f};
                if (row < 4) v = *(const f32x4*)(c_prompt + (size_t)row * DM + k0 + 4 * c4);
                else if (row < NADA) v = *(const f32x4*)(c_sample + (size_t)(row - 4) * DM + k0 + 4 * c4);
                u32x2v o; o.x = pk2(silu_f(v.x), silu_f(v.y)); o.y = pk2(silu_f(v.z), silu_f(v.w));
                *(LAS u32x2v*)(As + row * 264 + 4 * c4) = o;
            }
#pragma unroll
            for (int i = 0; i < 6; ++i) { const int idx = tid + 512 * i, kk = idx / 12, n4 = idx % 12;
                Bs[(4 * n4 + 0) * 264 + kk] = (bf16)f2bf(vb[i].x); Bs[(4 * n4 + 1) * 264 + kk] = (bf16)f2bf(vb[i].y);
                Bs[(4 * n4 + 2) * 264 + kk] = (bf16)f2bf(vb[i].z); Bs[(4 * n4 + 3) * 264 + kk] = (bf16)f2bf(vb[i].w); }
            if (kc < 7) {
#pragma unroll
                for (int i = 0; i < 6; ++i) { const int idx = tid + 512 * i, kk = idx / 12, n4 = idx % 12; vb[i] = *(const f32x4*)(w_ada + (size_t)(k0 + 256 + kk) * ADAW + n0 + 4 * n4); }
            }
            __syncthreads();
#pragma unroll
            for (int mi = 0; mi < 2; ++mi) {
                const int mt = w + 8 * mi;
                if (mt < 9) {
#pragma unroll
                    for (int ks = 0; ks < 8; ++ks) {
                        const bf16x8 a = *(const LAS bf16x8*)(As + (mt * 16 + (lane & 15)) * 264 + ks * 32 + 8 * (lane >> 4));
#pragma unroll
                        for (int nt = 0; nt < 3; ++nt) {
                            const bf16x8 b = *(const LAS bf16x8*)(Bs + (nt * 16 + (lane & 15)) * 264 + ks * 32 + 8 * (lane >> 4));
                            acc[mi][nt] = mfma16(a, b, acc[mi][nt]);
                        }
                    }
                }
            }
        }
#pragma unroll
        for (int mi = 0; mi < 2; ++mi) {
            const int mt = w + 8 * mi;
            if (mt < 9) {
#pragma unroll
                for (int nt = 0; nt < 3; ++nt) {
                    const int col = n0 + nt * 16 + (lane & 15); const float bb = b_ada[col];
#pragma unroll
                    for (int r = 0; r < 4; ++r) { const int row = mt * 16 + 4 * (lane >> 4) + r; if (row < NADA) ADA[(size_t)row * ADAW + col] = acc[mi][nt][r] + bb; }
                }
            }
        }
    }
    __syncthreads();
}
template <class Map>
__device__ __forceinline__ void transpose_item(const float* W, int K, int N, bf16* WT, LAS float* scr, int kb, int nb, int lane, const Map& map) {
    const int k0 = 64 * kb, n0 = 32 * nb;
    const int src = map(n0 + (lane & 31));
#pragma unroll 8
    for (int i = 0; i < 32; ++i) { const int kk = 2 * i + (lane >> 5); scr[kk * 33 + (lane & 31)] = (src >= 0) ? W[(size_t)(k0 + kk) * N + src] : 0.f; }
    LDS_WAIT(); asm volatile("" ::: "memory");
    const int c = lane & 7;
#pragma unroll
    for (int j = 0; j < 4; ++j) { const int n = (lane >> 3) + 8 * j; const LAS float* s = scr + (8 * c) * 33 + n;
        v4u o; o.x = pk2(s[0 * 33], s[1 * 33]); o.y = pk2(s[2 * 33], s[3 * 33]); o.z = pk2(s[4 * 33], s[5 * 33]); o.w = pk2(s[6 * 33], s[7 * 33]);
        *(GAS v4u*)(WT + (size_t)(n0 + n) * K + k0 + 8 * c) = o; }
    LDS_WAIT(); asm volatile("" ::: "memory");
}
struct MapIn { __device__ __forceinline__ int operator()(int n) const {
    if (n < 4096) return n; if (n < 6208) return n + 16; if (n < 6224) return n - 6208 + 4096; if (n < 6232) return n; if (n < 6400) return -1; return n - 168; } };
struct MapId { __device__ __forceinline__ int operator()(int n) const { return n; } };
template <class Map>
__device__ __forceinline__ void transpose_all(Frame& F, const float* W, int K, int N, int Nd, bf16* WT, const Map& map) {
    LAS float* scr = (LAS float*)(F.lds + RING_OFF + F.wave * 16384);
    const int gw = F.bid * NWAVES + F.wave, NGW = F.G * NWAVES;
    const int nblk = Nd / 32, items = (K / 64) * nblk;
    for (int it = gw; it < items; it += NGW) transpose_item(W, K, N, WT, scr, it / nblk, it % nblk, F.lane, map);
}
__device__ __forceinline__ void p0_rope(Frame& F, const Args& args, f32x2v* ROPE) {
    const int gt = F.bid * 512 + F.tid, NT = F.G * 512;
    for (int i = gt; i < 2052 * 24; i += NT) {
        const int pos = i / 24, f = i % 24;
        double rev = (double)pos * args.invf[f] * 0.15915494309189535;
        rev -= __builtin_floor(rev);
        const float r = (float)rev;
        ROPE[i] = (f32x2v){__builtin_amdgcn_cosf(r), __builtin_amdgcn_sinf(r)};
    }
}
__device__ __forceinline__ void norm_mod_row(const float* xrow, const float* g, const float* sh, const float* sc, bf16* orow, int lane) {
    const GAS f32x4* xr = (const GAS f32x4*)xrow + lane;
    f32x4 v[8]; float s = 0.f;
#pragma unroll
    for (int j = 0; j < 8; ++j) { v[j] = xr[64 * j]; s += (v[j].x * v[j].x + v[j].y * v[j].y) + (v[j].z * v[j].z + v[j].w * v[j].w); }
    const float rstd = 1.0f / sqrtf(wave_sum(s) * (1.0f / DM) + NORM_EPS);
    GAS u32x2v* o8 = (GAS u32x2v*)orow + lane;
#pragma unroll
    for (int j = 0; j < 8; ++j) {
        const int idx = 4 * lane + 256 * j;
        const f32x4 gg = *(const f32x4*)(g + idx), s1 = *(const f32x4*)(sc + idx), s0 = *(const f32x4*)(sh + idx);
        const f32x4 y = v[j] * rstd * gg * (s1 + 1.0f) + s0;
        u32x2v o; o.x = pk2(y.x, y.y); o.y = pk2(y.z, y.w); o8[64 * j] = o;
    }
}
template <class Epi>
__device__ __forceinline__ void small_gemm(Frame& F, const bf16* A, int lda, const bf16* Bt, int K, const Epi& epi) {
    const int lane = F.lane, w = F.wave;
    for (int tile = F.bid; tile < 256; tile += F.G) {
        const int tm = tile >> 5, tn = tile & 31, mt = w >> 1, nt0 = 2 * (w & 1);
        const bf16* ap = A + (size_t)(64 * tm + 16 * mt + (lane & 15)) * lda + 8 * (lane >> 4);
        const bf16* bp0 = Bt + (size_t)(64 * tn + 16 * nt0 + (lane & 15)) * K + 8 * (lane >> 4);
        const bf16* bp1 = bp0 + (size_t)16 * K;
        f32x4 acc0 = (f32x4){0.f, 0.f, 0.f, 0.f}, acc1 = acc0;
#pragma unroll 4
        for (int ks = 0; ks < K / 32; ++ks) {
            const bf16x8 a = *(const GAS bf16x8*)(ap + 32 * ks), b0 = *(const GAS bf16x8*)(bp0 + 32 * ks), b1 = *(const GAS bf16x8*)(bp1 + 32 * ks);
            acc0 = mfma16(a, b0, acc0); acc1 = mfma16(a, b1, acc1);
        }
#pragma unroll
        for (int r = 0; r < 4; ++r) { const int row = 64 * tm + 16 * mt + 4 * (lane >> 4) + r;
            epi(row, 64 * tn + 16 * nt0 + (lane & 15), acc0[r]); epi(row, 64 * tn + 16 * (nt0 + 1) + (lane & 15), acc1[r]); }
    }
}
struct P3Bufs { const bf16* Y1; const f32x2v* ROPE; bf16 *QB, *KB, *IQ, *IK; float* IW; float* out; };
__device__ __forceinline__ void p3_rot_row(const P3Bufs& P, int m, int lane) {
    const bf16* y = P.Y1 + (size_t)m * NIN;
    const bool pr = m < NPR;
    const int pos = pr ? (m & (TP - 1)) : TP + ((m - NPR) & 3);
    const f32x2v* rp = P.ROPE + pos * 24;
    float* kout = pr ? P.out + O_KP + (size_t)m * 256 : P.out + O_KS + (size_t)(m - NPR) * 256;
    float* vout = pr ? P.out + O_VP + (size_t)m * 256 : P.out + O_VS + (size_t)(m - NPR) * 256;
    float* ikout = pr ? P.out + O_IKP + (size_t)m * 64 : P.out + O_IKS + (size_t)(m - NPR) * 64;
#pragma unroll 4
    for (int i = 0; i < 16; ++i) {
        const int idx = lane + 64 * i, d = idx & 127;
        float v = bf2f(y[C_DQ + idx]);
        if (d < 32) { const float p = bf2f(y[C_DQ + (idx ^ 16)]); const f32x2v cs = rp[d & 15]; v = (d < 16) ? v * cs.x - p * cs.y : v * cs.x + p * cs.y; }
        P.QB[(size_t)m * 1024 + idx] = (bf16)f2bf(v * QSCALE);
    }
#pragma unroll
    for (int i = 0; i < 4; ++i) {
        const int idx = lane + 64 * i, d = idx & 127;
        float v = bf2f(y[C_DK + idx]);
        if (d < 32) { const float p = bf2f(y[C_DK + (idx ^ 16)]); const f32x2v cs = rp[d & 15]; v = (d < 16) ? v * cs.x - p * cs.y : v * cs.x + p * cs.y; }
        P.KB[(size_t)m * 256 + idx] = (bf16)f2bf(v); kout[idx] = v;
    }
#pragma unroll
    for (int i = 0; i < 4; ++i) { const int idx = lane + 64 * i; vout[idx] = bf2f(y[C_DV + idx]); }
#pragma unroll
    for (int i = 0; i < 8; ++i) {
        const int idx = lane + 64 * i, d = idx & 63;
        float v = bf2f(y[C_IQ + idx]);
        if (d < 16) { const float p = bf2f(y[C_IQ + (idx ^ 8)]); const f32x2v cs = rp[16 + (d & 7)]; v = (d < 8) ? v * cs.x - p * cs.y : v * cs.x + p * cs.y; }
        P.IQ[(size_t)m * 512 + idx] = (bf16)f2bf(v);
    }
    {
        const int d = lane;
        float v = bf2f(y[C_IK + d]);
        if (d < 16) { const float p = bf2f(y[C_IK + (d ^ 8)]); const f32x2v cs = rp[16 + (d & 7)]; v = (d < 8) ? v * cs.x - p * cs.y : v * cs.x + p * cs.y; }
        P.IK[(size_t)m * 64 + d] = (bf16)f2bf(v); ikout[d] = v;
    }
    if (lane < 8) P.IW[(size_t)m * 8 + lane] = bf2f(y[C_IW + lane]) * IDX_SCALE;
    int crow = -1; float* cout = nullptr;
    if (pr) { const int t = m & (TP - 1); if (t >= TP - 3) { crow = t - (TP - 3); cout = P.out + O_GCP + (size_t)((m >> 11) * 3 + crow) * 3072; } }
    else { const int ts = (m - NPR) & 3; if (ts >= 1) { crow = ts - 1; cout = P.out + O_GCS + (size_t)(((m - NPR) >> 2) * 3 + crow) * 3072; } }
    if (crow >= 0) { for (int i = 0; i < 48; ++i) cout[lane + 64 * i] = bf2f(y[C_QKV + lane + 64 * i]); }
}
__device__ __forceinline__ void p3_vt(Frame& F, const bf16* Y1, bf16* VT) {
    LAS bf16* T = (LAS bf16*)F.lds;
    for (int it = F.bid; it < 256; it += F.G) {
        const int b = it >> 6, kvh = (it >> 5) & 1, tt = it & 31;
        __syncthreads();
        { const int t = F.tid >> 3, c = F.tid & 7;
          const bf16* src = Y1 + (size_t)(b * TP + tt * 64 + t) * NIN + C_DV + kvh * 128 + c * 16;
          const v4u a = *(const GAS v4u*)src, bq = *(const GAS v4u*)(src + 8);
          LAS unsigned* dst = (LAS unsigned*)(T + t * 130 + c * 16);
          dst[0] = a.x; dst[1] = a.y; dst[2] = a.z; dst[3] = a.w; dst[4] = bq.x; dst[5] = bq.y; dst[6] = bq.z; dst[7] = bq.w; }
        __syncthreads();
        { const int d = F.tid >> 2, q = F.tid & 3;
          unsigned w[8];
#pragma unroll
          for (int e = 0; e < 8; ++e) w[e] = (unsigned)T[(q * 16 + 2 * e) * 130 + d] | ((unsigned)T[(q * 16 + 2 * e + 1) * 130 + d] << 16);
          bf16* dst = VT + ((size_t)((b * 2 + kvh) * 128 + d)) * TP + tt * 64 + q * 16;
          *(GAS v4u*)dst = (v4u){w[0], w[1], w[2], w[3]}; *(GAS v4u*)(dst + 8) = (v4u){w[4], w[5], w[6], w[7]}; }
    }
    __syncthreads();
}
__device__ __forceinline__ void unpack8(const v4u w, float (&f)[8]) {
    f[0] = bflo(w.x); f[1] = bfhi(w.x); f[2] = bflo(w.y); f[3] = bfhi(w.y); f[4] = bflo(w.z); f[5] = bfhi(w.z); f[6] = bflo(w.w); f[7] = bfhi(w.w); }
__device__ __forceinline__ void p9_conv(Frame& F, const bf16* U, const float* state_ffn, const float* wc, const float* bc, bf16* ACT, float* out) {
    const int gw = F.bid * NWAVES + F.wave, NGW = F.G * NWAVES, lane = F.lane;
    for (int it = gw; it < 136 * 11; it += NGW) {
        const int seg = it / 11, ci = it % 11, j0 = ci * 512 + lane * 8;
        float w0g[8], w1g[8], w2g[8], bg[8], w0v[8], w1v[8], w2v[8], bv[8];
#pragma unroll
        for (int e = 0; e < 8; ++e) { w0g[e] = wc[j0 + e]; w1g[e] = wc[FF2 + j0 + e]; w2g[e] = wc[2 * FF2 + j0 + e]; bg[e] = bc[j0 + e];
            w0v[e] = wc[FF + j0 + e]; w1v[e] = wc[FF2 + FF + j0 + e]; w2v[e] = wc[2 * FF2 + FF + j0 + e]; bv[e] = bc[FF + j0 + e]; }
        float g1[8], g2[8], v1[8], v2[8];
        const int r0 = seg * 64;
        if (seg < 128 && (r0 & (TP - 1)) != 0) {
            unpack8(*(const GAS v4u*)(U + (size_t)(r0 - 1) * FF2 + j0), g1); unpack8(*(const GAS v4u*)(U + (size_t)(r0 - 2) * FF2 + j0), g2);
            unpack8(*(const GAS v4u*)(U + (size_t)(r0 - 1) * FF2 + FF + j0), v1); unpack8(*(const GAS v4u*)(U + (size_t)(r0 - 2) * FF2 + FF + j0), v2);
        } else {
#pragma unroll
            for (int e = 0; e < 8; ++e) { g1[e] = 0.f; g2[e] = 0.f; v1[e] = 0.f; v2[e] = 0.f; }
        }
        for (int r = 0; r < 64; ++r) {
            const int m = r0 + r;
            if (seg >= 128 && (r & 3) == 0) {
                const float* sb = state_ffn + (size_t)((m - NPR) >> 2) * 2 * FF2;
#pragma unroll
                for (int e = 0; e < 8; ++e) { g2[e] = sb[j0 + e]; g1[e] = sb[FF2 + j0 + e]; v2[e] = sb[FF + j0 + e]; v1[e] = sb[FF2 + FF + j0 + e]; }
            }
            float g0[8], v0[8];
            unpack8(*(const GAS v4u*)(U + (size_t)m * FF2 + j0), g0); unpack8(*(const GAS v4u*)(U + (size_t)m * FF2 + FF + j0), v0);
            float a[8];
#pragma unroll
            for (int e = 0; e < 8; ++e) {
                const float gg = bg[e] + w0g[e] * g2[e] + w1g[e] * g1[e] + w2g[e] * g0[e];
                const float vv = bv[e] + w0v[e] * v2[e] + w1v[e] * v1[e] + w2v[e] * v0[e];
                a[e] = silu_f(gg) * vv;
            }
            *(GAS v4u*)(ACT + (size_t)m * FF + j0) = (v4u){pk2(a[0], a[1]), pk2(a[2], a[3]), pk2(a[4], a[5]), pk2(a[6], a[7])};
            float* co = nullptr;
            if (seg < 128) { const int t = m & (TP - 1); if (t >= TP - 2) co = out + O_FCP + (size_t)((m >> 11) * 2 + (t - (TP - 2))) * FF2; }
            else { const int ts = (m - NPR) & 3; if (ts >= 2) co = out + O_FCS + (size_t)(((m - NPR) >> 2) * 2 + (ts - 2)) * FF2; }
            if (co) {
                *(f32x4*)(co + j0) = (f32x4){g0[0], g0[1], g0[2], g0[3]}; *(f32x4*)(co + j0 + 4) = (f32x4){g0[4], g0[5], g0[6], g0[7]};
                *(f32x4*)(co + FF + j0) = (f32x4){v0[0], v0[1], v0[2], v0[3]}; *(f32x4*)(co + FF + j0 + 4) = (f32x4){v0[4], v0[5], v0[6], v0[7]};
            }
#pragma unroll
            for (int e = 0; e < 8; ++e) { g2[e] = g1[e]; g1[e] = g0[e]; v2[e] = v1[e]; v1[e] = v0[e]; }
        }
    }
}
__device__ __forceinline__ void final_norm_row(const float* xrow, const float* g, float* orow, int lane) {
    const GAS f32x4* xr = (const GAS f32x4*)xrow + lane;
    f32x4 v[8]; float s = 0.f;
#pragma unroll
    for (int j = 0; j < 8; ++j) { v[j] = xr[64 * j]; s += (v[j].x * v[j].x + v[j].y * v[j].y) + (v[j].z * v[j].z + v[j].w * v[j].w); }
    const float rstd = 1.0f / sqrtf(wave_sum(s) * (1.0f / DM) + NORM_EPS);
#pragma unroll
    for (int j = 0; j < 8; ++j) { const f32x4 gg = *(const f32x4*)(g + 4 * lane + 256 * j); ((GAS f32x4*)orow)[lane + 64 * j] = v[j] * rstd * gg; }
}
constexpr int GP_QS = 0, GP_KS = 17408, GP_KT = 34816, GP_VT = 53248, GP_QK = 71680, GP_PB = 80896, GP_XA = 90112, GP_XT = 99328, GP_UVT = 108544, GP_WKT = 126976, GP_ARR = 145408;
__device__ __forceinline__ bf16x8 ldsfrag(const LAS bf16* base, int pitch, int row0, int k0, int lane) {
    return *(const LAS bf16x8*)(base + (row0 + (lane & 15)) * pitch + k0 + 8 * (lane >> 4));
}
__device__ __forceinline__ float softplus_f(float x) { return x > 20.f ? x : log1pf(__expf(x)); }
__device__ __forceinline__ void st4bf(LAS bf16* p, float a, float b, float c, float d) { *(LAS u32x2v*)p = (u32x2v){pk2(a, b), pk2(c, d)}; }
__device__ __forceinline__ void gst4bf(bf16* p, float a, float b, float c, float d) { *(GAS u32x2v*)p = (u32x2v){pk2(a, b), pk2(c, d)}; }

struct GdnW { const bf16* Y1; const float* w_gconv; const float* a_log; const float* dt_bias; unsigned char* gch; float* GE; };

__device__ __forceinline__ void gdn_chunk_prep(Frame& F, const GdnW& W, int ci) {
    int tid = F.tid; asm volatile("" : "+v"(tid));
    const int lane = tid & 63, w = __builtin_amdgcn_readfirstlane(tid >> 6), g4 = lane >> 4, l15 = lane & 15;
    const int bh = ci >> 5, n = ci & 31, b = bh >> 3, h = bh & 7;
    const int r0 = b * TP + n * 64;
    LAS bf16* Qs = (LAS bf16*)(F.lds + GP_QS); LAS bf16* Ks = (LAS bf16*)(F.lds + GP_KS); LAS bf16* Kt = (LAS bf16*)(F.lds + GP_KT); LAS bf16* Vt = (LAS bf16*)(F.lds + GP_VT);
    LAS bf16* QKs = (LAS bf16*)(F.lds + GP_QK); LAS bf16* Pb = (LAS bf16*)(F.lds + GP_PB); LAS bf16* Xa = (LAS bf16*)(F.lds + GP_XA); LAS bf16* Xt = (LAS bf16*)(F.lds + GP_XT);
    LAS bf16* UvT = (LAS bf16*)(F.lds + GP_UVT); LAS bf16* WkT = (LAS bf16*)(F.lds + GP_WKT);
    LAS float* garr = (LAS float*)(F.lds + GP_ARR); LAS float* barr = garr + 64; LAS float* gcs = garr + 128; LAS float* eg = garr + 192; LAS float* ek = garr + 256; LAS float* rqa = garr + 320; LAS float* rka = garr + 384;
    __syncthreads();
    {
        const int r = tid >> 3, ch = tid & 7, m = r0 + r, tseq = n * 64 + r;
        if (ch < 6) {
            const int seg = ch >> 1, cb = (ch & 1) * 64, col = seg * 1024 + h * 128 + cb;
            float ss = 0.f;
#pragma unroll 2
            for (int sc = 0; sc < 8; ++sc) {
                float y[8];
#pragma unroll
                for (int e = 0; e < 8; ++e) y[e] = 0.f;
#pragma unroll
                for (int i = 0; i < 4; ++i) {
                    if (tseq - 3 + i >= 0) {
                        float x[8]; unpack8(*(const GAS v4u*)(W.Y1 + (size_t)(m - 3 + i) * NIN + col + 8 * sc), x);
                        const f32x4 wa = *(const f32x4*)(W.w_gconv + i * 3072 + col + 8 * sc), wb = *(const f32x4*)(W.w_gconv + i * 3072 + col + 8 * sc + 4);
                        y[0] += wa.x * x[0]; y[1] += wa.y * x[1]; y[2] += wa.z * x[2]; y[3] += wa.w * x[3];
                        y[4] += wb.x * x[4]; y[5] += wb.y * x[5]; y[6] += wb.z * x[6]; y[7] += wb.w * x[7];
                    }
                }
#pragma unroll
                for (int e = 0; e < 8; ++e) { y[e] = silu_f(y[e]); ss += y[e] * y[e]; }
                const int cc = cb + 8 * sc;
                if (seg == 0) { st4bf(Qs + r * 136 + cc, y[0], y[1], y[2], y[3]); st4bf(Qs + r * 136 + cc + 4, y[4], y[5], y[6], y[7]); }
                else if (seg == 1) { st4bf(Ks + r * 136 + cc, y[0], y[1], y[2], y[3]); st4bf(Ks + r * 136 + cc + 4, y[4], y[5], y[6], y[7]);
#pragma unroll
                    for (int e = 0; e < 8; ++e) Kt[(cc + e) * 72 + r] = (bf16)f2bf(y[e]); }
                else {
#pragma unroll
                    for (int e = 0; e < 8; ++e) Vt[(cc + e) * 72 + r] = (bf16)f2bf(y[e]); }
            }
            if (seg < 2) { ss += __shfl_xor(ss, 1); const float scl = (1.0f / sqrtf(ss + NORM_EPS)) * (seg == 0 ? 0.08838834764831845f : 1.0f);
                if ((ch & 1) == 0) { if (seg == 0) rqa[r] = scl; else rka[r] = scl; } }
        } else if (ch == 6) {
            const float ar = bf2f(W.Y1[(size_t)m * NIN + C_A + h]), br = bf2f(W.Y1[(size_t)m * NIN + C_B + h]);
            garr[r] = -__expf(W.a_log[h]) * softplus_f(ar + W.dt_bias[h]);
            barr[r] = sigm_f(br);
        }
    }
    __syncthreads();
    if (w == 0) {
        float g = garr[lane];
#pragma unroll
        for (int off = 1; off < 64; off <<= 1) { const float t = __shfl_up(g, off); if (lane >= off) g += t; }
        const float gl = __shfl(g, 63);
        gcs[lane] = g; eg[lane] = __expf(g); ek[lane] = __expf(gl - g);
        if (lane == 63) W.GE[ci] = __expf(g);
    }
    __syncthreads();
    const int mtC = w >> 1, ntC = 2 * (w & 1);
    f32x4 pacc[2];
    {
        f32x4 akk[2], aqk[2];
#pragma unroll
        for (int i = 0; i < 2; ++i) { akk[i] = (f32x4){0.f, 0.f, 0.f, 0.f}; aqk[i] = akk[i]; }
#pragma unroll
        for (int ks = 0; ks < 4; ++ks) {
            const bf16x8 aK = ldsfrag(Ks, 136, 16 * mtC, 32 * ks, lane), aQ = ldsfrag(Qs, 136, 16 * mtC, 32 * ks, lane);
#pragma unroll
            for (int i = 0; i < 2; ++i) { const bf16x8 bK = ldsfrag(Ks, 136, 16 * (ntC + i), 32 * ks, lane); akk[i] = mfma16(aK, bK, akk[i]); aqk[i] = mfma16(aQ, bK, aqk[i]); }
        }
#pragma unroll
        for (int i = 0; i < 2; ++i) {
            const int j = 16 * (ntC + i) + l15; const float gj = gcs[j], rkj = rka[j];
            float av[4], qv[4];
#pragma unroll
            for (int r = 0; r < 4; ++r) {
                const int c = 16 * mtC + 4 * g4 + r;
                const float dec = (j <= c) ? __expf(gcs[c] - gj) : 0.f;
                av[r] = (j < c) ? barr[c] * akk[i][r] * (rka[c] * rkj) * dec : 0.f; qv[r] = aqk[i][r] * (rqa[c] * rkj) * dec;
                pacc[i][r] = ((c == j) ? 1.0f : 0.f) - av[r];
                Pb[c * 72 + j] = (bf16)f2bf(pacc[i][r]); Xa[c * 72 + j] = (bf16)f2bf(av[r]); QKs[c * 72 + j] = (bf16)f2bf(qv[r]);
            }
            st4bf(Xt + j * 72 + 16 * mtC + 4 * g4, av[0], av[1], av[2], av[3]);
        }
    }
    __syncthreads();
    {
        f32x4 xacc[2];
#pragma unroll
        for (int i = 0; i < 2; ++i) { xacc[i] = (f32x4){0.f, 0.f, 0.f, 0.f};
#pragma unroll
            for (int ks = 0; ks < 2; ++ks) xacc[i] = mfma16(ldsfrag(Xa, 72, 16 * mtC, 32 * ks, lane), ldsfrag(Xt, 72, 16 * (ntC + i), 32 * ks, lane), xacc[i]); }
        __syncthreads();
#pragma unroll
        for (int i = 0; i < 2; ++i) { const int j = 16 * (ntC + i) + l15;
#pragma unroll
            for (int r = 0; r < 4; ++r) Xa[(16 * mtC + 4 * g4 + r) * 72 + j] = (bf16)f2bf(xacc[i][r]);
            st4bf(Xt + j * 72 + 16 * mtC + 4 * g4, xacc[i][0], xacc[i][1], xacc[i][2], xacc[i][3]); }
        __syncthreads();
#pragma unroll 1
        for (int it = 1; it <= 5; ++it) {
#pragma unroll
            for (int i = 0; i < 2; ++i) {
                xacc[i] = (f32x4){0.f, 0.f, 0.f, 0.f};
#pragma unroll
                for (int ks = 0; ks < 2; ++ks) {
                    const bf16x8 bX = ldsfrag(Xt, 72, 16 * (ntC + i), 32 * ks, lane);
                    pacc[i] = mfma16(ldsfrag(Pb, 72, 16 * mtC, 32 * ks, lane), bX, pacc[i]);
                    xacc[i] = mfma16(ldsfrag(Xa, 72, 16 * mtC, 32 * ks, lane), bX, xacc[i]);
                }
            }
            __syncthreads();
#pragma unroll
            for (int i = 0; i < 2; ++i) { const int j = 16 * (ntC + i) + l15;
#pragma unroll
                for (int r = 0; r < 4; ++r) { const int c = 16 * mtC + 4 * g4 + r; Pb[c * 72 + j] = (bf16)f2bf(pacc[i][r]); Xa[c * 72 + j] = (bf16)f2bf(xacc[i][r]); }
                st4bf(Xt + j * 72 + 16 * mtC + 4 * g4, xacc[i][0], xacc[i][1], xacc[i][2], xacc[i][3]); }
            __syncthreads();
        }
#pragma unroll
        for (int i = 0; i < 2; ++i) { const int j = 16 * (ntC + i) + l15; const float bj = barr[j], bg = bj * eg[j] * rka[j];
#pragma unroll
            for (int r = 0; r < 4; ++r) { const int c = 16 * mtC + 4 * g4 + r; Xa[c * 72 + j] = (bf16)f2bf(pacc[i][r] * bj); Xt[c * 72 + j] = (bf16)f2bf(pacc[i][r] * bg); } }
    }
    __syncthreads();
#pragma unroll
    for (int mt = 0; mt < 4; ++mt) {
        f32x4 au = (f32x4){0.f, 0.f, 0.f, 0.f}, aw = au;
#pragma unroll
        for (int ks = 0; ks < 2; ++ks) {
            au = mfma16(ldsfrag(Xa, 72, 16 * mt, 32 * ks, lane), ldsfrag(Vt, 72, 16 * w, 32 * ks, lane), au);
            aw = mfma16(ldsfrag(Xt, 72, 16 * mt, 32 * ks, lane), ldsfrag(Kt, 72, 16 * w, 32 * ks, lane), aw);
        }
        st4bf(UvT + (16 * w + l15) * 72 + 16 * mt + 4 * g4, au[0], au[1], au[2], au[3]);
        st4bf(WkT + (16 * w + l15) * 72 + 16 * mt + 4 * g4, aw[0], aw[1], aw[2], aw[3]);
    }
    __syncthreads();
    {
        const int dk = tid >> 2, c0 = (tid & 3) * 16;
#pragma unroll
        for (int q = 0; q < 2; ++q) {
            LAS v4u* p = (LAS v4u*)(Kt + dk * 72 + c0 + 8 * q); float x[8]; unpack8(*p, x);
#pragma unroll
            for (int e = 0; e < 8; ++e) x[e] *= ek[c0 + 8 * q + e] * rka[c0 + 8 * q + e];
            *p = (v4u){pk2(x[0], x[1]), pk2(x[2], x[3]), pk2(x[4], x[5]), pk2(x[6], x[7])};
        }
    }
    __syncthreads();
    unsigned char* gb = W.gch + (size_t)ci * GCH_BYTES;
    bf16* MS = (bf16*)(gb + GCH_MS); bf16* BT = (bf16*)(gb + GCH_BT); bf16* QE = (bf16*)(gb + GCH_QE); bf16* OLT = (bf16*)(gb + GCH_OLT);
#pragma unroll 2
    for (int nt = 0; nt < 8; ++nt) {
        f32x4 am = (f32x4){0.f, 0.f, 0.f, 0.f}, ab = am;
#pragma unroll
        for (int ks = 0; ks < 2; ++ks) {
            am = mfma16(ldsfrag(WkT, 72, 16 * w, 32 * ks, lane), ldsfrag(Kt, 72, 16 * nt, 32 * ks, lane), am);
            ab = mfma16(ldsfrag(Kt, 72, 16 * w, 32 * ks, lane), ldsfrag(UvT, 72, 16 * nt, 32 * ks, lane), ab);
        }
        gst4bf(MS + (size_t)(16 * nt + l15) * 128 + 16 * w + 4 * g4, -am[0], -am[1], -am[2], -am[3]);
        gst4bf(BT + (size_t)(16 * nt + l15) * 128 + 16 * w + 4 * g4, ab[0], ab[1], ab[2], ab[3]);
    }
#pragma unroll
    for (int nt = 0; nt < 4; ++nt) {
        f32x4 aq = (f32x4){0.f, 0.f, 0.f, 0.f};
#pragma unroll
        for (int ks = 0; ks < 2; ++ks) aq = mfma16(ldsfrag(WkT, 72, 16 * w, 32 * ks, lane), ldsfrag(QKs, 72, 16 * nt, 32 * ks, lane), aq);
        const int c = 16 * nt + l15; const float e = eg[c] * rqa[c];
        const u32x2v qq = *(const LAS u32x2v*)(Qs + c * 136 + 16 * w + 4 * g4);
        gst4bf(QE + (size_t)c * 128 + 16 * w + 4 * g4, e * bflo(qq.x) - aq[0], e * bfhi(qq.x) - aq[1], e * bflo(qq.y) - aq[2], e * bfhi(qq.y) - aq[3]);
    }
#pragma unroll
    for (int mt = 0; mt < 4; ++mt) {
        f32x4 ao = (f32x4){0.f, 0.f, 0.f, 0.f};
#pragma unroll
        for (int ks = 0; ks < 2; ++ks) ao = mfma16(ldsfrag(QKs, 72, 16 * mt, 32 * ks, lane), ldsfrag(UvT, 72, 16 * w, 32 * ks, lane), ao);
        gst4bf(OLT + (size_t)(16 * w + l15) * 64 + 16 * mt + 4 * g4, ao[0], ao[1], ao[2], ao[3]);
    }
}

struct GdnS { const bf16* Y1; const float* w_gconv; const float* a_log; const float* dt_bias; const float* g_gnorm; const float* state_gdn; const float* state_gconv; bf16* OG; float* out; };
__device__ __forceinline__ void gdn_sample_item(Frame& F, const GdnS& W, int item) {
    int tid = F.tid; asm volatile("" : "+v"(tid));
    const int lane = tid & 63, w = __builtin_amdgcn_readfirstlane(tid >> 6);
    const int db = item >> 3, h = item & 7;
    LAS float* cv = (LAS float*)(F.lds);
    LAS float* gb = cv + 1536;
    LAS float* part = gb + 8;
    LAS float* opart = part + 2048;
    __syncthreads();
    const size_t mrow = (size_t)NPR + 4 * db;
    if (tid < 384) {
        const int seg = tid >> 7, col = seg * 1024 + h * 128 + (tid & 127);
        float xx[7];
#pragma unroll
        for (int i = 0; i < 3; ++i) xx[i] = W.state_gconv[(size_t)(db * 3 + i) * 3072 + col];
#pragma unroll
        for (int i = 0; i < 4; ++i) xx[3 + i] = bf2f(W.Y1[(mrow + i) * NIN + col]);
        const float w0 = W.w_gconv[col], w1 = W.w_gconv[3072 + col], w2 = W.w_gconv[2 * 3072 + col], w3 = W.w_gconv[3 * 3072 + col];
#pragma unroll
        for (int ts = 0; ts < 4; ++ts) cv[ts * 384 + tid] = silu_f(w0 * xx[ts] + w1 * xx[ts + 1] + w2 * xx[ts + 2] + w3 * xx[ts + 3]);
    } else if (tid < 388) {
        const int ts = tid - 384;
        const float ar = bf2f(W.Y1[(mrow + ts) * NIN + C_A + h]), br = bf2f(W.Y1[(mrow + ts) * NIN + C_B + h]);
        gb[ts] = -__expf(W.a_log[h]) * softplus_f(ar + W.dt_bias[h]); gb[4 + ts] = sigm_f(br);
    }
    const float* Sg = W.state_gdn + ((size_t)(db * 8 + h) * 128) * 128;
    f32x4 S[8];
#pragma unroll
    for (int i = 0; i < 8; ++i) S[i] = *(const f32x4*)(Sg + (size_t)(16 * w + 2 * i + (lane >> 5)) * 128 + 4 * (lane & 31));
    __syncthreads();
    {
        const int ts = w >> 1, sg = w & 1;
        LAS float* p = cv + ts * 384 + sg * 128;
        const float a = p[lane], b2 = p[lane + 64];
        const float scl = (1.0f / sqrtf(wave_sum(a * a + b2 * b2) + NORM_EPS)) * (sg == 0 ? 0.08838834764831845f : 1.0f);
        p[lane] = a * scl; p[lane + 64] = b2 * scl;
    }
    __syncthreads();
#pragma unroll 1
    for (int ts = 0; ts < 4; ++ts) {
        const LAS float* q = cv + ts * 384; const LAS float* k = q + 128; const LAS float* v = q + 256;
        const float al = __expf(gb[ts]), be = gb[4 + ts];
        float kr[8];
        f32x4 p = (f32x4){0.f, 0.f, 0.f, 0.f};
#pragma unroll
        for (int i = 0; i < 8; ++i) { kr[i] = k[16 * w + 2 * i + (lane >> 5)]; p += S[i] * kr[i]; }
        p.x += __shfl_xor(p.x, 32); p.y += __shfl_xor(p.y, 32); p.z += __shfl_xor(p.z, 32); p.w += __shfl_xor(p.w, 32);
        LAS float* pp = part + (ts & 1) * 1024;
        if (lane < 32) *(LAS f32x4*)(pp + w * 128 + 4 * lane) = p;
        __syncthreads();
        f32x4 ks = (f32x4){0.f, 0.f, 0.f, 0.f};
#pragma unroll
        for (int ww = 0; ww < 8; ++ww) ks += *(const LAS f32x4*)(pp + ww * 128 + 4 * (lane & 31));
        const f32x4 vv = *(const LAS f32x4*)(v + 4 * (lane & 31));
        const f32x4 dlt = (vv - ks * al) * be;
        f32x4 po = (f32x4){0.f, 0.f, 0.f, 0.f};
#pragma unroll
        for (int i = 0; i < 8; ++i) { S[i] = S[i] * al + dlt * kr[i]; po += S[i] * q[16 * w + 2 * i + (lane >> 5)]; }
        po.x += __shfl_xor(po.x, 32); po.y += __shfl_xor(po.y, 32); po.z += __shfl_xor(po.z, 32); po.w += __shfl_xor(po.w, 32);
        if (lane < 32) *(LAS f32x4*)(opart + (ts * 8 + w) * 128 + 4 * lane) = po;
    }
    float* So = W.out + O_GSS + ((size_t)(db * 8 + h) * 128) * 128;
#pragma unroll
    for (int i = 0; i < 8; ++i) *(f32x4*)(So + (size_t)(16 * w + 2 * i + (lane >> 5)) * 128 + 4 * (lane & 31)) = S[i];
    __syncthreads();
    if (w < 4) {
        float o0 = 0.f, o1 = 0.f;
#pragma unroll
        for (int ww = 0; ww < 8; ++ww) { o0 += opart[(w * 8 + ww) * 128 + lane]; o1 += opart[(w * 8 + ww) * 128 + 64 + lane]; }
        const float rstd = 1.0f / sqrtf(wave_sum(o0 * o0 + o1 * o1) * (1.0f / 128.0f) + NORM_EPS);
        const bf16* zr = W.Y1 + (mrow + w) * NIN + C_Z + h * 128;
        bf16* og = W.OG + (mrow + w) * 1024 + h * 128;
        og[lane] = (bf16)f2bf(o0 * rstd * W.g_gnorm[lane] * silu_f(bf2f(zr[lane])));
        og[lane + 64] = (bf16)f2bf(o1 * rstd * W.g_gnorm[lane + 64] * silu_f(bf2f(zr[lane + 64])));
    }
}

constexpr int GS_BUF = 52224;
constexpr int GS_PART = 2 * GS_BUF;
constexpr int GS_OBUF = GS_PART + 4096;
struct GdnP { const bf16* Y1; const float* g_gnorm; const unsigned char* gch; const float* GE; bf16* OG; float* out; unsigned char* dbg; };
__device__ __forceinline__ bf16x8 permfrag(const LAS bf16* rowp, int k0, int g4) {
    const u32x2v a = *(const LAS u32x2v*)(rowp + k0 + 4 * g4), b = *(const LAS u32x2v*)(rowp + k0 + 16 + 4 * g4);
    return __builtin_bit_cast(bf16x8, (v4u){a.x, a.y, b.x, b.y});
}
__device__ __forceinline__ void gdn_scan_item(Frame& F, const GdnP& W, int bh) {
    int tid = F.tid; asm volatile("" : "+v"(tid));
    const int lane = tid & 63, w = __builtin_amdgcn_readfirstlane(tid >> 6), g4 = lane >> 4, l15 = lane & 15;
    const int b = bh >> 3, h = bh & 7;
    const unsigned char* gb0 = W.gch + (size_t)(bh * 32) * GCH_BYTES;
    f32x4 S[8];
#pragma unroll
    for (int mt = 0; mt < 8; ++mt) S[mt] = (f32x4){0.f, 0.f, 0.f, 0.f};
    __syncthreads();
    v4u st[6];
#pragma unroll
    for (int i = 0; i < 6; ++i) { const int idx = tid + 512 * i; const unsigned char* src = gb0 + (idx < 2048 ? GCH_MS + (size_t)idx * 16 : GCH_QE + (size_t)(idx - 2048) * 16); st[i] = *(const GAS v4u*)src; }
#pragma unroll
    for (int i = 0; i < 6; ++i) { const int idx = tid + 512 * i, row = idx >> 4, cchunk = idx & 15; *(LAS v4u*)(F.lds + row * 272 + cchunk * 16) = st[i]; }
    __syncthreads();
    const float gdv = W.g_gnorm[16 * w + l15];
    LAS float* part = (LAS float*)(F.lds + GS_PART);
    LAS f32x4* obuf = (LAS f32x4*)(F.lds + GS_OBUF) + (w * 64 + lane) * 4;
#define GDN_NORM_PREV(nprev) do { \
        const LAS float* pq = part + ((nprev) & 1) * 512; \
        const size_t rowb = (size_t)(b * TP + (nprev) * 64); \
        const bf16* zp = W.Y1 + rowb * NIN + C_Z + h * 128 + 16 * w + l15; \
        bf16* og = W.OG + rowb * 1024 + h * 128 + 16 * w + l15; \
        _Pragma("unroll 1") for (int ct = 0; ct < 4; ++ct) { \
            f32x4 tot = (f32x4){0.f, 0.f, 0.f, 0.f}; \
            _Pragma("unroll") for (int ww = 0; ww < 8; ++ww) tot += *(const LAS f32x4*)(pq + ww * 64 + 16 * ct + 4 * g4); \
            const f32x4 op = obuf[ct]; \
            _Pragma("unroll") for (int r = 0; r < 4; ++r) { const float rstd = 1.0f / sqrtf(tot[r] * (1.0f / 128.0f) + NORM_EPS); \
                const float zz = bf2f(zp[(size_t)(16 * ct + 4 * g4 + r) * NIN]); \
                og[(size_t)(16 * ct + 4 * g4 + r) * 1024] = (bf16)f2bf(op[r] * rstd * gdv * silu_f(zz)); } \
            asm volatile("" ::: "memory"); } } while (0)
#pragma unroll 1
    for (int n = 0; n < 32; ++n) {
        const unsigned char* gb = gb0 + (size_t)n * GCH_BYTES;
        const LAS bf16* MSl = (const LAS bf16*)(F.lds + (n & 1) * GS_BUF); const LAS bf16* QEl = MSl + 128 * 136;
        if (n < 31) {
#pragma unroll
            for (int i = 0; i < 6; ++i) { const int idx = tid + 512 * i; const unsigned char* src = gb + GCH_BYTES + (idx < 2048 ? GCH_MS + (size_t)idx * 16 : GCH_QE + (size_t)(idx - 2048) * 16); st[i] = *(const GAS v4u*)src; }
        }
        if (n > 0) GDN_NORM_PREV(n - 1);
        asm volatile("" ::: "memory");
        const float ge = W.GE[bh * 32 + n];
        const bf16* BTg = (const bf16*)(gb + GCH_BT) + (size_t)(16 * w + l15) * 128; const bf16* OLg = (const bf16*)(gb + GCH_OLT) + (size_t)(16 * w + l15) * 64;
        bf16x8 Sb[4];
#pragma unroll
        for (int ks = 0; ks < 4; ++ks)
            Sb[ks] = __builtin_bit_cast(bf16x8, (v4u){pk2(S[2 * ks][0], S[2 * ks][1]), pk2(S[2 * ks][2], S[2 * ks][3]), pk2(S[2 * ks + 1][0], S[2 * ks + 1][1]), pk2(S[2 * ks + 1][2], S[2 * ks + 1][3])});
        LAS float* pp = part + (n & 1) * 512 + w * 64;
#pragma unroll
        for (int ct = 0; ct < 4; ++ct) {
            const u32x2v olv = *(const GAS u32x2v*)(OLg + 16 * ct + 4 * g4);
            f32x4 o = (f32x4){bflo(olv.x), bfhi(olv.x), bflo(olv.y), bfhi(olv.y)};
            const LAS bf16* rp = QEl + (16 * ct + l15) * 136;
#pragma unroll
            for (int ks = 0; ks < 4; ++ks) o = mfma16(permfrag(rp, 32 * ks, g4), Sb[ks], o);
            obuf[ct] = o;
#if defined(MK_DIAG)
            { float* dbg = (float*)(W.dbg) + (size_t)(b * TP + n * 64) * 1024 + h * 128 + 16 * w + l15;
              for (int r = 0; r < 4; ++r) dbg[(size_t)(16 * ct + 4 * g4 + r) * 1024] = o[r]; }
#endif
            f32x4 sq = o * o;
#pragma unroll
            for (int off = 1; off < 16; off <<= 1) { sq.x += __shfl_xor(sq.x, off); sq.y += __shfl_xor(sq.y, off); sq.z += __shfl_xor(sq.z, off); sq.w += __shfl_xor(sq.w, off); }
            if (l15 == 0) *(LAS f32x4*)(pp + 16 * ct + 4 * g4) = sq;
            asm volatile("" ::: "memory");
        }
#pragma unroll
        for (int mt = 0; mt < 8; ++mt) {
            const u32x2v btv = *(const GAS u32x2v*)(BTg + 16 * mt + 4 * g4);
            f32x4 acc = S[mt] * ge + (f32x4){bflo(btv.x), bfhi(btv.x), bflo(btv.y), bfhi(btv.y)};
            const LAS bf16* rp = MSl + (16 * mt + l15) * 136;
#pragma unroll
            for (int ks = 0; ks < 4; ++ks) acc = mfma16(permfrag(rp, 32 * ks, g4), Sb[ks], acc);
            S[mt] = acc;
            if (mt & 1) asm volatile("" ::: "memory");
        }
        if (n < 31) {
#pragma unroll
            for (int i = 0; i < 6; ++i) { const int idx = tid + 512 * i, row = idx >> 4, cchunk = idx & 15; *(LAS v4u*)(F.lds + ((n + 1) & 1) * GS_BUF + row * 272 + cchunk * 16) = st[i]; }
        }
        __syncthreads();
    }
    GDN_NORM_PREV(31);
#undef GDN_NORM_PREV
    float* So = W.out + O_GSP + (size_t)bh * 128 * 128;
#pragma unroll
    for (int mt = 0; mt < 8; ++mt)
#pragma unroll
        for (int r = 0; r < 4; ++r) So[(size_t)(16 * mt + 4 * g4 + r) * 128 + 16 * w + l15] = S[mt][r];
    __syncthreads();
}
typedef float f32x16 __attribute__((ext_vector_type(16)));
__device__ __forceinline__ f32x16 mfma32(bf16x8 a, bf16x8 b, f32x16 c) { return __builtin_amdgcn_mfma_f32_32x32x16_bf16(a, b, c, 0, 0, 0); }
__device__ __forceinline__ unsigned sortkey(float x) { const unsigned u = __float_as_uint(x); return u ^ ((u >> 31) ? 0xFFFFFFFFu : 0x80000000u); }
__device__ __forceinline__ unsigned ld_sc1(const unsigned* p) { return __hip_atomic_load(p, __ATOMIC_RELAXED, __HIP_MEMORY_SCOPE_AGENT); }
constexpr int DSA_TOPK = 256;
constexpr int DL_K = 0;
constexpr int DL_V = 34816;
constexpr int DL_MASK = 71680;
constexpr int DL_END = 79872;
template <int NI>
__device__ __forceinline__ unsigned radix_select(const unsigned (&u)[NI], int& cgt) {
    unsigned T = 0u;
#pragma unroll 1
    for (int bit = 31; bit >= 0; --bit) {
        const unsigned cand = T | (1u << bit); int cnt = 0;
#pragma unroll
        for (int i = 0; i < NI; ++i) cnt += __builtin_popcountll(__ballot(u[i] >= cand));
        if (cnt >= DSA_TOPK) T = cand;
    }
    int c = 0;
#pragma unroll
    for (int i = 0; i < NI; ++i) c += __builtin_popcountll(__ballot(u[i] > T));
    cgt = c; return T;
}
struct DsaP { const bf16 *QB, *KB, *VT, *IQ, *IK; const float* IW; float* SCR; bf16* OD; };
__device__ __forceinline__ void dsa_prompt_item(Frame& F, const DsaP& W, int b, int qb) {
    int tid = F.tid; asm volatile("" : "+v"(tid));
    const int lane = tid & 63, w = __builtin_amdgcn_readfirstlane(tid >> 6), r32 = lane & 31, hh = lane >> 5;
    const int t0 = 32 * qb, m0 = b * TP + t0, nk = t0 + 32, ntile = (nk + 63) >> 6;
    LAS unsigned* maskb = (LAS unsigned*)(F.lds + DL_MASK);
    float* scr = W.SCR + (size_t)F.bid * 32 * 2048;
    __syncthreads();
    {
        bf16x8 aq[4];
#pragma unroll
        for (int ks = 0; ks < 4; ++ks) aq[ks] = *(const GAS bf16x8*)(W.IQ + (size_t)(m0 + 4 * w + (r32 >> 3)) * 512 + (r32 & 7) * 64 + 16 * ks + 8 * hh);
        float wq[4][4];
#pragma unroll
        for (int g = 0; g < 4; ++g) { const f32x4 t = *(const f32x4*)(W.IW + (size_t)(m0 + 4 * w + g) * 8 + 4 * hh); wq[g][0] = t.x; wq[g][1] = t.y; wq[g][2] = t.z; wq[g][3] = t.w; }
        const bf16* ikb = W.IK + (size_t)(b * TP + r32) * 64 + 8 * hh;
        const int nkt = nk >> 5;
        bf16x8 bk[4];
#pragma unroll
        for (int ks = 0; ks < 4; ++ks) bk[ks] = *(const GAS bf16x8*)(ikb + 16 * ks);
#pragma unroll 1
        for (int kt = 0; kt < nkt; ++kt) {
            bf16x8 bn[4];
            const int ktn = (kt + 1 < nkt) ? kt + 1 : kt;
#pragma unroll
            for (int ks = 0; ks < 4; ++ks) bn[ks] = *(const GAS bf16x8*)(ikb + (size_t)ktn * 32 * 64 + 16 * ks);
            f32x16 acc = {};
#pragma unroll
            for (int ks = 0; ks < 4; ++ks) acc = mfma32(aq[ks], bk[ks], acc);
#pragma unroll
            for (int g = 0; g < 4; ++g) {
                float s = wq[g][0] * fmaxf(acc[4 * g], 0.f) + wq[g][1] * fmaxf(acc[4 * g + 1], 0.f) + wq[g][2] * fmaxf(acc[4 * g + 2], 0.f) + wq[g][3] * fmaxf(acc[4 * g + 3], 0.f);
                s += __shfl_xor(s, 32);
                if (hh == (g >> 1)) scr[(size_t)(4 * w + g) * 2048 + 32 * kt + r32] = s;
            }
#pragma unroll
            for (int ks = 0; ks < 4; ++ks) bk[ks] = bn[ks];
        }
    }
    asm volatile("s_waitcnt vmcnt(0)" ::: "memory");
#pragma unroll 1
    for (int g = 0; g < 4; ++g) {
        const int q = 4 * w + g, p = t0 + q;
        const unsigned* srow = (const unsigned*)(scr + (size_t)q * 2048);
        unsigned u[32];
#pragma unroll
        for (int i = 0; i < 32; ++i) { const int s = i * 64 + lane; u[i] = 0u; if (i * 64 < nk) { const unsigned x = ld_sc1(srow + s); u[i] = (s <= p) ? sortkey(__uint_as_float(x)) : 0u; } }
        if (p + 1 <= DSA_TOPK) {
#pragma unroll
            for (int i = 0; i < 32; ++i) { const unsigned long long mk = __ballot(u[i] != 0u); if (lane == 0) { maskb[(q * 32 + i) * 2] = (unsigned)mk; maskb[(q * 32 + i) * 2 + 1] = (unsigned)(mk >> 32); } }
        } else {
            int cgt; const unsigned T = radix_select<32>(u, cgt);
            const int need = DSA_TOPK - cgt; int run = 0;
            const unsigned long long lt = (1ull << lane) - 1ull;
#pragma unroll
            for (int i = 0; i < 32; ++i) {
                const bool eq = (u[i] == T); const unsigned long long me = __ballot(eq);
                const int pre = run + __builtin_popcountll(me & lt); run += __builtin_popcountll(me);
                const unsigned long long mk = __ballot((u[i] > T) || (eq && pre < need));
                if (lane == 0) { maskb[(q * 32 + i) * 2] = (unsigned)mk; maskb[(q * 32 + i) * 2 + 1] = (unsigned)(mk >> 32); }
            }
        }
    }
    const int kvh = w >> 2;
    bf16x8 qf[8];
#pragma unroll
    for (int ks = 0; ks < 8; ++ks) qf[ks] = *(const GAS bf16x8*)(W.QB + (size_t)(m0 + r32) * 1024 + w * 128 + 16 * ks + 8 * hh);
    f32x16 o[4];
#pragma unroll
    for (int d = 0; d < 4; ++d) o[d] = (f32x16){};
    float mrun = -1e30f, lrun = 0.f;
    v4u pre[8];
    const unsigned koff = (unsigned)((tid >> 4) * 256 + (tid & 15) * 8), voff = (unsigned)((tid >> 3) * TP + (tid & 7) * 8);
    const unsigned klds = (unsigned)(DL_K + (tid >> 4) * 272 + (tid & 15) * 16), vlds = (unsigned)(DL_V + (tid >> 3) * 144 + (tid & 7) * 16);
#define DSA_LOAD_TILE(kt_) do { \
        const bf16* kb_ = W.KB + (size_t)(b * TP + 64 * (kt_)) * 256; const bf16* vb_ = W.VT + (size_t)(b * 2) * 128 * TP + 64 * (kt_); \
        _Pragma("unroll") for (int i = 0; i < 4; ++i) { \
            pre[i] = *(const GAS v4u*)(kb_ + ((i & 1) * 32 * 256 + (i >> 1) * 128) + koff); \
            pre[4 + i] = *(const GAS v4u*)(vb_ + (size_t)((i >> 1) * 128 + (i & 1) * 64) * TP + voff); } } while (0)
    DSA_LOAD_TILE(0);
    const LAS bf16* Kl = (const LAS bf16*)(F.lds + DL_K) + kvh * 64 * 136;
    const LAS bf16* Vl = (const LAS bf16*)(F.lds + DL_V) + kvh * 128 * 72;
#pragma unroll 1
    for (int kt = 0; kt < ntile; ++kt) {
        __syncthreads();
#pragma unroll
        for (int i = 0; i < 4; ++i) {
            *(LAS v4u*)(F.lds + klds + ((i >> 1) * 64 + (i & 1) * 32) * 272) = pre[i];
            *(LAS v4u*)(F.lds + vlds + ((i >> 1) * 128 + (i & 1) * 64) * 144) = pre[4 + i]; }
        __syncthreads();
        if (kt + 1 < ntile) DSA_LOAD_TILE(kt + 1);
        f32x16 p0 = {}, p1 = {};
#pragma unroll
        for (int ks = 0; ks < 8; ++ks) {
            const bf16x8 k0 = *(const LAS bf16x8*)(Kl + r32 * 136 + 16 * ks + 8 * hh), k1 = *(const LAS bf16x8*)(Kl + (32 + r32) * 136 + 16 * ks + 8 * hh);
            p0 = mfma32(k0, qf[ks], p0); p1 = mfma32(k1, qf[ks], p1);
            if (ks & 1) asm volatile("" ::: "memory");
        }
        const unsigned mlo = maskb[(r32 * 32 + kt) * 2] >> (4 * hh), mhi = maskb[(r32 * 32 + kt) * 2 + 1] >> (4 * hh);
        float mx = -INFINITY;
#pragma unroll
        for (int r = 0; r < 16; ++r) { const int pos = (r & 3) + 8 * (r >> 2);
            p0[r] = ((mlo >> pos) & 1u) ? p0[r] : -INFINITY; p1[r] = ((mhi >> pos) & 1u) ? p1[r] : -INFINITY;
            mx = fmaxf(mx, fmaxf(p0[r], p1[r])); }
        mx = fmaxf(mx, __shfl_xor(mx, 32));
        const float mnew = fmaxf(mrun, mx), alpha = __builtin_amdgcn_exp2f(mrun - mnew);
        mrun = mnew;
        float ls = 0.f;
#pragma unroll
        for (int r = 0; r < 16; ++r) { p0[r] = __builtin_amdgcn_exp2f(p0[r] - mnew); p1[r] = __builtin_amdgcn_exp2f(p1[r] - mnew); ls += p0[r] + p1[r]; }
        ls += __shfl_xor(ls, 32);
        lrun = lrun * alpha + ls;
#pragma unroll
        for (int d = 0; d < 4; ++d) o[d] = o[d] * alpha;
        bf16x8 pf[4];
        pf[0] = __builtin_bit_cast(bf16x8, (v4u){pk2(p0[0], p0[1]), pk2(p0[2], p0[3]), pk2(p0[4], p0[5]), pk2(p0[6], p0[7])});
        pf[1] = __builtin_bit_cast(bf16x8, (v4u){pk2(p0[8], p0[9]), pk2(p0[10], p0[11]), pk2(p0[12], p0[13]), pk2(p0[14], p0[15])});
        pf[2] = __builtin_bit_cast(bf16x8, (v4u){pk2(p1[0], p1[1]), pk2(p1[2], p1[3]), pk2(p1[4], p1[5]), pk2(p1[6], p1[7])});
        pf[3] = __builtin_bit_cast(bf16x8, (v4u){pk2(p1[8], p1[9]), pk2(p1[10], p1[11]), pk2(p1[12], p1[13]), pk2(p1[14], p1[15])});
#pragma unroll
        for (int d = 0; d < 4; ++d) {
            const LAS bf16* vr = Vl + (32 * d + r32) * 72 + 4 * hh;
#pragma unroll
            for (int s = 0; s < 4; ++s) {
                const u32x2v a = *(const LAS u32x2v*)(vr + 16 * s), c = *(const LAS u32x2v*)(vr + 16 * s + 8);
                o[d] = mfma32(__builtin_bit_cast(bf16x8, (v4u){a.x, a.y, c.x, c.y}), pf[s], o[d]);
            }
            asm volatile("" ::: "memory");
        }
    }
#undef DSA_LOAD_TILE
    const float inv = 1.0f / lrun;
    bf16* od = W.OD + (size_t)(m0 + r32) * 1024 + w * 128;
#pragma unroll
    for (int d = 0; d < 4; ++d)
#pragma unroll
        for (int rg = 0; rg < 4; ++rg) gst4bf(od + 32 * d + 8 * rg + 4 * hh, o[d][4 * rg] * inv, o[d][4 * rg + 1] * inv, o[d][4 * rg + 2] * inv, o[d][4 * rg + 3] * inv);
}
struct DsaS { const bf16 *QB, *IQ, *IK; const float* IW; const float *cache_k, *cache_v, *cache_ik; const int* page_table; const float* knew; const float* vnew; bf16* OD; };
constexpr int SL_SC = 0;
constexpr int SL_LIST = 33792;
constexpr int SL_Q = 37888;
constexpr int SL_P = 54272;
constexpr int SL_END = 87040;
__device__ __forceinline__ void dsa_sample_item(Frame& F, const DsaS& W, int db) {
    int tid = F.tid; asm volatile("" : "+v"(tid));
    const int lane = tid & 63, w = __builtin_amdgcn_readfirstlane(tid >> 6), r32 = lane & 31, hh = lane >> 5;
    const int m0 = NPR + 4 * db;
    LAS float* sc = (LAS float*)(F.lds + SL_SC);
    LAS unsigned* list = (LAS unsigned*)(F.lds + SL_LIST);
    const int* pt = W.page_table + db * 16;
    __syncthreads();
    {
        bf16x8 aq[4];
#pragma unroll
        for (int ks = 0; ks < 4; ++ks) aq[ks] = *(const GAS bf16x8*)(W.IQ + (size_t)(m0 + (r32 >> 3)) * 512 + (r32 & 7) * 64 + 16 * ks + 8 * hh);
        float wq[4][4];
#pragma unroll
        for (int g = 0; g < 4; ++g) { const f32x4 t = *(const f32x4*)(W.IW + (size_t)(m0 + g) * 8 + 4 * hh); wq[g][0] = t.x; wq[g][1] = t.y; wq[g][2] = t.z; wq[g][3] = t.w; }
#pragma unroll 1
        for (int kt = w; kt < 66; kt += 8) {
            bf16x8 bk[4];
            const int s = 32 * kt + r32;
            if (s < 2048) {
                const float* src = W.cache_ik + ((size_t)pt[s >> 7] * 128 + (s & 127)) * 64 + 8 * hh;
#pragma unroll
                for (int ks = 0; ks < 4; ++ks) { const f32x4 a = *(const f32x4*)(src + 16 * ks), c = *(const f32x4*)(src + 16 * ks + 4);
                    bk[ks] = __builtin_bit_cast(bf16x8, (v4u){pk2(a.x, a.y), pk2(a.z, a.w), pk2(c.x, c.y), pk2(c.z, c.w)}); }
            } else if (s < 2052) {
#pragma unroll
                for (int ks = 0; ks < 4; ++ks) bk[ks] = *(const GAS bf16x8*)(W.IK + (size_t)(m0 + s - 2048) * 64 + 16 * ks + 8 * hh);
            } else {
#pragma unroll
                for (int ks = 0; ks < 4; ++ks) bk[ks] = (bf16x8){0, 0, 0, 0, 0, 0, 0, 0};
            }
            f32x16 acc = {};
#pragma unroll
            for (int ks = 0; ks < 4; ++ks) acc = mfma32(aq[ks], bk[ks], acc);
#pragma unroll
            for (int g = 0; g < 4; ++g) {
                float v = wq[g][0] * fmaxf(acc[4 * g], 0.f) + wq[g][1] * fmaxf(acc[4 * g + 1], 0.f) + wq[g][2] * fmaxf(acc[4 * g + 2], 0.f) + wq[g][3] * fmaxf(acc[4 * g + 3], 0.f);
                v += __shfl_xor(v, 32);
                if (hh == (g >> 1)) sc[g * 2112 + s] = v;
            }
        }
        { const int q = w >> 1, kvh = w & 1; LAS float* qs = (LAS float*)(F.lds + SL_Q) + w * 512;
#pragma unroll
          for (int i = 0; i < 8; ++i) { const int idx = lane + 64 * i; qs[idx] = bf2f(W.QB[(size_t)(m0 + q) * 1024 + kvh * 512 + idx]); } }
    }
    __syncthreads();
    if (w < 4) {
        const int p = 2048 + w;
        unsigned u[33];
#pragma unroll
        for (int i = 0; i < 33; ++i) { const int s = i * 64 + lane; u[i] = (s <= p) ? sortkey(sc[w * 2112 + s]) : 0u; }
        int cgt; const unsigned T = radix_select<33>(u, cgt);
        const int need = DSA_TOPK - cgt; int run = 0, base = 0;
        const unsigned long long lt = (1ull << lane) - 1ull;
#pragma unroll
        for (int i = 0; i < 33; ++i) {
            const bool eq = (u[i] == T); const unsigned long long me = __ballot(eq);
            const int pre = run + __builtin_popcountll(me & lt); run += __builtin_popcountll(me);
            const bool sel = (u[i] > T) || (eq && pre < need);
            const unsigned long long mk = __ballot(sel);
            if (sel) { const int s = i * 64 + lane; const int pos = base + __builtin_popcountll(mk & lt);
                list[w * 256 + pos] = (s < 2048) ? (unsigned)(pt[s >> 7] * 128 + (s & 127)) : (0x80000000u | (unsigned)(s - 2048)); }
            base += __builtin_popcountll(mk);
        }
    }
    __syncthreads();
    {
        const int q = w >> 1, kvh = w & 1;
        const LAS float* qs = (const LAS float*)(F.lds + SL_Q) + w * 512;
        LAS float* pl = (LAS float*)(F.lds + SL_P) + w * 1024;
        const LAS unsigned* lq = list + q * 256;
        float sv[4][4];
#pragma unroll 1
        for (int rd = 0; rd < 4; ++rd) {
            const unsigned ro = lq[rd * 64 + lane];
            const float* kr = (ro & 0x80000000u) ? W.knew + (size_t)(4 * db + (ro & 3u)) * 256 + kvh * 128 : W.cache_k + (size_t)ro * 256 + kvh * 128;
            float a0 = 0.f, a1 = 0.f, a2 = 0.f, a3 = 0.f;
#pragma unroll 1
            for (int cb = 0; cb < 4; ++cb) {
                f32x4 kv[8];
#pragma unroll
                for (int c = 0; c < 8; ++c) kv[c] = *(const f32x4*)(kr + 32 * cb + 4 * c);
#pragma unroll
                for (int c = 0; c < 8; ++c) {
                    const int d = 32 * cb + 4 * c;
                    const f32x4 q0 = *(const LAS f32x4*)(qs + d), q1 = *(const LAS f32x4*)(qs + 128 + d), q2 = *(const LAS f32x4*)(qs + 256 + d), q3 = *(const LAS f32x4*)(qs + 384 + d);
                    a0 += kv[c].x * q0.x + kv[c].y * q0.y + kv[c].z * q0.z + kv[c].w * q0.w;
                    a1 += kv[c].x * q1.x + kv[c].y * q1.y + kv[c].z * q1.z + kv[c].w * q1.w;
                    a2 += kv[c].x * q2.x + kv[c].y * q2.y + kv[c].z * q2.z + kv[c].w * q2.w;
                    a3 += kv[c].x * q3.x + kv[c].y * q3.y + kv[c].z * q3.z + kv[c].w * q3.w;
                }
            }
            sv[rd][0] = a0; sv[rd][1] = a1; sv[rd][2] = a2; sv[rd][3] = a3;
        }
#pragma unroll
        for (int h = 0; h < 4; ++h) {
            float mx = fmaxf(fmaxf(sv[0][h], sv[1][h]), fmaxf(sv[2][h], sv[3][h]));
#pragma unroll
            for (int o = 1; o < 64; o <<= 1) mx = fmaxf(mx, __shfl_xor(mx, o));
            float e0 = __builtin_amdgcn_exp2f(sv[0][h] - mx), e1 = __builtin_amdgcn_exp2f(sv[1][h] - mx), e2 = __builtin_amdgcn_exp2f(sv[2][h] - mx), e3 = __builtin_amdgcn_exp2f(sv[3][h] - mx);
            const float inv = 1.0f / wave_sum(e0 + e1 + e2 + e3);
            pl[h * 256 + lane] = e0 * inv; pl[h * 256 + 64 + lane] = e1 * inv; pl[h * 256 + 128 + lane] = e2 * inv; pl[h * 256 + 192 + lane] = e3 * inv;
        }
        asm volatile("s_waitcnt lgkmcnt(0)" ::: "memory");
        f32x2v o0 = (f32x2v){0.f, 0.f}, o1 = o0, o2 = o0, o3 = o0;
#pragma unroll 8
        for (int j = 0; j < 256; ++j) {
            const unsigned ro = lq[j];
            const float* vr = (ro & 0x80000000u) ? W.vnew + (size_t)(4 * db + (ro & 3u)) * 256 + kvh * 128 : W.cache_v + (size_t)ro * 256 + kvh * 128;
            const f32x2v vv = *(const f32x2v*)(vr + 2 * lane);
            o0 += vv * pl[j]; o1 += vv * pl[256 + j]; o2 += vv * pl[512 + j]; o3 += vv * pl[768 + j];
        }
        bf16* od = W.OD + (size_t)(m0 + q) * 1024 + kvh * 512 + 2 * lane;
        *(GAS unsigned*)(od) = pk2(o0.x, o0.y); *(GAS unsigned*)(od + 128) = pk2(o1.x, o1.y); *(GAS unsigned*)(od + 256) = pk2(o2.x, o2.y); *(GAS unsigned*)(od + 384) = pk2(o3.x, o3.y);
    }
}
#ifndef MK_N_LAUNCHES
#define MK_N_LAUNCHES 1
#endif
constexpr int N_PHASES = 12;
__global__ void __launch_bounds__(NWAVES * 64, 2) mk_fwd(Args args) {
    extern __shared__ __attribute__((aligned(16))) unsigned char lds[];
    Frame F;
    F.lds = (LAS unsigned char*)lds;
    F.tid = threadIdx.x; F.lane = F.tid & 63; F.wave = __builtin_amdgcn_readfirstlane(F.tid >> 6);
    F.G = gridDim.x; F.bid = blockIdx.x;
    unsigned char* ws = args.ws;
    F.ctl = (gu32*)(ws + WS_CTL);
    volatile LAS unsigned* MISC = (volatile LAS unsigned*)(F.lds + MISC_OFF);
    for (int u = F.tid; u < (LDS_BYTES - LDSCTL_OFF) / 4; u += NWAVES * 64) ((LAS unsigned*)(F.lds + LDSCTL_OFF))[u] = 0u;
    __syncthreads();
    XcdBarrier bar; bar.bar = (unsigned*)(F.ctl + CW_BAR); bar.x = 0; bar.st = nullptr;
    if (MK_N_LAUNCHES == 1) bar = xcd_barrier_post((unsigned*)(F.ctl + CW_BAR), MISC + 8);
    const int lo = args.ph_lo, hi = args.ph_hi;
#define IN(k) (lo <= (k) && (k) < hi)
#define SEAM(k) do { if (IN(k) && IN((k) + 1)) xcd_barrier(bar); } while (0)
    const float* x_prompt = args.in[0]; const float* x_sample = args.in[1]; const float* c_prompt = args.in[2]; const float* c_sample = args.in[3];
    const float* cache_k = args.in[4]; const float* cache_v = args.in[5]; const float* cache_ik = args.in[6]; const int* page_table = (const int*)args.in[7];
    const float* state_gdn = args.in[8]; const float* state_gconv = args.in[9]; const float* state_fconv = args.in[10];
    const float* w_ada = args.in[11]; const float* b_ada = args.in[12]; const float* g_norm1 = args.in[13]; const float* w_in = args.in[14];
    const float* w_gconv = args.in[15]; const float* a_log = args.in[16]; const float* dt_bias = args.in[17]; const float* g_gnorm = args.in[18];
    const float* w_gout = args.in[19]; const float* w_dout = args.in[20]; const float* w_o = args.in[21]; const float* g_norm2 = args.in[22];
    const float* w_up = args.in[23]; const float* w_fconv = args.in[24]; const float* b_fconv = args.in[25]; const float* w_down = args.in[26]; const float* g_final = args.in[27];
    float* out = args.out;
    f32x2v* ROPE = (f32x2v*)(ws + WS_ROPE); float* ADA = (float*)(ws + WS_ADA);
    bf16* WIN = (bf16*)(ws + WS_WIN); bf16* WG = (bf16*)(ws + WS_WG); bf16* WD = (bf16*)(ws + WS_WD); bf16* WO = (bf16*)(ws + WS_WO);
    bf16* WUP = (bf16*)(ws + WS_WUP); bf16* WDN = (bf16*)(ws + WS_WDN);
    bf16* H = (bf16*)(ws + WS_H); bf16* Y1 = (bf16*)(ws + WS_Y1);
    bf16* QB = (bf16*)(ws + WS_QB); bf16* KB = (bf16*)(ws + WS_KB); bf16* VT = (bf16*)(ws + WS_VT); bf16* IQ = (bf16*)(ws + WS_IQ); bf16* IK = (bf16*)(ws + WS_IK);
    float* IW = (float*)(ws + WS_IW);
    bf16* OG = (bf16*)(ws + WS_OG); bf16* OD = (bf16*)(ws + WS_OD); bf16* MIX = (bf16*)(ws + WS_MIX); float* X1 = (float*)(ws + WS_X1);
    bf16* U = (bf16*)(ws + WS_U); bf16* ACT = (bf16*)(ws + WS_ACT);
#if defined(MK_DIAG)
    bf16* H2 = (bf16*)(ws + (size_t)960 * MiB); float* X2 = (float*)(ws + (size_t)1000 * MiB);
#else
    bf16* H2 = H; float* X2 = X1;
#endif
    const int gw = F.bid * NWAVES + F.wave, NGW = F.G * NWAVES;
    (void)cache_k; (void)cache_v; (void)cache_ik; (void)page_table; (void)state_gdn; (void)state_gconv; (void)w_gconv; (void)a_log; (void)dt_bias; (void)g_gnorm;
    (void)QB; (void)KB; (void)VT; (void)IQ; (void)IK; (void)IW;

    if (IN(0)) {
        p0_ada(F, c_prompt, c_sample, w_ada, b_ada, ADA);
        p0_rope(F, args, ROPE);
        transpose_all(F, w_in, DM, 10328, NIN, WIN, MapIn());
    }
    SEAM(0);
    if (IN(1)) {
        for (int m = gw; m < NTOK; m += NGW) {
            const float* xr = m < NPR ? x_prompt + (size_t)m * DM : x_sample + (size_t)(m - NPR) * DM;
            const float* ar = ADA + (size_t)ada_row(m) * ADAW;
            norm_mod_row(xr, g_norm1, ar, ar + 2048, H + (size_t)m * DM, F.lane);
        }
        transpose_all(F, w_gout, 1024, DM, DM, WG, MapId());
        transpose_all(F, w_dout, 1024, DM, DM, WD, MapId());
        transpose_all(F, w_o, DM, DM, DM, WO, MapId());
        transpose_all(F, w_up, DM, FF2, FF2, WUP, MapId());
        transpose_all(F, w_down, FF, DM, DM, WDN, MapId());
    }
    SEAM(1);
    if (IN(2)) {
        pg8::Gemm g{H, WIN, NTOK, NIN, DM}; pg8::StaticOrder S; S.init(NTOK, NIN, F.G, F.bid);
        pg8::EpiBf16<0> E{Y1, NIN, nullptr, 0, 0, 1.f};
        pg8::gemm_phase<pg8::EpiBf16<0>, pg8::StaticOrder, true, true>(F.lds + RING_OFF, g, S, E);
    }
    SEAM(2);
    if (IN(3)) {
        P3Bufs P{Y1, ROPE, QB, KB, IQ, IK, IW, out};
        for (int m = gw; m < NTOK; m += NGW) p3_rot_row(P, m, F.lane);
        p3_vt(F, Y1, VT);
        { GdnW Wp{Y1, w_gconv, a_log, dt_bias, ws + WS_GCH, (float*)(ws + WS_GE)};
          for (int ci = F.bid; ci < 1024; ci += F.G) gdn_chunk_prep(F, Wp, ci);
          GdnS Wsm{Y1, w_gconv, a_log, dt_bias, g_gnorm, state_gdn, state_gconv, OG, out};
          for (int it = F.bid; it < 1024; it += F.G) gdn_sample_item(F, Wsm, it); }
    }
    SEAM(3);
    if (IN(4)) {
        { GdnP Wq{Y1, g_gnorm, ws + WS_GCH, (const float*)(ws + WS_GE), OG, out, ws + (size_t)1080 * MiB};
          if (F.bid < 32) gdn_scan_item(F, Wq, F.bid); }
        { DsaS Wsd{QB, IQ, IK, IW, cache_k, cache_v, cache_ik, page_table, out + O_KS, out + O_VS, OD};
          volatile LAS unsigned* qslot = (volatile LAS unsigned*)(F.lds + LDSCTL_OFF);
          for (;;) {
              __syncthreads();
              if (F.tid == 0) qslot[0] = __hip_atomic_fetch_add(F.ctl + CW_QUEUE, 1u, RLX_AGENT);
              __syncthreads();
              const int item = (int)qslot[0];
              if (item >= 128) break;
              dsa_sample_item(F, Wsd, item);
          } }
        { DsaP Wd{QB, KB, VT, IQ, IK, IW, (float*)(ws + WS_SCR), OD};
          volatile LAS unsigned* qslot = (volatile LAS unsigned*)(F.lds + LDSCTL_OFF);
          for (;;) {
              __syncthreads();
              if (F.tid == 0) qslot[0] = __hip_atomic_fetch_add(F.ctl + CW_QUEUE + 64, 1u, RLX_AGENT);
              __syncthreads();
              const int k = (int)qslot[0];
              if (k >= 256) break;
              dsa_prompt_item(F, Wd, k & 3, 63 - (k >> 2));
          } }
    }
    SEAM(4);
    if (IN(5)) {
        { pg8::Gemm g{OG, WG, NPR, DM, 1024}; pg8::StaticOrder S; S.init(NPR, DM, F.G, F.bid);
          pg8::EpiGate<false> E{MIX, DM, Y1 + C_G1, NIN};
          pg8::gemm_phase<pg8::EpiGate<false>, pg8::StaticOrder, true, true>(F.lds + RING_OFF, g, S, E); }
        { pg8::Gemm g{OD, WD, NPR, DM, 1024}; pg8::StaticOrder S; S.init(NPR, DM, F.G, F.bid);
          pg8::EpiGate<true> E{MIX, DM, Y1 + C_G2, NIN};
          pg8::gemm_phase<pg8::EpiGate<true>, pg8::StaticOrder, true, true>(F.lds + RING_OFF, g, S, E); }
        { const bf16* gq = Y1 + (size_t)NPR * NIN; bf16* mx = MIX + (size_t)NPR * DM;
          small_gemm(F, OG + (size_t)NPR * 1024, 1024, WG, 1024, [&](int row, int col, float v) {
              mx[(size_t)row * DM + col] = (bf16)f2bf(sigm_f(bf2f(gq[(size_t)row * NIN + C_G1 + col])) * v); });
          small_gemm(F, OD + (size_t)NPR * 1024, 1024, WD, 1024, [&](int row, int col, float v) {
              bf16* p = mx + (size_t)row * DM + col; *p = (bf16)f2bf(bf2f(*p) + sigm_f(bf2f(gq[(size_t)row * NIN + C_G2 + col])) * v); }); }
    }
    SEAM(5);
    if (IN(6)) {
        { pg8::Gemm g{MIX, WO, NPR, DM, DM}; pg8::StaticOrder S; S.init(NPR, DM, F.G, F.bid);
          pg8::EpiResid E{x_prompt, X1, ADA + 4096, ADAW};
          pg8::gemm_phase<pg8::EpiResid, pg8::StaticOrder, true, true>(F.lds + RING_OFF, g, S, E); }
        small_gemm(F, MIX + (size_t)NPR * DM, DM, WO, DM, [&](int row, int col, float v) {
            X1[(size_t)(NPR + row) * DM + col] = x_sample[(size_t)row * DM + col] + ADA[(size_t)(4 + (row >> 2)) * ADAW + 4096 + col] * v; });
    }
    SEAM(6);
    if (IN(7)) {
        for (int m = gw; m < NTOK; m += NGW) {
            const float* ar = ADA + (size_t)ada_row(m) * ADAW;
            norm_mod_row(X1 + (size_t)m * DM, g_norm2, ar + 6144, ar + 8192, H2 + (size_t)m * DM, F.lane);
        }
    }
    SEAM(7);
    if (IN(8)) {
        pg8::Gemm g{H2, WUP, NTOK, FF2, DM}; pg8::StaticOrder S; S.init(NTOK, FF2, F.G, F.bid);
        pg8::EpiBf16<0> E{U, FF2, nullptr, 0, 0, 1.f};
        pg8::gemm_phase<pg8::EpiBf16<0>, pg8::StaticOrder, true, true>(F.lds + RING_OFF, g, S, E);
    }
    SEAM(8);
    if (IN(9)) p9_conv(F, U, state_fconv, w_fconv, b_fconv, ACT, out);
    SEAM(9);
    if (IN(10)) {
        { pg8::Gemm g{ACT, WDN, NPR, DM, FF}; pg8::StaticOrder S; S.init(NPR, DM, F.G, F.bid);
          pg8::EpiResid E{X1, X2, ADA + 10240, ADAW};
          pg8::gemm_phase<pg8::EpiResid, pg8::StaticOrder, true, true>(F.lds + RING_OFF, g, S, E); }
        small_gemm(F, ACT + (size_t)NPR * FF, FF, WDN, FF, [&](int row, int col, float v) {
            const size_t o_ = (size_t)(NPR + row) * DM + col; X2[o_] = X1[o_] + ADA[(size_t)(4 + (row >> 2)) * ADAW + 10240 + col] * v; });
    }
    SEAM(10);
    if (IN(11)) {
        for (int m = gw; m < NTOK; m += NGW) final_norm_row(X2 + (size_t)m * DM, g_final, out + O_Y + (size_t)m * DM, F.lane);
    }
#undef IN
#undef SEAM
}

extern "C" void kernel_launch(void* const* d_in, const int* in_sizes, int n_in, void* d_out, int out_size, void* d_ws, size_t ws_size, hipStream_t stream) {
    static int grid = 0;
    if (grid == 0) {
        if (n_in != 28 || (size_t)out_size != O_END || ws_size < WS_END) { fprintf(stderr, "kernel_launch: unexpected sizes n_in %d out %d ws %zu (need %zu)\n", n_in, out_size, ws_size, (size_t)WS_END); grid = -1; return; }
        int dev = 0, cus = 0, per_cu = 0;
        if (hipGetDevice(&dev) != hipSuccess || hipDeviceGetAttribute(&cus, hipDeviceAttributeMultiprocessorCount, dev) != hipSuccess) { grid = -1; return; }
        if (hipFuncSetAttribute((const void*)mk_fwd, hipFuncAttributeMaxDynamicSharedMemorySize, LDS_BYTES) != hipSuccess) { fprintf(stderr, "kernel_launch: hipFuncSetAttribute failed\n"); grid = -1; return; }
        if (hipOccupancyMaxActiveBlocksPerMultiprocessor(&per_cu, (const void*)mk_fwd, NWAVES * 64, LDS_BYTES) != hipSuccess || per_cu < 1)
            fprintf(stderr, "kernel_launch: occupancy query reports %d\n", per_cu);
        (void)hipGetLastError();
        grid = cus;
    }
    if (grid < 0) return;
    if (hipMemsetAsync((char*)d_ws + WS_CTL, 0, CTL_ZERO_BYTES, stream) != hipSuccess) return;
    Args a{};
    for (int i = 0; i < 28; ++i) a.in[i] = (const float*)d_in[i];
    a.out = (float*)d_out; a.ws = (unsigned char*)d_ws;
    for (int i = 0; i < 16; ++i) a.invf[i] = pow(500000.0, -(double)i / 16.0);
    for (int i = 0; i < 8; ++i) a.invf[16 + i] = pow(500000.0, -(double)i / 8.0);
    if (MK_N_LAUNCHES == 1) {
        a.ph_lo = 0; a.ph_hi = N_PHASES;
        hipLaunchKernelGGL(mk_fwd, dim3(grid), dim3(NWAVES * 64), LDS_BYTES, stream, a);
    } else {
        for (int p = 0; p < N_PHASES; ++p) { a.ph_lo = p; a.ph_hi = p + 1; hipLaunchKernelGGL(mk_fwd, dim3(grid), dim3(NWAVES * 64), LDS_BYTES, stream, a); }
    }
}
```

```cpp
#include <hip/hip_runtime.h>
#include <cstdio>
#include <cstdint>
#include <cmath>
namespace pg8 {
#define PG8_LAS __attribute__((address_space(3)))
typedef unsigned short bf16_t;
typedef short bf16x8 __attribute__((ext_vector_type(8)));
typedef float f32x4 __attribute__((ext_vector_type(4)));
typedef unsigned u32x4 __attribute__((ext_vector_type(4)));
constexpr int BM = 256, BK = 64, HALF = 128, HTB = HALF * BK * 2  , STAGE_BYTES = 8 * HTB, NXCD = 8, WGM = 8;

__host__ __device__ __forceinline__ int lds_byte(int r, int c) { const int st = (r >> 4) * 2 + (c >> 5), rr = r & 15, cc = c & 31, ob = rr * 64 + cc * 2; return st * 1024 + (ob ^ (((ob >> 9) & 1) << 5)); }
__host__ __device__ __forceinline__ void stage_rc(int b, int& R, int& C) { const int st = b / 1024, sb = b % 1024, swz = sb ^ (((sb >> 9) & 1) << 5); R = (st >> 1) * 16 + swz / 64; C = (st & 1) * 32 + (swz % 64) / 2; }
__host__ __device__ __forceinline__ int perm32(int rho) { const int n = rho >> 4, i = rho & 15; return 8 * (i >> 2) + 4 * n + (i & 3); }

struct Unit { int pm, pn; };
struct Gemm { const bf16_t* A; const bf16_t* Bt; int M, N, K; };

struct StaticOrder {
    int nM, nN, nwg, G, c;
    __host__ __device__ void init(int M, int N, int G_, int c_) { nM = M / BM; nN = N / BM; nwg = nM * nN; G = G_; c = c_; }
    __host__ __device__ bool next(int i, Unit& u) const {
        const long L = (long)i * G + c; if (L >= nwg) return false;
        int wgid = (int)L; { const int q = nwg / NXCD, r = nwg % NXCD, xcd = wgid % NXCD, off = wgid / NXCD; wgid = (xcd < r ? xcd * (q + 1) : r * (q + 1) + (xcd - r) * q) + off; }
        const int nig = WGM * nN, gid = wgid / nig, fm = gid * WGM, gsz = (nM - fm) < WGM ? (nM - fm) : WGM;
        u.pm = fm + ((wgid % nig) % gsz); u.pn = (wgid % nig) / gsz; return true;
    }
    __device__ __forceinline__ void a_ready(const Unit&) const {}
    __device__ __forceinline__ void done(const Unit&) const {}
};

struct OneUnit {
    int pm, pn;
    __device__ __forceinline__ bool next(int i, Unit& u) const { if (i) return false; u.pm = pm; u.pn = pn; return true; }
    __device__ __forceinline__ void a_ready(const Unit&) const {}
    __device__ __forceinline__ void done(const Unit&) const {}
};

typedef float f32x2_c2 __attribute__((ext_vector_type(2))); typedef __bf16 bf16x2_c2 __attribute__((ext_vector_type(2)));
__device__ __forceinline__ unsigned cvt_pk_bf16(float lo, float hi) { const f32x2_c2 v = {lo, hi}; const bf16x2_c2 b = __builtin_convertvector(v, bf16x2_c2); return __builtin_bit_cast(unsigned, b); }
typedef float f32x2 __attribute__((ext_vector_type(2)));
__device__ __forceinline__ f32x2 gelu_pk(f32x2 v) {
    const f32x2 av = __builtin_elementwise_abs(v), d = av * 0.2316418882f + 1.0f;
    f32x2 t; t.x = __builtin_amdgcn_rcpf(d.x); t.y = __builtin_amdgcn_rcpf(d.y);
    f32x2 q = t * 0.5307027145f + (-0.7265760135f); q = q * t + 0.7107068705f; q = q * t + (-0.142248368f); q = q * t + 0.127414796f; q = q * t;
    const f32x2 s = (v * v) * (-0.72134752044f);
    f32x2 e; e.x = __builtin_amdgcn_exp2f(s.x); e.y = __builtin_amdgcn_exp2f(s.y);
    const f32x2 m = v * (q * e), r = v - m;
    f32x2 o; o.x = v.x < 0.f ? m.x : r.x; o.y = v.y < 0.f ? m.y : r.y; return o;
}

template <int ACT  > struct EpiBf16 {
    static constexpr bool PERM = true, AFTER_DRAIN = false, HAS_MID = false; static_assert(ACT == 0 || ACT == 1, "EpiBf16: ACT is 0 (none) or 1 (gelu_pk)");
    bf16_t* O; int ldc; const float* bias; int split_cols; size_t split_stride; float scale0;
    __device__ __forceinline__ void operator()(const f32x4 (&acc)[2][2][4][2], const Unit& u, int wr, int wc, int fr, int fq) const {
        const int row0 = u.pm * BM + wr * 64 + fr; int colt = u.pn * BM; bf16_t* base = O;
        float sc = 1.f; if (split_cols) { const int t = colt / split_cols; base += (size_t)t * split_stride; colt -= t * split_cols; if (t == 0) sc = scale0; }
        const int col0 = colt + wc * 32 + 8 * fq, bcol0 = u.pn * BM + wc * 32 + 8 * fq;
        f32x4 bv[2][2];
#pragma unroll
        for (int bj = 0; bj < 2; ++bj)
#pragma unroll
            for (int n = 0; n < 2; ++n) bv[bj][n] = bias ? *(const f32x4*)(bias + bcol0 + bj * HALF + 4 * n) : (f32x4){0.f, 0.f, 0.f, 0.f};
#pragma unroll
        for (int ai = 0; ai < 2; ++ai)
#pragma unroll
            for (int m = 0; m < 4; ++m) { bf16_t* rowp = base + (size_t)(row0 + ai * HALF + m * 16) * ldc + col0;
#pragma unroll
                for (int bj = 0; bj < 2; ++bj) { f32x4 v0 = acc[ai][bj][m][0] + bv[bj][0], v1 = acc[ai][bj][m][1] + bv[bj][1];
                    if (ACT == 1) { f32x2 a = gelu_pk((f32x2){v0[0], v0[1]}), b = gelu_pk((f32x2){v0[2], v0[3]}), c = gelu_pk((f32x2){v1[0], v1[1]}), d = gelu_pk((f32x2){v1[2], v1[3]});
                        v0 = (f32x4){a.x, a.y, b.x, b.y}; v1 = (f32x4){c.x, c.y, d.x, d.y}; }
                    v0 = v0 * sc; v1 = v1 * sc; u32x4 w; w.x = cvt_pk_bf16(v0[0], v0[1]); w.y = cvt_pk_bf16(v0[2], v0[3]); w.z = cvt_pk_bf16(v1[0], v1[1]); w.w = cvt_pk_bf16(v1[2], v1[3]);
                    *(u32x4*)(rowp + bj * HALF) = w; } }
    }
};
__device__ __forceinline__ float bf2f(unsigned short b) { return __uint_as_float(((unsigned)b) << 16); }
__device__ __forceinline__ float sigmoidf_(float x) { return __builtin_amdgcn_rcpf(1.0f + __expf(-x)); }
template <bool ACCUM> struct EpiGate {
    static constexpr bool PERM = true, AFTER_DRAIN = false, HAS_MID = false;
    bf16_t* O; int ldc; const bf16_t* G; int ldg;
    __device__ __forceinline__ void operator()(const f32x4 (&acc)[2][2][4][2], const Unit& u, int wr, int wc, int fr, int fq) const {
        const int row0 = u.pm * BM + wr * 64 + fr, col0 = u.pn * BM + wc * 32 + 8 * fq;
#pragma unroll
        for (int ai = 0; ai < 2; ++ai)
#pragma unroll
            for (int m = 0; m < 4; ++m) { const size_t row = (size_t)(row0 + ai * HALF + m * 16);
#pragma unroll
                for (int bj = 0; bj < 2; ++bj) {
                    const u32x4 g = *(const u32x4*)(G + row * ldg + col0 + bj * HALF);
                    bf16_t* op = O + row * ldc + col0 + bj * HALF;
                    u32x4 prev = (u32x4){0u, 0u, 0u, 0u}; if (ACCUM) prev = *(const u32x4*)op;
                    const f32x4 v0 = acc[ai][bj][m][0], v1 = acc[ai][bj][m][1];
                    float r[8];
#pragma unroll
                    for (int e = 0; e < 4; ++e) {
                        const unsigned gw = g[e], pw = prev[e];
                        const float a0 = (e < 2) ? v0[2 * e] : v1[2 * e - 4], a1 = (e < 2) ? v0[2 * e + 1] : v1[2 * e - 3];
                        r[2 * e] = __uint_as_float(pw << 16) + sigmoidf_(__uint_as_float(gw << 16)) * a0;
                        r[2 * e + 1] = __uint_as_float(pw & 0xffff0000u) + sigmoidf_(__uint_as_float(gw & 0xffff0000u)) * a1;
                    }
                    u32x4 w; w.x = cvt_pk_bf16(r[0], r[1]); w.y = cvt_pk_bf16(r[2], r[3]); w.z = cvt_pk_bf16(r[4], r[5]); w.w = cvt_pk_bf16(r[6], r[7]);
                    *(u32x4*)op = w; } }
    }
};
struct EpiResid {
    static constexpr bool PERM = false, AFTER_DRAIN = false, HAS_MID = false;
    const float* base; float* out; const float* gate; int gpitch;
    __device__ __forceinline__ void operator()(const f32x4 (&acc)[2][2][4][2], const Unit& u, int wr, int wc, int fr, int fq) const {
        const int row0 = u.pm * BM + wr * 64 + fr, col0 = u.pn * BM + wc * 32 + 4 * fq;
        const float* gp = gate + (size_t)((u.pm * BM) >> 11) * gpitch + col0;
        f32x4 gv[2][2];
#pragma unroll
        for (int bj = 0; bj < 2; ++bj)
#pragma unroll
            for (int n = 0; n < 2; ++n) gv[bj][n] = *(const f32x4*)(gp + bj * HALF + n * 16);
#pragma unroll
        for (int ai = 0; ai < 2; ++ai) {
            f32x4 bs[4][2][2];
#pragma unroll
            for (int m = 0; m < 4; ++m) { const size_t off = (size_t)(row0 + ai * HALF + m * 16) * 2048 + col0;
#pragma unroll
                for (int bj = 0; bj < 2; ++bj)
#pragma unroll
                    for (int n = 0; n < 2; ++n) bs[m][bj][n] = *(const f32x4*)(base + off + bj * HALF + n * 16); }
            __builtin_amdgcn_sched_barrier(0);
#pragma unroll
            for (int m = 0; m < 4; ++m) { const size_t off = (size_t)(row0 + ai * HALF + m * 16) * 2048 + col0;
#pragma unroll
                for (int bj = 0; bj < 2; ++bj)
#pragma unroll
                    for (int n = 0; n < 2; ++n) *(f32x4*)(out + off + bj * HALF + n * 16) = bs[m][bj][n] + gv[bj][n] * acc[ai][bj][m][n]; }
        }
    }
};
template <bool BF_BASE, bool BF_OUT> struct EpiResid2 {
    static constexpr bool PERM = true, AFTER_DRAIN = false, HAS_MID = false;
    const void* base; void* out; const float* gate; int gpitch;
    __device__ __forceinline__ void operator()(const f32x4 (&acc)[2][2][4][2], const Unit& u, int wr, int wc, int fr, int fq) const {
        const int row0 = u.pm * BM + wr * 64 + fr, col0 = u.pn * BM + wc * 32 + 8 * fq;
        const float* gp = gate + (size_t)((u.pm * BM) >> 11) * gpitch + col0;
        f32x4 gv[2][2];
#pragma unroll
        for (int bj = 0; bj < 2; ++bj)
#pragma unroll
            for (int n = 0; n < 2; ++n) gv[bj][n] = *(const f32x4*)(gp + bj * HALF + 4 * n);
#pragma unroll
        for (int ai = 0; ai < 2; ++ai) {
            f32x4 bs[4][2][2];
#pragma unroll
            for (int m = 0; m < 4; ++m) { const size_t off = (size_t)(row0 + ai * HALF + m * 16) * 2048 + col0;
#pragma unroll
                for (int bj = 0; bj < 2; ++bj) {
                    if constexpr (BF_BASE) { const u32x4 w = *(const u32x4*)((const bf16_t*)base + off + bj * HALF);
                        bs[m][bj][0] = (f32x4){__uint_as_float(w.x << 16), __uint_as_float(w.x & 0xffff0000u), __uint_as_float(w.y << 16), __uint_as_float(w.y & 0xffff0000u)};
                        bs[m][bj][1] = (f32x4){__uint_as_float(w.z << 16), __uint_as_float(w.z & 0xffff0000u), __uint_as_float(w.w << 16), __uint_as_float(w.w & 0xffff0000u)}; }
                    else { bs[m][bj][0] = *(const f32x4*)((const float*)base + off + bj * HALF); bs[m][bj][1] = *(const f32x4*)((const float*)base + off + bj * HALF + 4); } } }
            __builtin_amdgcn_sched_barrier(0);
#pragma unroll
            for (int m = 0; m < 4; ++m) { const size_t off = (size_t)(row0 + ai * HALF + m * 16) * 2048 + col0;
#pragma unroll
                for (int bj = 0; bj < 2; ++bj) {
                    const f32x4 v0 = bs[m][bj][0] + gv[bj][0] * acc[ai][bj][m][0], v1 = bs[m][bj][1] + gv[bj][1] * acc[ai][bj][m][1];
                    if constexpr (BF_OUT) { u32x4 w; w.x = cvt_pk_bf16(v0[0], v0[1]); w.y = cvt_pk_bf16(v0[2], v0[3]); w.z = cvt_pk_bf16(v1[0], v1[1]); w.w = cvt_pk_bf16(v1[2], v1[3]);
                        *(u32x4*)((bf16_t*)out + off + bj * HALF) = w; }
                    else { *(f32x4*)((float*)out + off + bj * HALF) = v0; *(f32x4*)((float*)out + off + bj * HALF + 4) = v1; } } }
        }
    }
};
__device__ __forceinline__ float dpp_ror1(float v) { return __builtin_bit_cast(float, __builtin_amdgcn_update_dpp(0, __builtin_bit_cast(int, v), 0x121, 0xf, 0xf, false)); }
__device__ __forceinline__ float dpp_ror2(float v) { return __builtin_bit_cast(float, __builtin_amdgcn_update_dpp(0, __builtin_bit_cast(int, v), 0x122, 0xf, 0xf, false)); }
typedef unsigned u32x2 __attribute__((ext_vector_type(2)));
struct EpiConv {
    static constexpr bool PERM = true, AFTER_DRAIN = false, HAS_MID = false;
    bf16_t* ACT; bf16_t* U; bf16_t* HB; const float* wcv; const float* bcv;
    __device__ __forceinline__ void operator()(const f32x4 (&acc)[2][2][4][2], const Unit& u, int wr, int wc, int fr, int fq) const {
        const int j0 = u.pn * 128 + wc * 32 + 8 * fq;
        if (u.pm >= 32) {
#pragma unroll
            for (int ai = 0; ai < 2; ++ai)
#pragma unroll
                for (int m = 0; m < 4; ++m) { bf16_t* rowp = U + (size_t)(u.pm * BM + ai * HALF + wr * 64 + m * 16 + fr) * 11264 + j0;
#pragma unroll
                    for (int bj = 0; bj < 2; ++bj) { const f32x4 v0 = acc[ai][bj][m][0], v1 = acc[ai][bj][m][1];
                        u32x4 w; w.x = cvt_pk_bf16(v0[0], v0[1]); w.y = cvt_pk_bf16(v0[2], v0[3]); w.z = cvt_pk_bf16(v1[0], v1[1]); w.w = cvt_pk_bf16(v1[2], v1[3]);
                        *(u32x4*)(rowp + bj * 5632) = w; } }
            return;
        }
        f32x4 wg[2][3], wv[2][3], bg[2], bv[2];
#pragma unroll
        for (int n = 0; n < 2; ++n) { const int jn = j0 + 4 * n;
#pragma unroll
            for (int i = 0; i < 3; ++i) { wg[n][i] = *(const f32x4*)(wcv + i * 11264 + jn); wv[n][i] = *(const f32x4*)(wcv + i * 11264 + 5632 + jn); }
            bg[n] = *(const f32x4*)(bcv + jn); bv[n] = *(const f32x4*)(bcv + 5632 + jn); }
#pragma unroll
        for (int ai = 0; ai < 2; ++ai)
#pragma unroll
            for (int m = 0; m < 4; ++m) {
                const size_t row = (size_t)(u.pm * BM + ai * HALF + wr * 64 + m * 16 + fr);
                float r[8];
#pragma unroll
                for (int n = 0; n < 2; ++n)
#pragma unroll
                    for (int c = 0; c < 4; ++c) {
                        const float g0 = acc[ai][0][m][n][c], v0 = acc[ai][1][m][n][c];
                        float g1, g2, v1, v2;
                        if (m > 0) {
                            const float pg = acc[ai][0][m > 0 ? m - 1 : 0][n][c], pv = acc[ai][1][m > 0 ? m - 1 : 0][n][c];
                            g1 = dpp_ror1(fr == 15 ? pg : g0); v1 = dpp_ror1(fr == 15 ? pv : v0);
                            g2 = dpp_ror2(fr >= 14 ? pg : g0); v2 = dpp_ror2(fr >= 14 ? pv : v0);
                        } else { g1 = dpp_ror1(g0); g2 = dpp_ror2(g0); v1 = dpp_ror1(v0); v2 = dpp_ror2(v0); }
                        const float gg = bg[n][c] + wg[n][0][c] * g2 + wg[n][1][c] * g1 + wg[n][2][c] * g0;
                        const float vv = bv[n][c] + wv[n][0][c] * v2 + wv[n][1][c] * v1 + wv[n][2][c] * v0;
                        r[4 * n + c] = gg * __builtin_amdgcn_rcpf(1.0f + __expf(-gg)) * vv;
                    }
                if (m > 0 || fr >= 2) { u32x4 w; w.x = cvt_pk_bf16(r[0], r[1]); w.y = cvt_pk_bf16(r[2], r[3]); w.z = cvt_pk_bf16(r[4], r[5]); w.w = cvt_pk_bf16(r[6], r[7]); *(u32x4*)(ACT + row * 5632 + j0) = w; }
            }
#pragma unroll
        for (int ai = 0; ai < 2; ++ai) {
            const int blk = u.pm * 4 + ai * 2 + wr;
            bf16_t* hb = HB + (size_t)blk * 4 * 11264 + j0;
#pragma unroll
            for (int m = 0; m < 4; m += 3) {
                const int slot = (m == 3 && fr >= 14) ? fr - 14 : ((m == 0 && fr < 2) ? 2 + fr : -1);
                if (slot >= 0) {
#pragma unroll
                    for (int bj = 0; bj < 2; ++bj) { const f32x4 v0 = acc[ai][bj][m][0], v1 = acc[ai][bj][m][1];
                        u32x4 w; w.x = cvt_pk_bf16(v0[0], v0[1]); w.y = cvt_pk_bf16(v0[2], v0[3]); w.z = cvt_pk_bf16(v1[0], v1[1]); w.w = cvt_pk_bf16(v1[2], v1[3]);
                        *(u32x4*)(hb + (size_t)slot * 11264 + bj * 5632) = w; }
                }
            }
        }
    }
};

struct EpiGate2 {
    static constexpr bool PERM = true, AFTER_DRAIN = false, HAS_MID = true;
    bf16_t* O; int ldc; const bf16_t* G1; const bf16_t* G2; int ldg;
    __device__ __forceinline__ void mid(f32x4 (&acc)[2][2][4][2], const Unit& u, int wr, int wc, int fr, int fq) const {
        asm volatile("" : "+v"(fr), "+v"(fq));
        const int row0 = u.pm * BM + wr * 64 + fr, col0 = u.pn * BM + wc * 32 + 8 * fq;
#pragma unroll
        for (int ai = 0; ai < 2; ++ai)
#pragma unroll
            for (int mp = 0; mp < 2; ++mp) {
                u32x4 ga[2][2], gb[2][2];
#pragma unroll
                for (int m2 = 0; m2 < 2; ++m2) { const size_t row = (size_t)(row0 + ai * HALF + (2 * mp + m2) * 16);
#pragma unroll
                    for (int bj = 0; bj < 2; ++bj) { ga[m2][bj] = *(const u32x4*)(G1 + row * ldg + col0 + bj * HALF); gb[m2][bj] = *(const u32x4*)(G2 + row * ldg + col0 + bj * HALF); } }
                __builtin_amdgcn_sched_barrier(0);
#pragma unroll
                for (int m2 = 0; m2 < 2; ++m2) { const int m = 2 * mp + m2;
#pragma unroll
                    for (int bj = 0; bj < 2; ++bj)
#pragma unroll
                        for (int e = 0; e < 4; ++e) {
                            const unsigned g1 = ga[m2][bj][e], g2 = gb[m2][bj][e];
                            const float r0 = (1.0f + __expf(-__uint_as_float(g2 << 16))) * __builtin_amdgcn_rcpf(1.0f + __expf(-__uint_as_float(g1 << 16)));
                            const float r1 = (1.0f + __expf(-__uint_as_float(g2 & 0xffff0000u))) * __builtin_amdgcn_rcpf(1.0f + __expf(-__uint_as_float(g1 & 0xffff0000u)));
                            acc[ai][bj][m][e >> 1][(e & 1) * 2] *= r0; acc[ai][bj][m][e >> 1][(e & 1) * 2 + 1] *= r1;
                        } }
                asm volatile("" ::: "memory");
            }
    }
    __device__ __forceinline__ void operator()(const f32x4 (&acc)[2][2][4][2], const Unit& u, int wr, int wc, int fr, int fq) const {
        const int row0 = u.pm * BM + wr * 64 + fr, col0 = u.pn * BM + wc * 32 + 8 * fq;
#pragma unroll
        for (int ai = 0; ai < 2; ++ai) {
            u32x4 gg[4][2];
#pragma unroll
            for (int m = 0; m < 4; ++m)
#pragma unroll
                for (int bj = 0; bj < 2; ++bj) gg[m][bj] = *(const u32x4*)(G2 + (size_t)(row0 + ai * HALF + m * 16) * ldg + col0 + bj * HALF);
            __builtin_amdgcn_sched_barrier(0);
#pragma unroll
            for (int m = 0; m < 4; ++m) { const size_t row = (size_t)(row0 + ai * HALF + m * 16);
#pragma unroll
                for (int bj = 0; bj < 2; ++bj) {
                    const u32x4 g = gg[m][bj];
                    const f32x4 v0 = acc[ai][bj][m][0], v1 = acc[ai][bj][m][1];
                    float r[8];
#pragma unroll
                    for (int e = 0; e < 4; ++e) {
                        const float a0 = (e < 2) ? v0[2 * e] : v1[2 * e - 4], a1 = (e < 2) ? v0[2 * e + 1] : v1[2 * e - 3];
                        r[2 * e] = sigmoidf_(__uint_as_float(g[e] << 16)) * a0; r[2 * e + 1] = sigmoidf_(__uint_as_float(g[e] & 0xffff0000u)) * a1;
                    }
                    u32x4 w; w.x = cvt_pk_bf16(r[0], r[1]); w.y = cvt_pk_bf16(r[2], r[3]); w.z = cvt_pk_bf16(r[4], r[5]); w.w = cvt_pk_bf16(r[6], r[7]);
                    *(u32x4*)(O + row * ldc + col0 + bj * HALF) = w; } }
        }
    }
};
template <class Epi, class Sched, bool ALIGN_EPI = false, bool SP2 = false>
__device__ __forceinline__ void gemm_phase(PG8_LAS unsigned char* lds, const Gemm g, const Sched& S, const Epi& E) {
    const int tid = threadIdx.x, wid = __builtin_amdgcn_readfirstlane(tid >> 6), lane = tid & 63, wr = wid >> 2, wc = wid & 3, fr = lane & 15, fq = lane >> 4;
    const int K = g.K, nt = K / BK;
    unsigned voffA[2], voffB[2];
#pragma unroll
    for (int i = 0; i < 2; ++i) { int R, C; stage_rc(tid * 16 + i * 8192, R, C); const int Rb = Epi::PERM ? ((R & ~31) + perm32(R & 31)) : R;
        voffA[i] = (unsigned)(R * K + C) * 2u; voffB[i] = (unsigned)(Rb * K + C) * 2u; }
    const size_t kstep = (size_t)(BK * 2);
    const size_t hstep = (size_t)HALF * K * 2;
    const size_t tstep = 2 * hstep;
    const unsigned ldsw = (unsigned)wid * 1024u;
    const int aoff = lds_byte(wr * 64 + fr, fq * 8), boff = lds_byte(wc * 32 + fr, fq * 8);
#define PG8_SA(b, h) (((b) * 2 + (h)) * HTB)
#define PG8_SB(b, h) ((4 + (b) * 2 + (h)) * HTB)
#define PG8_STAGE(bufoff, gbase, voff) do { _Pragma("unroll") for (int _i = 0; _i < 2; ++_i) \
        __builtin_amdgcn_global_load_lds((const unsigned*)((const char*)(gbase) + (voff)[_i]), (PG8_LAS unsigned*)(lds + (bufoff) + ldsw + _i * 8192), 16, 0, 0); } while (0)
#define PG8_LDA(dst, b, h) do { _Pragma("unroll") for (int m = 0; m < 4; ++m) _Pragma("unroll") for (int k = 0; k < 2; ++k) dst[m][k] = *(const PG8_LAS bf16x8*)(lds + PG8_SA(b, h) + aoff + m * 2048 + k * 1024); } while (0)
#define PG8_LDB(dst, b, h) do { _Pragma("unroll") for (int n = 0; n < 2; ++n) _Pragma("unroll") for (int k = 0; k < 2; ++k) dst[n][k] = *(const PG8_LAS bf16x8*)(lds + PG8_SB(b, h) + boff + n * 2048 + k * 1024); } while (0)
#define PG8_MMA(ai, bj, At, Bt) do { __builtin_amdgcn_s_setprio(1); _Pragma("unroll") for (int m = 0; m < 4; ++m) _Pragma("unroll") for (int n = 0; n < 2; ++n) _Pragma("unroll") for (int k = 0; k < 2; ++k) \
        acc[ai][bj][m][n] = __builtin_amdgcn_mfma_f32_16x16x32_bf16(Bt[n][k], At[m][k], acc[ai][bj][m][n], 0, 0, 0); __builtin_amdgcn_s_setprio(0); } while (0)
#define PG8_WAIT_V(n) asm volatile("s_waitcnt vmcnt(" #n ")" ::: "memory")
#define PG8_WAIT_L(n) asm volatile("s_waitcnt lgkmcnt(" #n ")" ::: "memory")
#define PG8_BAR __builtin_amdgcn_s_barrier()
#define PG8_SCHED __builtin_amdgcn_sched_barrier(0)
    Unit cur, nxt; int ui = 0;
#if defined(MK_SUB)
#define GS_L3 volatile __attribute__((address_space(3)))
    if (threadIdx.x == 0) *(GS_L3 unsigned long long*)(lds + 149504 + 1088) = __builtin_amdgcn_s_memrealtime();
#define GSUB(i) do { if (threadIdx.x == 0) { const unsigned en_ = *(GS_L3 unsigned*)(lds + 149504 + 1096); if (en_) { const unsigned long long n_ = __builtin_amdgcn_s_memrealtime(); GS_L3 unsigned long long* t_ = (GS_L3 unsigned long long*)(lds + 149504 + 1088); \
        GS_L3 unsigned* a_ = (GS_L3 unsigned*)(lds + 149504 + 1104); a_[(en_ - 1) * 4 + (i)] += (unsigned)(n_ - t_[0]); t_[0] = n_; } } } while (0)
#define GSUBC() do { if (threadIdx.x == 0) { const unsigned en_ = *(GS_L3 unsigned*)(lds + 149504 + 1096); if (en_) { GS_L3 unsigned* a_ = (GS_L3 unsigned*)(lds + 149504 + 1104); a_[(en_ - 1) * 4 + 3] += 1u; } } } while (0)
#else
#define GSUB(i) do {} while (0)
#define GSUBC() do {} while (0)
#endif
    if (!S.next(0, cur)) return;
    f32x4 acc[2][2][4][2];
#pragma unroll
    for (int a = 0; a < 2; ++a)
#pragma unroll
        for (int b = 0; b < 2; ++b)
#pragma unroll
            for (int m = 0; m < 4; ++m)
#pragma unroll
                for (int n = 0; n < 2; ++n) acc[a][b][m][n] = (f32x4){0.f, 0.f, 0.f, 0.f};
    bf16x8 At[4][2], B0[2][2], B1[2][2];
    const char* cA = (const char*)g.A + (size_t)cur.pm * tstep; const char* cB = (const char*)g.Bt + (size_t)cur.pn * tstep;
    S.a_ready(cur);
    if constexpr (SP2) {
        PG8_STAGE(PG8_SB(0, 0), cB, voffB); PG8_STAGE(PG8_SB(0, 1), cB + hstep, voffB); PG8_STAGE(PG8_SA(0, 0), cA, voffA); PG8_STAGE(PG8_SA(0, 1), cA + hstep, voffA);
        if (wr == 1) PG8_BAR;
        PG8_WAIT_V(2); PG8_BAR;
        PG8_STAGE(PG8_SB(1, 0), cB + kstep, voffB); PG8_STAGE(PG8_SA(1, 0), cA + kstep, voffA); PG8_STAGE(PG8_SB(1, 1), cB + hstep + kstep, voffB);
        PG8_WAIT_V(6); PG8_BAR;
    } else {
        PG8_STAGE(PG8_SB(0, 0), cB, voffB); PG8_STAGE(PG8_SA(0, 0), cA, voffA); PG8_STAGE(PG8_SB(0, 1), cB + hstep, voffB); PG8_STAGE(PG8_SA(0, 1), cA + hstep, voffA);
        if (wr == 1) PG8_BAR;
        PG8_WAIT_V(4); PG8_BAR;
        PG8_STAGE(PG8_SB(1, 0), cB + kstep, voffB); PG8_STAGE(PG8_SA(1, 0), cA + kstep, voffA); PG8_STAGE(PG8_SB(1, 1), cB + hstep + kstep, voffB);
        PG8_WAIT_V(6); PG8_BAR;
    }
    for (;;) {
        const bool has_next = S.next(ui + 1, nxt);
        const char* nA = has_next ? (const char*)g.A + (size_t)nxt.pm * tstep : cA; const char* nB = has_next ? (const char*)g.Bt + (size_t)nxt.pn * tstep : cB;
        for (int t = 0; t < nt; t += 2) {
            if constexpr (Epi::HAS_MID) { if (t == (nt >> 1)) E.mid(acc, cur, wr, wc, fr, fq); }
            const bool last = (t == nt - 2);
            const char* a1 = cA + (size_t)(t + 1) * kstep;
            const char* a2 = last ? nA : cA + (size_t)(t + 2) * kstep; const char* b2 = last ? nB : cB + (size_t)(t + 2) * kstep;
            const char* a3 = a2 + kstep; const char* b3 = b2 + kstep;
            if (last && has_next) S.a_ready(nxt);
            if constexpr (SP2) {
            PG8_LDB(B0, 0, 0); PG8_LDB(B1, 0, 1); PG8_SCHED; PG8_LDA(At, 0, 0); PG8_STAGE(PG8_SA(1, 1), a1 + hstep, voffA);
            PG8_WAIT_V(8); PG8_WAIT_L(0); PG8_BAR; PG8_MMA(0, 0, At, B0); PG8_MMA(0, 1, At, B1); PG8_BAR; PG8_SCHED;
            PG8_LDA(At, 0, 1); PG8_STAGE(PG8_SB(0, 0), b2, voffB); PG8_STAGE(PG8_SB(0, 1), b2 + hstep, voffB); PG8_STAGE(PG8_SA(0, 0), a2, voffA);
            PG8_WAIT_V(8); PG8_WAIT_L(0); PG8_BAR; PG8_MMA(1, 0, At, B0); PG8_MMA(1, 1, At, B1); PG8_BAR; PG8_SCHED;
            PG8_LDB(B0, 1, 0); PG8_LDB(B1, 1, 1); PG8_SCHED; PG8_LDA(At, 1, 0); PG8_STAGE(PG8_SA(0, 1), a2 + hstep, voffA);
            PG8_WAIT_V(8); PG8_WAIT_L(0); PG8_BAR; PG8_MMA(0, 0, At, B0); PG8_MMA(0, 1, At, B1); PG8_BAR; PG8_SCHED;
            PG8_LDA(At, 1, 1); PG8_STAGE(PG8_SB(1, 0), b3, voffB); PG8_STAGE(PG8_SB(1, 1), b3 + hstep, voffB); PG8_STAGE(PG8_SA(1, 0), a3, voffA);
            PG8_WAIT_V(8); PG8_WAIT_L(0); PG8_BAR; PG8_MMA(1, 0, At, B0); PG8_MMA(1, 1, At, B1); PG8_BAR; PG8_SCHED;
            if (t == 0) GSUB(0);
            } else {
            PG8_LDB(B0, 0, 0); PG8_SCHED; PG8_LDA(At, 0, 0); PG8_STAGE(PG8_SA(1, 1), a1 + hstep, voffA);
            PG8_WAIT_L(8); PG8_BAR; PG8_WAIT_L(0); PG8_MMA(0, 0, At, B0); PG8_BAR; PG8_SCHED;
            PG8_LDB(B1, 0, 1); PG8_STAGE(PG8_SB(0, 0), b2, voffB);
            PG8_BAR; PG8_WAIT_L(0); PG8_MMA(0, 1, At, B1); PG8_BAR;
            PG8_LDA(At, 0, 1); PG8_STAGE(PG8_SA(0, 0), a2, voffA);
            PG8_BAR; PG8_WAIT_L(0); PG8_MMA(1, 0, At, B0); PG8_BAR; PG8_SCHED;
            PG8_STAGE(PG8_SB(0, 1), b2 + hstep, voffB);
            PG8_WAIT_V(6); PG8_BAR; PG8_MMA(1, 1, At, B1); PG8_BAR;
            PG8_LDB(B0, 1, 0); PG8_SCHED; PG8_LDA(At, 1, 0); PG8_STAGE(PG8_SA(0, 1), a2 + hstep, voffA);
            PG8_WAIT_L(8); PG8_BAR; PG8_WAIT_L(0); PG8_MMA(0, 0, At, B0); PG8_BAR; PG8_SCHED;
            PG8_LDB(B1, 1, 1); PG8_STAGE(PG8_SB(1, 0), b3, voffB);
            PG8_BAR; PG8_WAIT_L(0); PG8_MMA(0, 1, At, B1); PG8_BAR;
            PG8_LDA(At, 1, 1); PG8_STAGE(PG8_SA(1, 0), a3, voffA);
            PG8_BAR; PG8_WAIT_L(0); PG8_MMA(1, 0, At, B0); PG8_BAR; PG8_SCHED;
            PG8_STAGE(PG8_SB(1, 1), b3 + hstep, voffB);
            PG8_WAIT_V(6); PG8_BAR; PG8_MMA(1, 1, At, B1); PG8_BAR;
            }
        }
        GSUB(1);
        if constexpr (ALIGN_EPI) { if (wr == 0) PG8_BAR; }
        if constexpr (!Epi::AFTER_DRAIN) { E(acc, cur, wr, wc, fr, fq); S.done(cur); }
        GSUB(2); GSUBC();
        if (!has_next) break;
#pragma unroll
        for (int a = 0; a < 2; ++a)
#pragma unroll
            for (int b = 0; b < 2; ++b)
#pragma unroll
                for (int m = 0; m < 4; ++m)
#pragma unroll
                    for (int n = 0; n < 2; ++n) acc[a][b][m][n] = (f32x4){0.f, 0.f, 0.f, 0.f};
        cur = nxt; cA = nA; cB = nB; ++ui;
        if constexpr (ALIGN_EPI) { if (wr == 1) PG8_BAR; }
    }
    PG8_WAIT_V(0);
    if constexpr (!ALIGN_EPI) { if (wr == 0) PG8_BAR; }
    PG8_BAR;
    if constexpr (Epi::AFTER_DRAIN) { E.fused(acc, cur, wr, wc, fr, fq, lds, wid, lane); S.done(cur); }
#undef PG8_SA
#undef PG8_SB
#undef PG8_STAGE
#undef PG8_LDA
#undef PG8_LDB
#undef PG8_MMA
#undef PG8_WAIT_V
#undef PG8_WAIT_L
#undef PG8_BAR
#undef PG8_SCHED
}
}
#define GAS __attribute__((address_space(1)))
#define LAS __attribute__((address_space(3)))
typedef unsigned short bf16;
typedef unsigned v4u __attribute__((ext_vector_type(4)));
typedef float f32x4 __attribute__((ext_vector_type(4)));
typedef short bf16x8 __attribute__((ext_vector_type(8)));
typedef GAS unsigned gu32;
typedef GAS unsigned long long gu64;
#define RLX_AGENT __ATOMIC_RELAXED, __HIP_MEMORY_SCOPE_AGENT
#define LDS_WAIT() asm volatile("s_waitcnt lgkmcnt(0)" ::: "memory")
#define VM_WAIT() asm volatile("s_waitcnt vmcnt(0)" ::: "memory")
__device__ __forceinline__ unsigned long long rt() { return __builtin_amdgcn_s_memrealtime(); }
__device__ __forceinline__ unsigned f2bf(float f) { unsigned u = __builtin_bit_cast(unsigned, f); return (u + 0x7fffu + ((u >> 16) & 1u)) >> 16; }
typedef float f32x2_cv __attribute__((ext_vector_type(2))); typedef __bf16 bf16x2_cv __attribute__((ext_vector_type(2)));
__device__ __forceinline__ unsigned pk2(float lo, float hi) { const f32x2_cv v = {lo, hi}; const bf16x2_cv b = __builtin_convertvector(v, bf16x2_cv); return __builtin_bit_cast(unsigned, b); }

#define XB_TMO      128
#define XB_XCNT(j)  (256  + 64 * (j))
#define XB_XSUB(j)  (1280 + 64 * (j))
#define XB_XGEN(j)  (2304 + 64 * (j))
#define XB_TOP      3328
#define XB_TOPGEN   3392
#define XCD_BAR_WORDS 3456
#define XB_SPIN_CAP (1u << 18)

__device__ __forceinline__ unsigned xb_ld(unsigned* p)              { return __hip_atomic_load(p, __ATOMIC_RELAXED, __HIP_MEMORY_SCOPE_AGENT); }
__device__ __forceinline__ unsigned xb_add(unsigned* p, unsigned v) { return __hip_atomic_fetch_add(p, v, __ATOMIC_RELAXED, __HIP_MEMORY_SCOPE_AGENT); }
__device__ __forceinline__ unsigned xb_xcc_id() { return (unsigned)__builtin_amdgcn_s_getreg((3 << 11) | 20) & 0xFu; }
#define XB_SPIN(cond, bar) do { unsigned _sp = 0; while (cond) { __builtin_amdgcn_s_sleep(1); \
    if ((++_sp & 255u) == 0u) { if (xb_ld(&(bar)[XB_TMO])) break; if (_sp > XB_SPIN_CAP) { atomicAdd(&(bar)[XB_TMO], 1u); break; } } } } while (0)

struct XcdBarrier {
    unsigned* bar; unsigned x;
    volatile LAS unsigned* st;
};

__device__ __forceinline__ XcdBarrier xcd_barrier_post(unsigned* bar, volatile LAS unsigned* st) {
    XcdBarrier b; b.bar = bar; b.x = xb_xcc_id(); b.st = st;
    if (threadIdx.x == 0) (void)xb_add(&bar[XB_XCNT(b.x)], 1u);
    return b;
}
__device__ __forceinline__ void xcd_barrier_complete(unsigned* bar, unsigned x, unsigned& nloc, unsigned& nx) {
    const unsigned G = gridDim.x * gridDim.y * gridDim.z;
    unsigned sum, cnt, mine, sp = 0u;
    for (;;) {
        sum = 0u; cnt = 0u; mine = 0u;
#pragma unroll
        for (unsigned j = 0; j < 16; ++j) { const unsigned c = xb_ld(&bar[XB_XCNT(j)]); sum += c; cnt += (c > 0u) ? 1u : 0u; mine = (j == x) ? c : mine; }
        if (sum == G) break;
        __builtin_amdgcn_s_sleep(1);
        if ((++sp & 255u) == 0u) { if (xb_ld(&bar[XB_TMO])) break; if (sp > XB_SPIN_CAP) { atomicAdd(&bar[XB_TMO], 1u); break; } }
    }
    nloc = mine > 0u ? mine : 1u; nx = cnt > 0u ? cnt : 1u;
}

__device__ __forceinline__ void xcd_barrier(const XcdBarrier& b) {
    asm volatile("s_waitcnt vmcnt(0)" ::: "memory");
    __syncthreads();
    if (threadIdx.x == 0) {
        unsigned* bar = b.bar;
        __builtin_amdgcn_s_waitcnt(0);
        unsigned nloc = b.st[0], nx = b.st[1];
        if (nloc == 0u) { xcd_barrier_complete(bar, b.x, nloc, nx); b.st[0] = nloc; b.st[1] = nx; }
        const unsigned old = xb_add(&bar[XB_XSUB(b.x)], 1u);
        const unsigned gen = old / nloc;
        if (old + 1u == (gen + 1u) * nloc) {
            __builtin_amdgcn_fence(__ATOMIC_RELEASE, "agent");
            asm volatile("s_waitcnt vmcnt(0)" ::: "memory");
            const unsigned og = xb_add(&bar[XB_TOP], 1u);
            const unsigned tg = og / nx;
            if (og + 1u == (tg + 1u) * nx) xb_add(&bar[XB_TOPGEN], 1u);
            else XB_SPIN(xb_ld(&bar[XB_TOPGEN]) == tg, bar);
            __builtin_amdgcn_fence(__ATOMIC_ACQUIRE, "agent");
            xb_add(&bar[XB_XGEN(b.x)], 1u);
            asm volatile("s_waitcnt vmcnt(0)" ::: "memory");
        } else {
            XB_SPIN(xb_ld(&bar[XB_XGEN(b.x)]) == gen, bar);
            __builtin_amdgcn_fence(__ATOMIC_ACQUIRE, "agent");
            asm volatile("s_waitcnt vmcnt(0)" ::: "memory");
        }
    }
    __syncthreads();
}
#define WG_SYNC() asm volatile("s_waitcnt lgkmcnt(0)\n\ts_barrier" ::: "memory")
constexpr int NWAVES = 8;
constexpr int DM = 2048, NPR = 8192, NSM = 512, NTOK = 8704, TP = 2048, NB = 4, NDB = 128, TS = 4;
constexpr int NIN = 10496, FF = 5632, FF2 = 11264, ADAW = 12288, NADA = 132;
constexpr int C_QKV = 0, C_Z = 3072, C_DQ = 4096, C_DK = 5120, C_DV = 5376, C_IQ = 5632, C_IK = 6144, C_A = 6208, C_B = 6216, C_IW = 6224, C_G1 = 6400, C_G2 = 8448;
constexpr float NORM_EPS = 1e-6f;
constexpr float QSCALE = 0.08838834764831845f * 1.4426950408889634f;
constexpr float IDX_SCALE = 0.35355339059327373f * 0.125f;
constexpr size_t O_Y = 0, O_KP = 17825792, O_VP = O_KP + 2097152, O_IKP = O_VP + 2097152, O_GSP = O_IKP + 524288, O_GCP = O_GSP + 524288, O_FCP = O_GCP + 36864,
                 O_KS = O_FCP + 90112, O_VS = O_KS + 131072, O_IKS = O_VS + 131072, O_GSS = O_IKS + 32768, O_GCS = O_GSS + 16777216, O_FCS = O_GCS + 1179648, O_END = O_FCS + 2883584;
constexpr size_t MiB = 1u << 20;
constexpr size_t al(size_t x) { return (x + MiB - 1) / MiB * MiB; }
constexpr size_t WS_CTL = 0, CTL_ZERO_BYTES = 1 * MiB;
constexpr size_t WS_ROPE = 1 * MiB;
constexpr size_t WS_ADA  = WS_ROPE + al(2052 * 24 * 8);
constexpr size_t WS_WIN  = WS_ADA + al((size_t)NADA * ADAW * 4);
constexpr size_t WS_WG   = WS_WIN + al((size_t)NIN * DM * 2);
constexpr size_t WS_WD   = WS_WG + al((size_t)DM * 1024 * 2);
constexpr size_t WS_WO   = WS_WD + al((size_t)DM * 1024 * 2);
constexpr size_t WS_WUP  = WS_WO + al((size_t)DM * DM * 2);
constexpr size_t WS_WDN  = WS_WUP + al((size_t)FF2 * DM * 2);
constexpr size_t WS_H    = WS_WDN + al((size_t)DM * FF * 2);
constexpr size_t WS_Y1   = WS_H + al((size_t)NTOK * DM * 2);
constexpr size_t WS_QB   = WS_Y1 + al((size_t)NTOK * NIN * 2);
constexpr size_t WS_KB   = WS_QB + al((size_t)NTOK * 1024 * 2);
constexpr size_t WS_VT   = WS_KB + al((size_t)NTOK * 256 * 2);
constexpr size_t WS_IQ   = WS_VT + al((size_t)NPR * 256 * 2);
constexpr size_t WS_IK   = WS_IQ + al((size_t)NTOK * 512 * 2);
constexpr size_t WS_IW   = WS_IK + al((size_t)NTOK * 64 * 2);
constexpr size_t WS_GCH  = WS_IW + al((size_t)NTOK * 8 * 4);
constexpr size_t GCH_BYTES = 98304, GCH_MS = 0, GCH_BT = 32768, GCH_QE = 65536, GCH_OLT = 81920;
constexpr size_t WS_GE   = WS_GCH + al((size_t)1024 * GCH_BYTES);
constexpr size_t WS_OG   = WS_GE + MiB;
constexpr size_t WS_OD   = WS_OG + al((size_t)NTOK * 1024 * 2);
constexpr size_t WS_MIX  = WS_OD + al((size_t)NTOK * 1024 * 2);
constexpr size_t WS_X1   = WS_MIX + al((size_t)NTOK * DM * 2);
constexpr size_t WS_U    = WS_X1 + al((size_t)NTOK * DM * 4);
constexpr size_t WS_ACT  = WS_U + al((size_t)NTOK * FF2 * 2);
constexpr size_t WS_SCR  = WS_ACT + al((size_t)NTOK * FF * 2);
constexpr size_t WS_SN   = WS_SCR + al((size_t)256 * 32 * 2048 * 4);
constexpr size_t WS_HB   = WS_SN + al((size_t)1024 * 128 * 128 * 2);
constexpr size_t WS_ABF  = WS_HB + al((size_t)128 * 4 * 11264 * 2);
constexpr size_t WS_END  = WS_ABF + al((size_t)144 * 2048 * 2);
constexpr int CW_BAR = 4096;
constexpr int CW_ABF = 12288;
constexpr int CW_QUEUE = 16384;
constexpr int RING_OFF = 0, RING_BYTES = 131072;
constexpr int P2_DEFER = 1024;
constexpr int LDSCTL_OFF = 149504, MISC_OFF = LDSCTL_OFF + 320;
constexpr int LDS_BYTES = 151552;

struct Args {
    const float* in[28]; float* out; unsigned char* ws;
    double invf[24];
    int ph_lo, ph_hi;
};
struct Frame {
    LAS unsigned char* lds;
    gu32* ctl;
    int tid, lane, wave, G, bid;
};
typedef unsigned short bf16;
typedef unsigned u32x2v __attribute__((ext_vector_type(2)));
typedef float f32x2v __attribute__((ext_vector_type(2)));
__device__ __forceinline__ float wave_sum(float v) {
#pragma unroll
    for (int o = 1; o < 64; o <<= 1) v += __shfl_xor(v, o);
    return v;
}
__device__ __forceinline__ float xh_sum(float v) { auto rr = __builtin_amdgcn_permlane32_swap(__float_as_uint(v), __float_as_uint(v), false, false); return __uint_as_float(rr[0]) + __uint_as_float(rr[1]); }
__device__ __forceinline__ float xh_max(float v) { auto rr = __builtin_amdgcn_permlane32_swap(__float_as_uint(v), __float_as_uint(v), false, false); return fmaxf(__uint_as_float(rr[0]), __uint_as_float(rr[1])); }
__device__ __forceinline__ float bf2f(unsigned short b) { return __uint_as_float(((unsigned)b) << 16); }
__device__ __forceinline__ float bflo(unsigned w) { return __uint_as_float(w << 16); }
__device__ __forceinline__ float bfhi(unsigned w) { return __uint_as_float(w & 0xffff0000u); }
__device__ __forceinline__ float silu_f(float x) { return x * __builtin_amdgcn_rcpf(1.0f + __expf(-x)); }
__device__ __forceinline__ float sigm_f(float x) { return __builtin_amdgcn_rcpf(1.0f + __expf(-x)); }
__device__ __forceinline__ f32x4 mfma16(bf16x8 a, bf16x8 b, f32x4 c) { return __builtin_amdgcn_mfma_f32_16x16x32_bf16(a, b, c, 0, 0, 0); }
__device__ __forceinline__ int ada_row(int m) { return m < NPR ? (m >> 11) : 4 + ((m - NPR) >> 2); }

__device__ __forceinline__ void p0_silu(Frame& F, const float* c_prompt, const float* c_sample, bf16* ABF, unsigned* cnt) {
    for (int r = F.bid; r < 144; r += F.G) {
        const float* rp = (r < 4) ? c_prompt + (size_t)r * DM : c_sample + (size_t)(r - 4) * DM;
        f32x4 v = (f32x4){0.f, 0.f, 0.f, 0.f};
        if (r < NADA) v = *(const GAS f32x4*)(rp + 4 * F.tid);
        u32x2v o; o.x = (r < NADA) ? pk2(silu_f(v.x), silu_f(v.y)) : 0u; o.y = (r < NADA) ? pk2(silu_f(v.z), silu_f(v.w)) : 0u;
        *(GAS u32x2v*)(ABF + (size_t)r * DM + 4 * F.tid) = o;
        asm volatile("s_waitcnt vmcnt(0)" ::: "memory");
        __syncthreads();
        if (F.tid == 0) {
            __builtin_amdgcn_fence(__ATOMIC_RELEASE, "agent");
            asm volatile("s_waitcnt vmcnt(0)" ::: "memory");
            (void)xb_add(cnt, 1u);
        }
    }
}
__device__ __forceinline__ void p0_ada(Frame& F, const bf16* ABF, unsigned* cnt, unsigned* tmo, const float* w_ada, const float* b_ada, float* ADA) {
    LAS bf16* Bs = (LAS bf16*)(F.lds);
    const int tid = F.tid, lane = F.lane, w = F.wave;
    if (tid == 0) {
        XB_SPIN(xb_ld(cnt) < 144u, tmo);
        __builtin_amdgcn_fence(__ATOMIC_ACQUIRE, "agent");
        asm volatile("s_waitcnt vmcnt(0)" ::: "memory");
    }
    __syncthreads();
    for (int j = F.bid; j < 256; j += F.G) {
        const int n0 = 48 * j;
        f32x4 acc[2][3];
#pragma unroll
        for (int a = 0; a < 2; ++a)
#pragma unroll
            for (int b = 0; b < 3; ++b) acc[a][b] = (f32x4){0.f, 0.f, 0.f, 0.f};
        f32x4 vb[7]; v4u pa[9];
        const unsigned boff = (unsigned)((tid / 12) * ADAW + (tid % 12) * 4);
        const int bkk = tid / 12, bn4 = tid % 12;
        LAS bf16* As = (LAS bf16*)(F.lds + 25344);
        const bf16* ap0 = ABF + (size_t)(tid >> 5) * DM + 8 * (tid & 31);
#define ADA_LOAD(k0_) do { \
        _Pragma("unroll") for (int i = 0; i < 6; ++i) vb[i] = (tid < 504) ? *(const GAS f32x4*)(w_ada + (size_t)((k0_) + 42 * i) * ADAW + n0 + boff) : (f32x4){0.f, 0.f, 0.f, 0.f}; \
        vb[6] = (tid < 48) ? *(const GAS f32x4*)(w_ada + (size_t)((k0_) + 252) * ADAW + n0 + boff) : (f32x4){0.f, 0.f, 0.f, 0.f}; \
        _Pragma("unroll") for (int i = 0; i < 9; ++i) pa[i] = *(const GAS v4u*)(ap0 + (size_t)(16 * i) * DM + (k0_)); } while (0)
        ADA_LOAD(0);
        for (int kc = 0; kc < 8; ++kc) {
            const int k0 = 256 * kc;
            WG_SYNC();
#pragma unroll
            for (int i = 0; i < 7; ++i) { const int kk = bkk + 42 * i;
                if ((i < 6 && tid < 504) || (i == 6 && tid < 48)) {
                    Bs[(4 * bn4 + 0) * 264 + kk] = (bf16)f2bf(vb[i].x); Bs[(4 * bn4 + 1) * 264 + kk] = (bf16)f2bf(vb[i].y);
                    Bs[(4 * bn4 + 2) * 264 + kk] = (bf16)f2bf(vb[i].z); Bs[(4 * bn4 + 3) * 264 + kk] = (bf16)f2bf(vb[i].w); } }
#pragma unroll
            for (int i = 0; i < 9; ++i) *(LAS v4u*)(As + ((tid >> 5) + 16 * i) * 264 + 8 * (tid & 31)) = pa[i];
            if (kc < 7) ADA_LOAD(k0 + 256);
            WG_SYNC();
#pragma unroll
            for (int kh = 0; kh < 4; ++kh) {
                bf16x8 fb[3][2];
#pragma unroll
                for (int nt = 0; nt < 3; ++nt)
#pragma unroll
                    for (int k4 = 0; k4 < 2; ++k4) fb[nt][k4] = *(const LAS bf16x8*)(Bs + (nt * 16 + (lane & 15)) * 264 + (2 * kh + k4) * 32 + 8 * (lane >> 4));
                bf16x8 fa0[2];
#pragma unroll
                for (int k4 = 0; k4 < 2; ++k4) fa0[k4] = *(const LAS bf16x8*)(As + (w * 16 + (lane & 15)) * 264 + (2 * kh + k4) * 32 + 8 * (lane >> 4));
                __builtin_amdgcn_sched_barrier(0);
#pragma unroll
                for (int k4 = 0; k4 < 2; ++k4)
#pragma unroll
                    for (int nt = 0; nt < 3; ++nt) acc[0][nt] = mfma16(fa0[k4], fb[nt][k4], acc[0][nt]);
                if (w == 0) {
                    bf16x8 fa1[2];
#pragma unroll
                    for (int k4 = 0; k4 < 2; ++k4) fa1[k4] = *(const LAS bf16x8*)(As + (128 + (lane & 15)) * 264 + (2 * kh + k4) * 32 + 8 * (lane >> 4));
#pragma unroll
                    for (int k4 = 0; k4 < 2; ++k4)
#pragma unroll
                        for (int nt = 0; nt < 3; ++nt) acc[1][nt] = mfma16(fa1[k4], fb[nt][k4], acc[1][nt]);
                }
            }
        }
#pragma unroll
        for (int mi = 0; mi < 2; ++mi) {
            const int mt = w + 8 * mi;
            if (mt < 9) {
#pragma unroll
                for (int nt = 0; nt < 3; ++nt) {
                    const int col = n0 + nt * 16 + (lane & 15); const float bb = b_ada[col];
#pragma unroll
                    for (int r = 0; r < 4; ++r) { const int row = mt * 16 + 4 * (lane >> 4) + r; if (row < NADA) ADA[(size_t)row * ADAW + col] = acc[mi][nt][r] + bb; }
                }
            }
        }
    }
#undef ADA_LOAD
    WG_SYNC();
}
template <class Map>
__device__ __forceinline__ void transpose_item(const float* W, int K, int N, bf16* WT, LAS float* scr, int kb, int nb, int lane, const Map& map) {
    const int k0 = 64 * kb, n0 = 64 * nb;
    const int src = map(n0 + 4 * (lane & 15));
    f32x4 v[16];
#pragma unroll
    for (int i = 0; i < 16; ++i) { const int kk = 4 * i + (lane >> 4); v[i] = (src >= 0) ? *(const GAS f32x4*)(W + (size_t)(k0 + kk) * N + src) : (f32x4){0.f, 0.f, 0.f, 0.f}; }
#pragma unroll
    for (int i = 0; i < 16; ++i) { const int kk = 4 * i + (lane >> 4); LAS float* d = scr + kk * 65 + 4 * (lane & 15); d[0] = v[i].x; d[1] = v[i].y; d[2] = v[i].z; d[3] = v[i].w; }
    LDS_WAIT(); asm volatile("" ::: "memory");
    const int c = lane & 7;
#pragma unroll
    for (int j = 0; j < 8; ++j) { const int n = (lane >> 3) + 8 * j; const LAS float* s = scr + (8 * c) * 65 + n;
        v4u o; o.x = pk2(s[0 * 65], s[1 * 65]); o.y = pk2(s[2 * 65], s[3 * 65]); o.z = pk2(s[4 * 65], s[5 * 65]); o.w = pk2(s[6 * 65], s[7 * 65]);
        *(GAS v4u*)(WT + (size_t)(n0 + n) * K + k0 + 8 * c) = o; }
    LDS_WAIT(); asm volatile("" ::: "memory");
}
struct MapIn { __device__ __forceinline__ int operator()(int n) const {
    if (n < 4096) return n; if (n < 6208) return n + 16; if (n < 6224) return n - 6208 + 4096; if (n < 6232) return n; if (n < 6400) return -1; return n - 168; } };
struct MapId { __device__ __forceinline__ int operator()(int n) const { return n; } };
struct MapUp { __device__ __forceinline__ int operator()(int n) const { return ((n >> 7) & 1) * 5632 + (n >> 8) * 128 + (n & 127); } };
template <class Map>
__device__ __forceinline__ void transpose_all(Frame& F, const float* W, int K, int N, int Nd, bf16* WT, const Map& map) {
    LAS float* scr = (LAS float*)(F.lds + RING_OFF + F.wave * 16640);
    const int gw = F.bid * NWAVES + F.wave, NGW = F.G * NWAVES;
    const int nblk = Nd / 64, items = (K / 64) * nblk;
    for (int it = gw; it < items; it += NGW) transpose_item(W, K, N, WT, scr, it / nblk, it % nblk, F.lane, map);
}
__device__ __forceinline__ void p0_rope(Frame& F, const Args& args, f32x2v* ROPE) {
    const int gt = F.bid * 512 + F.tid, NT = F.G * 512;
    for (int i = gt; i < 2052 * 24; i += NT) {
        const int pos = i / 24, f = i % 24;
        double rev = (double)pos * args.invf[f] * 0.15915494309189535;
        rev -= __builtin_floor(rev);
        const float r = (float)rev;
        ROPE[i] = (f32x2v){__builtin_amdgcn_cosf(r), __builtin_amdgcn_sinf(r)};
    }
}
__device__ __forceinline__ void norm_mod_row(const float* xrow, const float* g, const float* sh, const float* sc, bf16* orow, int lane) {
    const GAS f32x4* xr = (const GAS f32x4*)xrow + lane;
    f32x4 v[8], gg[8], s1[8], s0[8]; float s = 0.f;
#pragma unroll
    for (int j = 0; j < 8; ++j) v[j] = xr[64 * j];
#pragma unroll
    for (int j = 0; j < 8; ++j) { const int idx = 4 * lane + 256 * j; gg[j] = *(const GAS f32x4*)(g + idx); s1[j] = *(const GAS f32x4*)(sc + idx); s0[j] = *(const GAS f32x4*)(sh + idx); }
#pragma unroll
    for (int j = 0; j < 8; ++j) s += (v[j].x * v[j].x + v[j].y * v[j].y) + (v[j].z * v[j].z + v[j].w * v[j].w);
    const float rstd = __builtin_amdgcn_rsqf(wave_sum(s) * (1.0f / DM) + NORM_EPS);
    GAS u32x2v* o8 = (GAS u32x2v*)orow + lane;
#pragma unroll
    for (int j = 0; j < 8; ++j) {
        const f32x4 y = v[j] * rstd * gg[j] * (s1[j] + 1.0f) + s0[j];
        u32x2v o; o.x = pk2(y.x, y.y); o.y = pk2(y.z, y.w); o8[64 * j] = o;
    }
}
template <bool XBF, class XRow>
__device__ __forceinline__ void norm_mod_pass(Frame& F, const XRow& xrow, const float* g, const float* ADA, int sh_off, int sc_off, bf16* O) {
    int tid = F.tid; asm volatile("" : "+v"(tid));
    const int lane = tid & 63, w = __builtin_amdgcn_readfirstlane(tid >> 6), NGW = F.G * NWAVES;
    LAS float* Gs = (LAS float*)F.lds;
    LAS float* Sh = Gs + 2048;
    LAS float* Sc = Sh + 4096;
#define NM_LOAD(mb_, v_, st_) do { const int m_ = (mb_) + w; \
        if constexpr (XBF) { const GAS v4u* xr_ = (const GAS v4u*)xrow(m_ < NTOK ? m_ : NTOK - 1) + lane; \
          _Pragma("unroll") for (int jj = 0; jj < 4; ++jj) { const v4u t_ = xr_[64 * jj]; v_[2 * jj] = (f32x4){bflo(t_.x), bfhi(t_.x), bflo(t_.y), bfhi(t_.y)}; v_[2 * jj + 1] = (f32x4){bflo(t_.z), bfhi(t_.z), bflo(t_.w), bfhi(t_.w)}; } } \
        else { const GAS f32x4* xr_ = (const GAS f32x4*)xrow(m_ < NTOK ? m_ : NTOK - 1) + lane; \
          _Pragma("unroll") for (int j = 0; j < 8; ++j) v_[j] = xr_[64 * j]; } \
        const int r0_ = ada_row(mb_), r1_ = ada_row((mb_) + 4 < NTOK ? (mb_) + 4 : NTOK - 1); \
        st_[0] = *(const GAS f32x4*)(ADA + (size_t)r0_ * ADAW + sh_off + 4 * tid); st_[1] = *(const GAS f32x4*)(ADA + (size_t)r1_ * ADAW + sh_off + 4 * tid); \
        st_[2] = *(const GAS f32x4*)(ADA + (size_t)r0_ * ADAW + sc_off + 4 * tid); st_[3] = *(const GAS f32x4*)(ADA + (size_t)r1_ * ADAW + sc_off + 4 * tid); } while (0)
    f32x4 v[8], st[4];
    WG_SYNC();
    *(LAS f32x4*)(Gs + 4 * tid) = *(const GAS f32x4*)(g + 4 * tid);
    if (8 * F.bid < NTOK) NM_LOAD(8 * F.bid, v, st);
#pragma unroll 1
    for (int mb = 8 * F.bid; mb < NTOK; mb += NGW) {
        const int m = mb + w;
        WG_SYNC();
        *(LAS f32x4*)(Sh + 4 * tid) = st[0]; *(LAS f32x4*)(Sh + 2048 + 4 * tid) = st[1]; *(LAS f32x4*)(Sc + 4 * tid) = st[2]; *(LAS f32x4*)(Sc + 2048 + 4 * tid) = st[3];
        WG_SYNC();
        f32x4 nv[8], nst[4];
        const bool more = mb + NGW < NTOK;
        if (more) NM_LOAD(mb + NGW, nv, nst);
        __builtin_amdgcn_sched_barrier(0);
        if (m < NTOK) {
            const LAS float* sh = Sh + (w >> 2) * 2048; const LAS float* sc = Sc + (w >> 2) * 2048;
            float s = 0.f;
#pragma unroll
            for (int j = 0; j < 8; ++j) s += (v[j].x * v[j].x + v[j].y * v[j].y) + (v[j].z * v[j].z + v[j].w * v[j].w);
            const float rstd = __builtin_amdgcn_rsqf(wave_sum(s) * (1.0f / DM) + NORM_EPS);
#pragma unroll
            for (int j = 0; j < 8; ++j) {
                const int idx = XBF ? 8 * lane + 512 * (j >> 1) + 4 * (j & 1) : 4 * lane + 256 * j;
                const f32x4 gg = *(const LAS f32x4*)(Gs + idx), s1 = *(const LAS f32x4*)(sc + idx), s0 = *(const LAS f32x4*)(sh + idx);
                const f32x4 y = v[j] * rstd * gg * (s1 + 1.0f) + s0;
                u32x2v o; o.x = pk2(y.x, y.y); o.y = pk2(y.z, y.w); *(GAS u32x2v*)(O + (size_t)m * DM + idx) = o;
            }
        }
        if (more) {
#pragma unroll
            for (int j = 0; j < 8; ++j) v[j] = nv[j];
#pragma unroll
            for (int j = 0; j < 4; ++j) st[j] = nst[j];
        }
    }
#undef NM_LOAD
    WG_SYNC();
}
template <bool SPLIT2 = false, class Epi>
__device__ __forceinline__ void small_gemm(Frame& F, const bf16* A, int lda, const bf16* Bt, int K, const Epi& epi) {
    int tid = F.tid; asm volatile("" : "+v"(tid));
    const int lane = tid & 63, w = __builtin_amdgcn_readfirstlane(tid >> 6), l15 = lane & 15, g4 = lane >> 4;
    LAS float* red = (LAS float*)F.lds;
    const int kw = K >> 3, nks = kw >> 5;
    for (int tile = F.bid; tile < 256; tile += F.G) {
        const int tm = tile >> 5, tn = tile & 31;
        const bf16* ap = A + (size_t)(64 * tm + l15) * lda + w * kw + 16 * g4;
        const bf16* bp = Bt + (size_t)(64 * tn + l15) * K + w * kw + 16 * g4;
        f32x4 acc[4][4];
#pragma unroll
        for (int i = 0; i < 4; ++i)
#pragma unroll
            for (int j = 0; j < 4; ++j) acc[i][j] = (f32x4){0.f, 0.f, 0.f, 0.f};
        {
            LAS unsigned char* wl = F.lds + w * 18432;
            const int lr = lane >> 3, lc = lane & 7;
            const bf16* apc = A + (size_t)(64 * tm + lr) * lda + w * kw + 8 * lc;
            const bf16* bpc = Bt + (size_t)(64 * tn + lr) * K + w * kw + 8 * lc;
            const int nd = nks >> 1;
            v4u la[8], lb[8];
#pragma unroll
            for (int i = 0; i < 8; ++i) { la[i] = *(const GAS v4u*)(apc + (size_t)(8 * i) * lda); lb[i] = *(const GAS v4u*)(bpc + (size_t)(8 * i) * K); }
            WG_SYNC();
#pragma unroll 1
            for (int d = 0; d < nd; ++d) {
#pragma unroll
                for (int i = 0; i < 8; ++i) { *(LAS v4u*)(wl + (8 * i + lr) * 144 + 16 * lc) = la[i]; *(LAS v4u*)(wl + 9216 + (8 * i + lr) * 144 + 16 * lc) = lb[i]; }
                if (d + 1 < nd) {
#pragma unroll
                    for (int i = 0; i < 8; ++i) { la[i] = *(const GAS v4u*)(apc + (size_t)(8 * i) * lda + 64 * (d + 1)); lb[i] = *(const GAS v4u*)(bpc + (size_t)(8 * i) * K + 64 * (d + 1)); }
                }
#pragma unroll
                for (int sst = 0; sst < 2; ++sst) {
                    bf16x8 fa[4], fbq[4];
#pragma unroll
                    for (int i = 0; i < 4; ++i) { fa[i] = *(const LAS bf16x8*)(wl + (16 * i + l15) * 144 + 64 * sst + 16 * g4); fbq[i] = *(const LAS bf16x8*)(wl + 9216 + (16 * i + l15) * 144 + 64 * sst + 16 * g4); }
                    __builtin_amdgcn_sched_barrier(0);
#pragma unroll
                    for (int i = 0; i < 4; ++i)
#pragma unroll
                        for (int j = 0; j < 4; ++j) acc[i][j] = mfma16(fa[i], fbq[j], acc[i][j]);
                }
            }
        }
        WG_SYNC();
#pragma unroll
        for (int i = 0; i < 4; ++i)
#pragma unroll
            for (int j = 0; j < 4; ++j)
#pragma unroll
                for (int r = 0; r < 4; ++r) red[(w * 64 + 16 * i + 4 * g4 + r) * 64 + 16 * j + l15] = acc[i][j][r];
        WG_SYNC();
        { const int row = tid >> 3, c0 = (tid & 7) * 8;
          const int grow = 64 * tm + row, gcol = 64 * tn + c0;
          if constexpr (!SPLIT2) {
              f32x4 s0 = (f32x4){0.f, 0.f, 0.f, 0.f}, s1 = s0;
#pragma unroll
              for (int ww = 0; ww < 8; ++ww) { s0 += *(const LAS f32x4*)(red + (ww * 64 + row) * 64 + c0); s1 += *(const LAS f32x4*)(red + (ww * 64 + row) * 64 + c0 + 4); }
              epi(grow, gcol, s0, s1);
          } else {
              f32x4 a0 = (f32x4){0.f, 0.f, 0.f, 0.f}, a1 = a0, b0 = a0, b1 = a0;
#pragma unroll
              for (int ww = 0; ww < 4; ++ww) { a0 += *(const LAS f32x4*)(red + (ww * 64 + row) * 64 + c0); a1 += *(const LAS f32x4*)(red + (ww * 64 + row) * 64 + c0 + 4);
                  b0 += *(const LAS f32x4*)(red + ((ww + 4) * 64 + row) * 64 + c0); b1 += *(const LAS f32x4*)(red + ((ww + 4) * 64 + row) * 64 + c0 + 4); }
              epi(grow, gcol, a0, a1, b0, b1);
          } }
    }
    WG_SYNC();
}
__device__ __forceinline__ void unpack8(const v4u w, float (&f)[8]) {
    f[0] = bflo(w.x); f[1] = bfhi(w.x); f[2] = bflo(w.y); f[3] = bfhi(w.y); f[4] = bflo(w.z); f[5] = bfhi(w.z); f[6] = bflo(w.w); f[7] = bfhi(w.w); }
struct P3Bufs { const bf16* Y1; const f32x2v* ROPE; bf16 *QB, *KB, *IQ, *IK; float* IW; float* out; };
template <int HC>
__device__ __forceinline__ void rot_apply8(int dc, const f32x2v* cs8, const v4u vw, const v4u pw, float (&v)[8]) {
    unpack8(vw, v);
    if (dc < 2 * HC) {
        float p[8]; unpack8(pw, p);
        const bool first = dc < HC;
#pragma unroll
        for (int e = 0; e < 8; ++e) { const f32x2v cs = cs8[e]; v[e] = first ? v[e] * cs.x - p[e] * cs.y : v[e] * cs.x + p[e] * cs.y; }
    }
}
__device__ __forceinline__ v4u pack8(const float (&v)[8]) { return (v4u){pk2(v[0], v[1]), pk2(v[2], v[3]), pk2(v[4], v[5]), pk2(v[6], v[7])}; }
__device__ __forceinline__ void p3_rot_row(const P3Bufs& P, int m, int lane) {
    asm volatile("" : "+v"(lane));
    const bf16* y = P.Y1 + (size_t)m * NIN;
    const bool pr = m < NPR;
    const int pos = pr ? (m & (TP - 1)) : TP + ((m - NPR) & 3);
    const f32x2v* rp = P.ROPE + pos * 24;
    float* kout = pr ? P.out + O_KP + (size_t)m * 256 : P.out + O_KS + (size_t)(m - NPR) * 256;
    float* vout = pr ? P.out + O_VP + (size_t)m * 256 : P.out + O_VS + (size_t)(m - NPR) * 256;
    float* ikout = pr ? P.out + O_IKP + (size_t)m * 64 : P.out + O_IKS + (size_t)(m - NPR) * 64;
    const int c0 = lane, c1 = lane + 64, ck = lane & 31;
    const v4u q0 = *(const GAS v4u*)(y + C_DQ + 8 * c0), q0p = *(const GAS v4u*)(y + C_DQ + 8 * (c0 ^ 2)), q1 = *(const GAS v4u*)(y + C_DQ + 8 * c1), q1p = *(const GAS v4u*)(y + C_DQ + 8 * (c1 ^ 2));
    const v4u kv = *(const GAS v4u*)(y + (lane < 32 ? C_DK : C_DV) + 8 * ck), kvp = *(const GAS v4u*)(y + (lane < 32 ? C_DK : C_DV) + 8 * (ck ^ 2));
    const v4u iqv = *(const GAS v4u*)(y + C_IQ + 8 * c0), iqp = *(const GAS v4u*)(y + C_IQ + 8 * (c0 ^ 1));
    const v4u ikv = *(const GAS v4u*)(y + C_IK + 8 * (lane & 7)), ikp = *(const GAS v4u*)(y + C_IK + 8 * ((lane & 7) ^ 1)), iwv = *(const GAS v4u*)(y + C_IW);
    f32x2v csA[8], csB[8];
#pragma unroll
    for (int e = 0; e < 8; ++e) { csA[e] = rp[8 * (c0 & 1) + e]; csB[e] = rp[16 + e]; }
    float v[8];
    rot_apply8<2>(c0 & 15, csA, q0, q0p, v);
#pragma unroll
    for (int e = 0; e < 8; ++e) v[e] *= QSCALE;
    *(GAS v4u*)(P.QB + (size_t)m * 1024 + 8 * c0) = pack8(v);
    rot_apply8<2>(c1 & 15, csA, q1, q1p, v);
#pragma unroll
    for (int e = 0; e < 8; ++e) v[e] *= QSCALE;
    *(GAS v4u*)(P.QB + (size_t)m * 1024 + 8 * c1) = pack8(v);
    if (lane < 32) {
        rot_apply8<2>(ck & 15, csA, kv, kvp, v);
        *(GAS v4u*)(P.KB + (size_t)m * 256 + 8 * ck) = pack8(v);
        *(f32x4*)(kout + 8 * ck) = (f32x4){v[0], v[1], v[2], v[3]}; *(f32x4*)(kout + 8 * ck + 4) = (f32x4){v[4], v[5], v[6], v[7]};
    } else {
        unpack8(kv, v);
        *(f32x4*)(vout + 8 * ck) = (f32x4){v[0], v[1], v[2], v[3]}; *(f32x4*)(vout + 8 * ck + 4) = (f32x4){v[4], v[5], v[6], v[7]};
    }
    rot_apply8<1>(c0 & 7, csB, iqv, iqp, v);
    *(GAS v4u*)(P.IQ + (size_t)m * 512 + 8 * c0) = pack8(v);
    if (lane < 8) {
        rot_apply8<1>(lane, csB, ikv, ikp, v);
        *(GAS v4u*)(P.IK + (size_t)m * 64 + 8 * lane) = pack8(v);
        *(f32x4*)(ikout + 8 * lane) = (f32x4){v[0], v[1], v[2], v[3]}; *(f32x4*)(ikout + 8 * lane + 4) = (f32x4){v[4], v[5], v[6], v[7]};
    } else if (lane == 8) {
        unpack8(iwv, v);
        *(f32x4*)(P.IW + (size_t)m * 8) = (f32x4){v[0], v[1], v[2], v[3]} * IDX_SCALE; *(f32x4*)(P.IW + (size_t)m * 8 + 4) = (f32x4){v[4], v[5], v[6], v[7]} * IDX_SCALE;
    }
    int crow = -1; float* cout = nullptr;
    if (pr) { const int t = m & (TP - 1); if (t >= TP - 3) { crow = t - (TP - 3); cout = P.out + O_GCP + (size_t)((m >> 11) * 3 + crow) * 3072; } }
    else { const int ts = (m - NPR) & 3; if (ts >= 1) { crow = ts - 1; cout = P.out + O_GCS + (size_t)(((m - NPR) >> 2) * 3 + crow) * 3072; } }
    if (crow >= 0) {
#pragma unroll
        for (int i = 0; i < 6; ++i) { const int c = lane + 64 * i; unpack8(*(const GAS v4u*)(y + C_QKV + 8 * c), v);
            *(f32x4*)(cout + 8 * c) = (f32x4){v[0], v[1], v[2], v[3]}; *(f32x4*)(cout + 8 * c + 4) = (f32x4){v[4], v[5], v[6], v[7]}; }
    }
}
__device__ __forceinline__ void p3_vt(Frame& F, const bf16* Y1, bf16* VT) {
    LAS bf16* T = (LAS bf16*)F.lds;
    for (int it = F.bid; it < 256; it += F.G) {
        const int b = it >> 6, kvh = (it >> 5) & 1, tt = it & 31;
        WG_SYNC();
        { const int t = F.tid >> 3, c = F.tid & 7;
          const bf16* src = Y1 + (size_t)(b * TP + tt * 64 + t) * NIN + C_DV + kvh * 128 + c * 16;
          const v4u a = *(const GAS v4u*)src, bq = *(const GAS v4u*)(src + 8);
          LAS unsigned* dst = (LAS unsigned*)(T + t * 130 + c * 16);
          dst[0] = a.x; dst[1] = a.y; dst[2] = a.z; dst[3] = a.w; dst[4] = bq.x; dst[5] = bq.y; dst[6] = bq.z; dst[7] = bq.w; }
        WG_SYNC();
        { const int d = F.tid >> 2, q = F.tid & 3;
          unsigned w[8];
#pragma unroll
          for (int e = 0; e < 8; ++e) w[e] = (unsigned)T[(q * 16 + 2 * e) * 130 + d] | ((unsigned)T[(q * 16 + 2 * e + 1) * 130 + d] << 16);
          bf16* dst = VT + ((size_t)((b * 2 + kvh) * 128 + d)) * TP + tt * 64 + q * 16;
          *(GAS v4u*)dst = (v4u){w[0], w[1], w[2], w[3]}; *(GAS v4u*)(dst + 8) = (v4u){w[4], w[5], w[6], w[7]}; }
    }
    WG_SYNC();
}
__device__ __forceinline__ void p9_conv(Frame& F, const bf16* U, const float* state_ffn, const float* wc, const float* bc, bf16* ACT, float* out) {
    const int gw = F.bid * NWAVES + F.wave, NGW = F.G * NWAVES, lane = F.lane;
    for (int it = gw; it < 128 * 11; it += NGW) {
        const int sq = it / 11, ci = it % 11, j0 = ci * 512 + lane * 8, m0 = NPR + 4 * sq;
        v4u ug[4], uv[4];
#pragma unroll
        for (int q = 0; q < 4; ++q) { ug[q] = *(const GAS v4u*)(U + (size_t)(m0 + q) * FF2 + j0); uv[q] = *(const GAS v4u*)(U + (size_t)(m0 + q) * FF2 + FF + j0); }
        const float* sb = state_ffn + (size_t)sq * 2 * FF2 + j0;
        f32x4 sg[2][2], sv[2][2];
#pragma unroll
        for (int r = 0; r < 2; ++r) { sg[r][0] = *(const GAS f32x4*)(sb + (size_t)r * FF2); sg[r][1] = *(const GAS f32x4*)(sb + (size_t)r * FF2 + 4);
            sv[r][0] = *(const GAS f32x4*)(sb + (size_t)r * FF2 + FF); sv[r][1] = *(const GAS f32x4*)(sb + (size_t)r * FF2 + FF + 4); }
        float wgt[8][8];
#pragma unroll
        for (int q = 0; q < 8; ++q) { const float* src = (q & 3) == 3 ? bc + (q >> 2) * FF + j0 : wc + (size_t)(q & 3) * FF2 + (q >> 2) * FF + j0;
            const f32x4 lo = *(const GAS f32x4*)src, hi = *(const GAS f32x4*)(src + 4);
            wgt[q][0] = lo.x; wgt[q][1] = lo.y; wgt[q][2] = lo.z; wgt[q][3] = lo.w; wgt[q][4] = hi.x; wgt[q][5] = hi.y; wgt[q][6] = hi.z; wgt[q][7] = hi.w; }
        float g2[8], g1[8], v2[8], v1[8];
#pragma unroll
        for (int e = 0; e < 4; ++e) { g2[e] = sg[0][0][e]; g2[4 + e] = sg[0][1][e]; g1[e] = sg[1][0][e]; g1[4 + e] = sg[1][1][e];
            v2[e] = sv[0][0][e]; v2[4 + e] = sv[0][1][e]; v1[e] = sv[1][0][e]; v1[4 + e] = sv[1][1][e]; }
#pragma unroll
        for (int q = 0; q < 4; ++q) {
            float g0[8], v0[8], a[8];
            unpack8(ug[q], g0); unpack8(uv[q], v0);
#pragma unroll
            for (int e = 0; e < 8; ++e) {
                const float gg = wgt[3][e] + wgt[0][e] * g2[e] + wgt[1][e] * g1[e] + wgt[2][e] * g0[e];
                const float vv = wgt[7][e] + wgt[4][e] * v2[e] + wgt[5][e] * v1[e] + wgt[6][e] * v0[e];
                a[e] = silu_f(gg) * vv;
            }
            *(GAS v4u*)(ACT + (size_t)(m0 + q) * FF + j0) = (v4u){pk2(a[0], a[1]), pk2(a[2], a[3]), pk2(a[4], a[5]), pk2(a[6], a[7])};
            if (q >= 2) {
                float* co = out + O_FCS + (size_t)(sq * 2 + (q - 2)) * FF2;
                *(f32x4*)(co + j0) = (f32x4){g0[0], g0[1], g0[2], g0[3]}; *(f32x4*)(co + j0 + 4) = (f32x4){g0[4], g0[5], g0[6], g0[7]};
                *(f32x4*)(co + FF + j0) = (f32x4){v0[0], v0[1], v0[2], v0[3]}; *(f32x4*)(co + FF + j0 + 4) = (f32x4){v0[4], v0[5], v0[6], v0[7]};
            }
#pragma unroll
            for (int e = 0; e < 8; ++e) { g2[e] = g1[e]; g1[e] = g0[e]; v2[e] = v1[e]; v1[e] = v0[e]; }
        }
    }
}
__device__ __forceinline__ void p10_fixup(Frame& F, const bf16* HB, const float* wc, const float* bc, bf16* ACT, float* out) {
    const int gw = F.bid * NWAVES + F.wave, NGW = F.G * NWAVES, lane = F.lane;
    for (int it = (gw >= 1408) ? gw - 1408 : gw + (NGW - 1408); it < 128 * 11; it += NGW) {
        const int blk = it / 11, ci = it % 11, j0 = ci * 512 + lane * 8;
        const bf16* hb = HB + (size_t)blk * 4 * FF2 + j0;
        float g[4][8], v[4][8];
        const bool first = (blk & 31) == 0;
#pragma unroll
        for (int s = 0; s < 2; ++s) {
            if (first) {
#pragma unroll
                for (int e = 0; e < 8; ++e) { g[s][e] = 0.f; v[s][e] = 0.f; }
            } else { unpack8(*(const GAS v4u*)(hb - (size_t)4 * FF2 + (size_t)s * FF2), g[s]); unpack8(*(const GAS v4u*)(hb - (size_t)4 * FF2 + (size_t)s * FF2 + FF), v[s]); }
            unpack8(*(const GAS v4u*)(hb + (size_t)(2 + s) * FF2), g[2 + s]); unpack8(*(const GAS v4u*)(hb + (size_t)(2 + s) * FF2 + FF), v[2 + s]);
        }
        float a0[8], a1[8];
        float wgt[8][8];
#pragma unroll
        for (int q = 0; q < 8; ++q) { const float* src = (q & 3) == 3 ? bc + (q >> 2) * FF + j0 : wc + (size_t)(q & 3) * FF2 + (q >> 2) * FF + j0;
            const f32x4 lo = *(const GAS f32x4*)src, hi = *(const GAS f32x4*)(src + 4);
            wgt[q][0] = lo.x; wgt[q][1] = lo.y; wgt[q][2] = lo.z; wgt[q][3] = lo.w; wgt[q][4] = hi.x; wgt[q][5] = hi.y; wgt[q][6] = hi.z; wgt[q][7] = hi.w; }
#pragma unroll
        for (int e = 0; e < 8; ++e) {
            const float w0g = wgt[0][e], w1g = wgt[1][e], w2g = wgt[2][e], bgv = wgt[3][e];
            const float w0v = wgt[4][e], w1v = wgt[5][e], w2v = wgt[6][e], bvv = wgt[7][e];
            a0[e] = silu_f(bgv + w0g * g[0][e] + w1g * g[1][e] + w2g * g[2][e]) * (bvv + w0v * v[0][e] + w1v * v[1][e] + w2v * v[2][e]);
            a1[e] = silu_f(bgv + w0g * g[1][e] + w1g * g[2][e] + w2g * g[3][e]) * (bvv + w0v * v[1][e] + w1v * v[2][e] + w2v * v[3][e]);
        }
        *(GAS v4u*)(ACT + (size_t)(blk * 64) * FF + j0) = pack8(a0);
        *(GAS v4u*)(ACT + (size_t)(blk * 64 + 1) * FF + j0) = pack8(a1);
        if ((blk & 31) == 31) {
            float* co = out + O_FCP + (size_t)((blk >> 5) * 2) * FF2;
#pragma unroll
            for (int s = 0; s < 2; ++s) { float x[8], y[8]; unpack8(*(const GAS v4u*)(hb + (size_t)s * FF2), x); unpack8(*(const GAS v4u*)(hb + (size_t)s * FF2 + FF), y);
                *(f32x4*)(co + (size_t)s * FF2 + j0) = (f32x4){x[0], x[1], x[2], x[3]}; *(f32x4*)(co + (size_t)s * FF2 + j0 + 4) = (f32x4){x[4], x[5], x[6], x[7]};
                *(f32x4*)(co + (size_t)s * FF2 + FF + j0) = (f32x4){y[0], y[1], y[2], y[3]}; *(f32x4*)(co + (size_t)s * FF2 + FF + j0 + 4) = (f32x4){y[4], y[5], y[6], y[7]}; }
        }
    }
}
__device__ __forceinline__ void final_norm_row(const float* xrow, const float* g, float* orow, int lane) {
    const GAS f32x4* xr = (const GAS f32x4*)xrow + lane;
    f32x4 v[8], gg[8]; float s = 0.f;
#pragma unroll
    for (int j = 0; j < 8; ++j) v[j] = xr[64 * j];
#pragma unroll
    for (int j = 0; j < 8; ++j) gg[j] = *(const GAS f32x4*)(g + 4 * lane + 256 * j);
#pragma unroll
    for (int j = 0; j < 8; ++j) s += (v[j].x * v[j].x + v[j].y * v[j].y) + (v[j].z * v[j].z + v[j].w * v[j].w);
    const float rstd = __builtin_amdgcn_rsqf(wave_sum(s) * (1.0f / DM) + NORM_EPS);
#pragma unroll
    for (int j = 0; j < 8; ++j) ((GAS f32x4*)orow)[lane + 64 * j] = v[j] * rstd * gg[j];
}
__device__ __forceinline__ void final_norm_row_bf(const bf16* xrow, const float* g, float* orow, int lane) {
    const GAS v4u* xr = (const GAS v4u*)xrow + lane;
    v4u t[4]; f32x4 v[8], gg[8]; float s = 0.f;
#pragma unroll
    for (int jj = 0; jj < 4; ++jj) t[jj] = xr[64 * jj];
#pragma unroll
    for (int j = 0; j < 8; ++j) gg[j] = *(const GAS f32x4*)(g + 8 * lane + 512 * (j >> 1) + 4 * (j & 1));
#pragma unroll
    for (int jj = 0; jj < 4; ++jj) { v[2 * jj] = (f32x4){bflo(t[jj].x), bfhi(t[jj].x), bflo(t[jj].y), bfhi(t[jj].y)}; v[2 * jj + 1] = (f32x4){bflo(t[jj].z), bfhi(t[jj].z), bflo(t[jj].w), bfhi(t[jj].w)}; }
#pragma unroll
    for (int j = 0; j < 8; ++j) s += (v[j].x * v[j].x + v[j].y * v[j].y) + (v[j].z * v[j].z + v[j].w * v[j].w);
    const float rstd = __builtin_amdgcn_rsqf(wave_sum(s) * (1.0f / DM) + NORM_EPS);
#pragma unroll
    for (int j = 0; j < 8; ++j) *(GAS f32x4*)(orow + 8 * lane + 512 * (j >> 1) + 4 * (j & 1)) = v[j] * rstd * gg[j];
}
#if defined(MK_SUB)
#define SUB0() do { if (F.tid == 0) ((volatile LAS unsigned long long*)(F.lds + LDSCTL_OFF + 1024))[0] = __builtin_amdgcn_s_memrealtime(); } while (0)
#define SUB(idx) do { if (F.tid == 0) { volatile LAS unsigned long long* tp_ = (volatile LAS unsigned long long*)(F.lds + LDSCTL_OFF + 1024); const unsigned long long now_ = __builtin_amdgcn_s_memrealtime(); \
        const unsigned d_ = (unsigned)(now_ - tp_[0]); tp_[0] = now_; atomicMax((unsigned*)(F.ctl + 20000 + (idx)), d_); atomicAdd((unsigned*)(F.ctl + 20100 + (idx)), d_); } } while (0)
#define SUBL0() do { if (F.tid == 0) ((volatile LAS unsigned long long*)(F.lds + LDSCTL_OFF + 1024))[1] = __builtin_amdgcn_s_memrealtime(); } while (0)
#define SUBL(idx) do { if (F.tid == 0) { volatile LAS unsigned long long* tp_ = (volatile LAS unsigned long long*)(F.lds + LDSCTL_OFF + 1024); const unsigned long long now_ = __builtin_amdgcn_s_memrealtime(); \
        const unsigned d_ = (unsigned)(now_ - tp_[1]); tp_[1] = now_; atomicMax((unsigned*)(F.ctl + 20000 + (idx)), d_); atomicAdd((unsigned*)(F.ctl + 20100 + (idx)), d_); } } while (0)
#define GS_ON(e) do { WG_SYNC(); if (F.tid == 0) *(volatile LAS unsigned*)(F.lds + LDSCTL_OFF + 1096) = (e); WG_SYNC(); } while (0)
#define GS_OFF(e) do { WG_SYNC(); if (F.tid == 0) { *(volatile LAS unsigned*)(F.lds + LDSCTL_OFF + 1096) = 0u; volatile LAS unsigned* a_ = (volatile LAS unsigned*)(F.lds + LDSCTL_OFF + 1104); \
        for (int i_ = 0; i_ < 4; ++i_) atomicAdd((unsigned*)(F.ctl + 20100 + 50 + ((e) - 1) * 4 + i_), a_[((e) - 1) * 4 + i_]); } WG_SYNC(); } while (0)
#else
#define GS_ON(e) do {} while (0)
#define GS_OFF(e) do {} while (0)
#define SUBL0() do {} while (0)
#define SUBL(idx) do {} while (0)
#define SUB0() do {} while (0)
#define SUB(idx) do {} while (0)
#endif
constexpr int GP_QS = 0, GP_KS = 17408, GP_KT = 34816, GP_VT = 53248, GP_QK = 71680, GP_PB = 80896, GP_XA = 90112, GP_XT = 99328, GP_UVT = 108544, GP_WKT = 126976, GP_ARR = 145408;
__device__ __forceinline__ bf16x8 ldsfrag(const LAS bf16* base, int pitch, int row0, int k0, int lane) {
    return *(const LAS bf16x8*)(base + (row0 + (lane & 15)) * pitch + k0 + 8 * (lane >> 4));
}
__device__ __forceinline__ float softplus_f(float x) { return x > 20.f ? x : log1pf(__expf(x)); }
__device__ __forceinline__ void st4bf(LAS bf16* p, float a, float b, float c, float d) { *(LAS u32x2v*)p = (u32x2v){pk2(a, b), pk2(c, d)}; }
__device__ __forceinline__ void gst4bf(bf16* p, float a, float b, float c, float d) { *(GAS u32x2v*)p = (u32x2v){pk2(a, b), pk2(c, d)}; }

__device__ __forceinline__ float row16_sum(float v) {
    v += __builtin_bit_cast(float, __builtin_amdgcn_update_dpp(0, __builtin_bit_cast(int, v), 0xB1, 0xf, 0xf, false));
    v += __builtin_bit_cast(float, __builtin_amdgcn_update_dpp(0, __builtin_bit_cast(int, v), 0x4E, 0xf, 0xf, false));
    v += __builtin_bit_cast(float, __builtin_amdgcn_update_dpp(0, __builtin_bit_cast(int, v), 0x141, 0xf, 0xf, false));
    v += __builtin_bit_cast(float, __builtin_amdgcn_update_dpp(0, __builtin_bit_cast(int, v), 0x140, 0xf, 0xf, false));
    return v;
}
struct GdnW { const bf16* Y1; const float* w_gconv; const float* a_log; const float* dt_bias; unsigned char* gch; float* GE; };

__device__ __forceinline__ void gdn_prep_load(const GdnW& W, int ci, int w, int lane, v4u (&xr)[11], f32x4 (&wg)[8]) {
    const int bh = ci >> 5, n = ci & 31, b = bh >> 3, h = bh & 7, r0 = b * TP + n * 64, rb = 8 * w;
    if (lane < 48) {
        const int seg = lane >> 4, cc = (lane & 15) * 8, col = seg * 1024 + h * 128 + cc;
#pragma unroll
        for (int j = 0; j < 11; ++j) xr[j] = (n * 64 + rb - 3 + j >= 0) ? *(const GAS v4u*)(W.Y1 + (size_t)(r0 + rb - 3 + j) * NIN + col) : (v4u){0u, 0u, 0u, 0u};
    } else if (lane < 56) {
        const size_t m = (size_t)(r0 + rb + (lane - 48));
        xr[0] = (v4u){(unsigned)W.Y1[m * NIN + C_A + h], (unsigned)W.Y1[m * NIN + C_B + h], __float_as_uint(W.a_log[h]), __float_as_uint(W.dt_bias[h])};
    }
}
__device__ __forceinline__ void gdn_chunk_prep(Frame& F, const GdnW& W, int ci, int ci_next, v4u (&xr)[11], f32x4 (&wgv)[8]) {
    int tid = F.tid; asm volatile("" : "+v"(tid));
    const int lane = tid & 63, w = __builtin_amdgcn_readfirstlane(tid >> 6), g4 = lane >> 4, l15 = lane & 15;
    const int bh = ci >> 5, n = ci & 31, b = bh >> 3, h = bh & 7;
    const int r0 = b * TP + n * 64;
    LAS bf16* Qs = (LAS bf16*)(F.lds + GP_QS); LAS bf16* Ks = (LAS bf16*)(F.lds + GP_KS); LAS bf16* Kt = (LAS bf16*)(F.lds + GP_KT); LAS bf16* Vt = (LAS bf16*)(F.lds + GP_VT);
    LAS bf16* QKs = (LAS bf16*)(F.lds + GP_QK); LAS bf16* Pb = (LAS bf16*)(F.lds + GP_PB); LAS bf16* Xa = (LAS bf16*)(F.lds + GP_XA); LAS bf16* Xt = (LAS bf16*)(F.lds + GP_XT);
    LAS bf16* UvT = (LAS bf16*)(F.lds + GP_UVT); LAS bf16* WkT = (LAS bf16*)(F.lds + GP_WKT);
    LAS float* garr = (LAS float*)(F.lds + GP_ARR); LAS float* barr = garr + 64; LAS float* gcs = garr + 128; LAS float* eg = garr + 192; LAS float* ek = garr + 256; LAS float* rqa = garr + 320; LAS float* rka = garr + 384;
    WG_SYNC();
    {
        const int rb = 8 * w;
        if (lane < 48) {
            const int seg = lane >> 4, cc = (lane & 15) * 8, col = seg * 1024 + h * 128 + cc;
            float wg[4][8];
#pragma unroll
            for (int i = 0; i < 4; ++i) { wgv[2 * i] = *(const GAS f32x4*)(W.w_gconv + i * 3072 + col); wgv[2 * i + 1] = *(const GAS f32x4*)(W.w_gconv + i * 3072 + col + 4); }
#pragma unroll
            for (int i = 0; i < 4; ++i) { wg[i][0] = wgv[2 * i].x; wg[i][1] = wgv[2 * i].y; wg[i][2] = wgv[2 * i].z; wg[i][3] = wgv[2 * i].w; wg[i][4] = wgv[2 * i + 1].x; wg[i][5] = wgv[2 * i + 1].y; wg[i][6] = wgv[2 * i + 1].z; wg[i][7] = wgv[2 * i + 1].w; }
            float y[8][8];
#pragma unroll
            for (int r = 0; r < 8; ++r) {
                float ss = 0.f;
#pragma unroll
                for (int e = 0; e < 8; ++e) y[r][e] = 0.f;
#pragma unroll
                for (int i = 0; i < 4; ++i) { float x[8]; unpack8(xr[r + i], x);
#pragma unroll
                    for (int e = 0; e < 8; ++e) y[r][e] += wg[i][e] * x[e]; }
#pragma unroll
                for (int e = 0; e < 8; ++e) { y[r][e] = silu_f(y[r][e]); ss += y[r][e] * y[r][e]; }
                ss = row16_sum(ss);
                if (seg < 2 && (lane & 15) == 0) { const float scl = __builtin_amdgcn_rsqf(ss + NORM_EPS) * (seg == 0 ? 0.08838834764831845f : 1.0f); if (seg == 0) rqa[rb + r] = scl; else rka[rb + r] = scl; }
                if (seg == 0) *(LAS v4u*)(Qs + (rb + r) * 136 + cc) = pack8(y[r]);
                else if (seg == 1) *(LAS v4u*)(Ks + (rb + r) * 136 + cc) = pack8(y[r]);
            }
            if (seg >= 1) { LAS bf16* T = (seg == 1) ? Kt : Vt;
#pragma unroll
                for (int e = 0; e < 8; ++e) *(LAS v4u*)(T + (cc + e) * 72 + rb) = (v4u){pk2(y[0][e], y[1][e]), pk2(y[2][e], y[3][e]), pk2(y[4][e], y[5][e]), pk2(y[6][e], y[7][e])}; }
        } else if (lane < 56) {
            const int r = rb + (lane - 48);
            const float ar = bf2f((unsigned short)xr[0].x), br = bf2f((unsigned short)xr[0].y);
            garr[r] = -__expf(__uint_as_float(xr[0].z)) * softplus_f(ar + __uint_as_float(xr[0].w));
            barr[r] = sigm_f(br);
        }
    }
    if (ci_next < 1024) gdn_prep_load(W, ci_next, w, lane, xr, wgv);
    WG_SYNC();
    if (w == 0) {
        float g = garr[lane];
#pragma unroll
        for (int off = 1; off < 64; off <<= 1) { const float t = __shfl_up(g, off); if (lane >= off) g += t; }
        const float gl = __shfl(g, 63);
        gcs[lane] = g; eg[lane] = __expf(g); ek[lane] = __expf(gl - g);
        if (lane == 63) W.GE[ci] = __expf(g);
    }
    WG_SYNC();
    const int mtC = w >> 1, ntC = 2 * (w & 1);
    f32x4 pacc[2];
    {
        f32x4 akk[2], aqk[2];
#pragma unroll
        for (int i = 0; i < 2; ++i) { akk[i] = (f32x4){0.f, 0.f, 0.f, 0.f}; aqk[i] = akk[i]; }
        { bf16x8 aK[4], aQ[4], bK[2][4];
#pragma unroll
          for (int ks = 0; ks < 4; ++ks) { aK[ks] = ldsfrag(Ks, 136, 16 * mtC, 32 * ks, lane); aQ[ks] = ldsfrag(Qs, 136, 16 * mtC, 32 * ks, lane); bK[0][ks] = ldsfrag(Ks, 136, 16 * ntC, 32 * ks, lane); bK[1][ks] = ldsfrag(Ks, 136, 16 * (ntC + 1), 32 * ks, lane); }
          __builtin_amdgcn_sched_barrier(0);
#pragma unroll
          for (int ks = 0; ks < 4; ++ks)
#pragma unroll
              for (int i = 0; i < 2; ++i) { akk[i] = mfma16(aK[ks], bK[i][ks], akk[i]); aqk[i] = mfma16(aQ[ks], bK[i][ks], aqk[i]); } }
#pragma unroll
        for (int i = 0; i < 2; ++i) {
            const int j = 16 * (ntC + i) + l15; const float gj = gcs[j], rkj = rka[j];
            float av[4], qv[4];
#pragma unroll
            for (int r = 0; r < 4; ++r) {
                const int c = 16 * mtC + 4 * g4 + r;
                const float dec = (j <= c) ? __expf(gcs[c] - gj) : 0.f;
                av[r] = (j < c) ? barr[c] * akk[i][r] * (rka[c] * rkj) * dec : 0.f; qv[r] = aqk[i][r] * (rqa[c] * rkj) * dec;
                pacc[i][r] = ((c == j) ? 1.0f : 0.f) - av[r];
                Pb[c * 72 + j] = (bf16)f2bf(pacc[i][r]); Xa[c * 72 + j] = (bf16)f2bf(av[r]); QKs[c * 72 + j] = (bf16)f2bf(qv[r]);
            }
            st4bf(Xt + j * 72 + 16 * mtC + 4 * g4, av[0], av[1], av[2], av[3]);
        }
    }
    WG_SYNC();
    {
        f32x4 xacc[2];
        { bf16x8 fa[2], fb[2][2];
#pragma unroll
          for (int ks = 0; ks < 2; ++ks) { fa[ks] = ldsfrag(Xa, 72, 16 * mtC, 32 * ks, lane); fb[0][ks] = ldsfrag(Xt, 72, 16 * ntC, 32 * ks, lane); fb[1][ks] = ldsfrag(Xt, 72, 16 * (ntC + 1), 32 * ks, lane); }
          __builtin_amdgcn_sched_barrier(0);
#pragma unroll
          for (int i = 0; i < 2; ++i) { xacc[i] = (f32x4){0.f, 0.f, 0.f, 0.f};
#pragma unroll
              for (int ks = 0; ks < 2; ++ks) xacc[i] = mfma16(fa[ks], fb[i][ks], xacc[i]); } }
        WG_SYNC();
#pragma unroll
        for (int i = 0; i < 2; ++i) { const int j = 16 * (ntC + i) + l15;
#pragma unroll
            for (int r = 0; r < 4; ++r) Xa[(16 * mtC + 4 * g4 + r) * 72 + j] = (bf16)f2bf(xacc[i][r]);
            st4bf(Xt + j * 72 + 16 * mtC + 4 * g4, xacc[i][0], xacc[i][1], xacc[i][2], xacc[i][3]); }
        WG_SYNC();
#pragma unroll 1
        for (int it = 1; it <= 5; ++it) {
            { bf16x8 fp[2], fa[2], fb[2][2];
#pragma unroll
              for (int ks = 0; ks < 2; ++ks) { fp[ks] = ldsfrag(Pb, 72, 16 * mtC, 32 * ks, lane); fa[ks] = ldsfrag(Xa, 72, 16 * mtC, 32 * ks, lane); fb[0][ks] = ldsfrag(Xt, 72, 16 * ntC, 32 * ks, lane); fb[1][ks] = ldsfrag(Xt, 72, 16 * (ntC + 1), 32 * ks, lane); }
              __builtin_amdgcn_sched_barrier(0);
#pragma unroll
              for (int i = 0; i < 2; ++i) { xacc[i] = (f32x4){0.f, 0.f, 0.f, 0.f};
#pragma unroll
                  for (int ks = 0; ks < 2; ++ks) { pacc[i] = mfma16(fp[ks], fb[i][ks], pacc[i]); xacc[i] = mfma16(fa[ks], fb[i][ks], xacc[i]); } } }
            WG_SYNC();
#pragma unroll
            for (int i = 0; i < 2; ++i) { const int j = 16 * (ntC + i) + l15;
#pragma unroll
                for (int r = 0; r < 4; ++r) { const int c = 16 * mtC + 4 * g4 + r; Pb[c * 72 + j] = (bf16)f2bf(pacc[i][r]); Xa[c * 72 + j] = (bf16)f2bf(xacc[i][r]); }
                st4bf(Xt + j * 72 + 16 * mtC + 4 * g4, xacc[i][0], xacc[i][1], xacc[i][2], xacc[i][3]); }
            WG_SYNC();
        }
#pragma unroll
        for (int i = 0; i < 2; ++i) { const int j = 16 * (ntC + i) + l15; const float bj = barr[j], bg = bj * eg[j] * rka[j];
#pragma unroll
            for (int r = 0; r < 4; ++r) { const int c = 16 * mtC + 4 * g4 + r; Xa[c * 72 + j] = (bf16)f2bf(pacc[i][r] * bj); Xt[c * 72 + j] = (bf16)f2bf(pacc[i][r] * bg); } }
    }
    WG_SYNC();
    { bf16x8 fv[2], fk[2];
#pragma unroll
      for (int ks = 0; ks < 2; ++ks) { fv[ks] = ldsfrag(Vt, 72, 16 * w, 32 * ks, lane); fk[ks] = ldsfrag(Kt, 72, 16 * w, 32 * ks, lane); }
#pragma unroll
      for (int mp = 0; mp < 2; ++mp) {
          bf16x8 fa[2][2], ft[2][2];
#pragma unroll
          for (int m2 = 0; m2 < 2; ++m2)
#pragma unroll
              for (int ks = 0; ks < 2; ++ks) { fa[m2][ks] = ldsfrag(Xa, 72, 16 * (2 * mp + m2), 32 * ks, lane); ft[m2][ks] = ldsfrag(Xt, 72, 16 * (2 * mp + m2), 32 * ks, lane); }
          __builtin_amdgcn_sched_barrier(0);
#pragma unroll
          for (int m2 = 0; m2 < 2; ++m2) { const int mt = 2 * mp + m2;
              f32x4 au = (f32x4){0.f, 0.f, 0.f, 0.f}, aw = au;
#pragma unroll
              for (int ks = 0; ks < 2; ++ks) { au = mfma16(fa[m2][ks], fv[ks], au); aw = mfma16(ft[m2][ks], fk[ks], aw); }
              st4bf(UvT + (16 * w + l15) * 72 + 16 * mt + 4 * g4, au[0], au[1], au[2], au[3]);
              st4bf(WkT + (16 * w + l15) * 72 + 16 * mt + 4 * g4, aw[0], aw[1], aw[2], aw[3]); }
      } }
    WG_SYNC();
    {
        const int dk = tid >> 2, c0 = (tid & 3) * 16;
#pragma unroll
        for (int q = 0; q < 2; ++q) {
            LAS v4u* p = (LAS v4u*)(Kt + dk * 72 + c0 + 8 * q); float x[8]; unpack8(*p, x);
#pragma unroll
            for (int e = 0; e < 8; ++e) x[e] *= ek[c0 + 8 * q + e] * rka[c0 + 8 * q + e];
            *p = (v4u){pk2(x[0], x[1]), pk2(x[2], x[3]), pk2(x[4], x[5]), pk2(x[6], x[7])};
        }
    }
    WG_SYNC();
    unsigned char* gb = W.gch + (size_t)ci * GCH_BYTES;
    bf16* MS = (bf16*)(gb + GCH_MS); bf16* BT = (bf16*)(gb + GCH_BT); bf16* QE = (bf16*)(gb + GCH_QE); bf16* OLT = (bf16*)(gb + GCH_OLT);
    {
        bf16x8 fw[2], fkw[2], fu[2];
#pragma unroll
        for (int ks = 0; ks < 2; ++ks) { fw[ks] = ldsfrag(WkT, 72, 16 * w, 32 * ks, lane); fkw[ks] = ldsfrag(Kt, 72, 16 * w, 32 * ks, lane); fu[ks] = ldsfrag(UvT, 72, 16 * w, 32 * ks, lane); }
#pragma unroll
        for (int np = 0; np < 4; ++np) {
            bf16x8 fk[2][2], fv[2][2];
#pragma unroll
            for (int n2 = 0; n2 < 2; ++n2)
#pragma unroll
                for (int ks = 0; ks < 2; ++ks) { fk[n2][ks] = ldsfrag(Kt, 72, 16 * (2 * np + n2), 32 * ks, lane); fv[n2][ks] = ldsfrag(UvT, 72, 16 * (2 * np + n2), 32 * ks, lane); }
            __builtin_amdgcn_sched_barrier(0);
#pragma unroll
            for (int n2 = 0; n2 < 2; ++n2) { const int nt = 2 * np + n2;
                f32x4 am = (f32x4){0.f, 0.f, 0.f, 0.f}, ab = am;
#pragma unroll
                for (int ks = 0; ks < 2; ++ks) { am = mfma16(fw[ks], fk[n2][ks], am); ab = mfma16(fkw[ks], fv[n2][ks], ab); }
                gst4bf(MS + (size_t)(16 * nt + l15) * 128 + 16 * w + 4 * g4, -am[0], -am[1], -am[2], -am[3]);
                gst4bf(BT + (size_t)(16 * nt + l15) * 128 + 16 * w + 4 * g4, ab[0], ab[1], ab[2], ab[3]); }
        }
        {
            bf16x8 fq[4][2];
#pragma unroll
            for (int nt = 0; nt < 4; ++nt)
#pragma unroll
                for (int ks = 0; ks < 2; ++ks) fq[nt][ks] = ldsfrag(QKs, 72, 16 * nt, 32 * ks, lane);
            __builtin_amdgcn_sched_barrier(0);
#pragma unroll
            for (int nt = 0; nt < 4; ++nt) {
                f32x4 aq = (f32x4){0.f, 0.f, 0.f, 0.f}, ao = aq;
#pragma unroll
                for (int ks = 0; ks < 2; ++ks) { aq = mfma16(fw[ks], fq[nt][ks], aq); ao = mfma16(fq[nt][ks], fu[ks], ao); }
                const int c = 16 * nt + l15; const float e = eg[c] * rqa[c];
                const u32x2v qq = *(const LAS u32x2v*)(Qs + c * 136 + 16 * w + 4 * g4);
                gst4bf(QE + (size_t)c * 128 + 16 * w + 4 * g4, e * bflo(qq.x) - aq[0], e * bfhi(qq.x) - aq[1], e * bflo(qq.y) - aq[2], e * bfhi(qq.y) - aq[3]);
                gst4bf(OLT + (size_t)(16 * w + l15) * 64 + 16 * nt + 4 * g4, ao[0], ao[1], ao[2], ao[3]);
            }
        }
    }
}

struct GdnS { const bf16* Y1; const float* w_gconv; const float* a_log; const float* dt_bias; const float* g_gnorm; const float* state_gdn; const float* state_gconv; bf16* OG; float* out; };
__device__ __forceinline__ void gdn_sample_group(Frame& F, const GdnS& W, int it0, int stride) {
    int tid = F.tid; asm volatile("" : "+v"(tid));
    const int lane = tid & 63, w = __builtin_amdgcn_readfirstlane(tid >> 6);
    LAS float* cv = (LAS float*)(F.lds);
    LAS float* gb = cv + 4 * 1536;
    LAS float* sq = gb + 32;
    const int ik = w >> 1, half = w & 1, dv = 64 * half + lane;
    const int item = it0 + ik * stride, db = item >> 3, h = item & 7;
    const size_t mrow = (size_t)NPR + 4 * db;
    WG_SYNC();
#pragma unroll
    for (int j = 0; j < 3; ++j) {
        const int p = tid + 512 * j, ii = p / 384, c = p - 384 * ii;
        const int it2 = it0 + ii * stride, db2 = it2 >> 3, h2 = it2 & 7, col = (c >> 7) * 1024 + h2 * 128 + (c & 127);
        const size_t mr2 = (size_t)NPR + 4 * db2;
        float xx[7], wq[4];
#pragma unroll
        for (int i = 0; i < 3; ++i) xx[i] = W.state_gconv[(size_t)(db2 * 3 + i) * 3072 + col];
#pragma unroll
        for (int i = 0; i < 4; ++i) xx[3 + i] = bf2f(W.Y1[(mr2 + i) * NIN + col]);
#pragma unroll
        for (int i = 0; i < 4; ++i) wq[i] = W.w_gconv[i * 3072 + col];
#pragma unroll
        for (int ts = 0; ts < 4; ++ts) cv[(ii * 4 + ts) * 384 + c] = silu_f(wq[0] * xx[ts] + wq[1] * xx[ts + 1] + wq[2] * xx[ts + 2] + wq[3] * xx[ts + 3]);
    }
    if (tid < 16) {
        const int ii = tid >> 2, ts = tid & 3, it2 = it0 + ii * stride, db2 = it2 >> 3, h2 = it2 & 7; const size_t m2 = (size_t)NPR + 4 * db2 + ts;
        const float ar = bf2f(W.Y1[m2 * NIN + C_A + h2]), br = bf2f(W.Y1[m2 * NIN + C_B + h2]);
        gb[ii * 8 + ts] = -__expf(W.a_log[h2]) * softplus_f(ar + W.dt_bias[h2]); gb[ii * 8 + 4 + ts] = sigm_f(br);
    }
    const float* Sg = W.state_gdn + ((size_t)(db * 8 + h) * 128) * 128 + dv;
    float S[128];
#pragma unroll
    for (int r = 0; r < 128; ++r) S[r] = Sg[(size_t)r * 128];
    float zz[4]; const float gn = W.g_gnorm[dv];
#pragma unroll
    for (int ts = 0; ts < 4; ++ts) zz[ts] = bf2f(W.Y1[(mrow + ts) * NIN + C_Z + h * 128 + dv]);
    WG_SYNC();
#pragma unroll
    for (int jj = 0; jj < 4; ++jj) {
        const int job = 4 * w + jj, ii = job >> 3, ts = (job >> 1) & 3, sg = job & 1;
        LAS float* p = cv + (ii * 4 + ts) * 384 + sg * 128;
        const float a = p[lane], b2 = p[lane + 64];
        const float scl = (1.0f / sqrtf(wave_sum(a * a + b2 * b2) + NORM_EPS)) * (sg == 0 ? 0.08838834764831845f : 1.0f);
        p[lane] = a * scl; p[lane + 64] = b2 * scl;
    }
    WG_SYNC();
    float ot[4];
#pragma unroll
    for (int ts = 0; ts < 4; ++ts) {
        const LAS float* q = cv + (ik * 4 + ts) * 384; const LAS float* k = q + 128;
        const float al = __expf(gb[ik * 8 + ts]), be = gb[ik * 8 + 4 + ts], vv = q[256 + dv];
        float kS = 0.f;
#pragma unroll
        for (int rb = 0; rb < 4; ++rb) {
            f32x4 kk[8];
#pragma unroll
            for (int r4 = 0; r4 < 8; ++r4) kk[r4] = *(const LAS f32x4*)(k + 32 * rb + 4 * r4);
#pragma unroll
            for (int r4 = 0; r4 < 8; ++r4) { const int r = 32 * rb + 4 * r4; kS += S[r] * kk[r4].x + S[r + 1] * kk[r4].y + S[r + 2] * kk[r4].z + S[r + 3] * kk[r4].w; }
            __builtin_amdgcn_sched_barrier(0);
        }
        const float dl = (vv - kS * al) * be;
        float o = 0.f;
#pragma unroll
        for (int rb = 0; rb < 8; ++rb) {
            f32x4 kk[4], qq[4];
#pragma unroll
            for (int r4 = 0; r4 < 4; ++r4) { kk[r4] = *(const LAS f32x4*)(k + 16 * rb + 4 * r4); qq[r4] = *(const LAS f32x4*)(q + 16 * rb + 4 * r4); }
#pragma unroll
            for (int r4 = 0; r4 < 4; ++r4) { const int r = 16 * rb + 4 * r4;
                S[r] = S[r] * al + dl * kk[r4].x; S[r + 1] = S[r + 1] * al + dl * kk[r4].y; S[r + 2] = S[r + 2] * al + dl * kk[r4].z; S[r + 3] = S[r + 3] * al + dl * kk[r4].w;
                o += S[r] * qq[r4].x + S[r + 1] * qq[r4].y + S[r + 2] * qq[r4].z + S[r + 3] * qq[r4].w; }
            __builtin_amdgcn_sched_barrier(0);
        }
        ot[ts] = o;
        const float s2 = wave_sum(o * o);
        if (lane == 0) sq[(ik * 4 + ts) * 2 + half] = s2;
    }
    float* So = W.out + O_GSS + ((size_t)(db * 8 + h) * 128) * 128 + dv;
#pragma unroll
    for (int r = 0; r < 128; ++r) So[(size_t)r * 128] = S[r];
    WG_SYNC();
#pragma unroll
    for (int ts = 0; ts < 4; ++ts) {
        const float rstd = 1.0f / sqrtf((sq[(ik * 4 + ts) * 2] + sq[(ik * 4 + ts) * 2 + 1]) * (1.0f / 128.0f) + NORM_EPS);
        W.OG[(mrow + ts) * 2048 + h * 128 + dv] = (bf16)f2bf(ot[ts] * rstd * gn * silu_f(zz[ts]));
    }
}
struct GdnSPre { float xx[7]; float wq[4]; f32x4 S[8]; };
__device__ __forceinline__ void gdn_sample_load(const GdnS& W, int item, int tid, GdnSPre& P) {
    asm volatile("" : "+v"(tid));
    const int lane = tid & 63, w = __builtin_amdgcn_readfirstlane(tid >> 6);
    const int db = item >> 3, h = item & 7;
    const size_t mrow = (size_t)NPR + 4 * db;
#pragma unroll
    for (int i = 0; i < 7; ++i) P.xx[i] = 0.f;
#pragma unroll
    for (int i = 0; i < 4; ++i) P.wq[i] = 0.f;
    if (tid < 384) {
        const int seg = tid >> 7, col = seg * 1024 + h * 128 + (tid & 127);
#pragma unroll
        for (int i = 0; i < 3; ++i) P.xx[i] = W.state_gconv[(size_t)(db * 3 + i) * 3072 + col];
#pragma unroll
        for (int i = 0; i < 4; ++i) P.xx[3 + i] = bf2f(W.Y1[(mrow + i) * NIN + col]);
#pragma unroll
        for (int i = 0; i < 4; ++i) P.wq[i] = W.w_gconv[i * 3072 + col];
    } else if (tid < 388) {
        const int ts = tid - 384;
        P.xx[0] = bf2f(W.Y1[(mrow + ts) * NIN + C_A + h]); P.xx[1] = bf2f(W.Y1[(mrow + ts) * NIN + C_B + h]);
        P.wq[0] = W.a_log[h]; P.wq[1] = W.dt_bias[h];
    }
    const float* Sg = W.state_gdn + ((size_t)(db * 8 + h) * 128) * 128;
#pragma unroll
    for (int i = 0; i < 8; ++i) P.S[i] = *(const f32x4*)(Sg + (size_t)(16 * w + 2 * i + (lane >> 5)) * 128 + 4 * (lane & 31));
}
__device__ __forceinline__ void gdn_sample_item(Frame& F, const GdnS& W, int item, int nxt, GdnSPre& P) {
    int tid = F.tid; asm volatile("" : "+v"(tid));
    const int lane = tid & 63, w = __builtin_amdgcn_readfirstlane(tid >> 6);
    const int db = item >> 3, h = item & 7;
    LAS float* cv = (LAS float*)(F.lds);
    LAS float* gb = cv + 1536;
    LAS float* part = gb + 8;
    LAS float* opart = part + 2048;
    WG_SYNC();
    const size_t mrow = (size_t)NPR + 4 * db;
    if (tid < 384) {
#pragma unroll
        for (int ts = 0; ts < 4; ++ts) cv[ts * 384 + tid] = silu_f(P.wq[0] * P.xx[ts] + P.wq[1] * P.xx[ts + 1] + P.wq[2] * P.xx[ts + 2] + P.wq[3] * P.xx[ts + 3]);
    } else if (tid < 388) {
        const int ts = tid - 384;
        gb[ts] = -__expf(P.wq[0]) * softplus_f(P.xx[0] + P.wq[1]); gb[4 + ts] = sigm_f(P.xx[1]);
    }
    f32x4 S[8];
#pragma unroll
    for (int i = 0; i < 8; ++i) S[i] = P.S[i];
    float z0 = 0.f, z1 = 0.f, gn0 = 0.f, gn1 = 0.f;
    if (w < 4) {
        const bf16* zr = W.Y1 + (mrow + w) * NIN + C_Z + h * 128;
        z0 = bf2f(zr[lane]); z1 = bf2f(zr[lane + 64]); gn0 = W.g_gnorm[lane]; gn1 = W.g_gnorm[lane + 64];
    }
    if (nxt < 1024) gdn_sample_load(W, nxt, tid, P);
    WG_SYNC();
    {
        const int ts = w >> 1, sg = w & 1;
        LAS float* p = cv + ts * 384 + sg * 128;
        const float a = p[lane], b2 = p[lane + 64];
        const float scl = (1.0f / sqrtf(wave_sum(a * a + b2 * b2) + NORM_EPS)) * (sg == 0 ? 0.08838834764831845f : 1.0f);
        p[lane] = a * scl; p[lane + 64] = b2 * scl;
    }
    WG_SYNC();
#pragma unroll 1
    for (int ts = 0; ts < 4; ++ts) {
        const LAS float* q = cv + ts * 384; const LAS float* k = q + 128; const LAS float* v = q + 256;
        const float al = __expf(gb[ts]), be = gb[4 + ts];
        float kr[8];
        f32x4 p = (f32x4){0.f, 0.f, 0.f, 0.f};
#pragma unroll
        for (int i = 0; i < 8; ++i) { kr[i] = k[16 * w + 2 * i + (lane >> 5)]; p += S[i] * kr[i]; }
        p.x = xh_sum(p.x); p.y = xh_sum(p.y); p.z = xh_sum(p.z); p.w = xh_sum(p.w);
        LAS float* pp = part + (ts & 1) * 1024;
        if (lane < 32) *(LAS f32x4*)(pp + w * 128 + 4 * lane) = p;
        WG_SYNC();
        f32x4 ks = (f32x4){0.f, 0.f, 0.f, 0.f};
#pragma unroll
        for (int ww = 0; ww < 8; ++ww) ks += *(const LAS f32x4*)(pp + ww * 128 + 4 * (lane & 31));
        const f32x4 vv = *(const LAS f32x4*)(v + 4 * (lane & 31));
        const f32x4 dlt = (vv - ks * al) * be;
        f32x4 po = (f32x4){0.f, 0.f, 0.f, 0.f};
#pragma unroll
        for (int i = 0; i < 8; ++i) { S[i] = S[i] * al + dlt * kr[i]; po += S[i] * q[16 * w + 2 * i + (lane >> 5)]; }
        po.x = xh_sum(po.x); po.y = xh_sum(po.y); po.z = xh_sum(po.z); po.w = xh_sum(po.w);
        if (lane < 32) *(LAS f32x4*)(opart + (ts * 8 + w) * 128 + 4 * lane) = po;
    }
    float* So = W.out + O_GSS + ((size_t)(db * 8 + h) * 128) * 128;
#pragma unroll
    for (int i = 0; i < 8; ++i) *(f32x4*)(So + (size_t)(16 * w + 2 * i + (lane >> 5)) * 128 + 4 * (lane & 31)) = S[i];
    WG_SYNC();
    if (w < 4) {
        float o0 = 0.f, o1 = 0.f;
#pragma unroll
        for (int ww = 0; ww < 8; ++ww) { o0 += opart[(w * 8 + ww) * 128 + lane]; o1 += opart[(w * 8 + ww) * 128 + 64 + lane]; }
        const float rstd = 1.0f / sqrtf(wave_sum(o0 * o0 + o1 * o1) * (1.0f / 128.0f) + NORM_EPS);
        bf16* og = W.OG + (mrow + w) * 2048 + h * 128;
        og[lane] = (bf16)f2bf(o0 * rstd * gn0 * silu_f(z0));
        og[lane + 64] = (bf16)f2bf(o1 * rstd * gn1 * silu_f(z1));
    }
}

constexpr int GS_BUF = 34816;
struct GdnP { const unsigned char* gch; const float* GE; bf16* SN; float* out; };
__device__ __forceinline__ bf16x8 permfrag(const LAS bf16* rowp, int k0, int g4) {
    const u32x2v a = *(const LAS u32x2v*)(rowp + k0 + 4 * g4), b = *(const LAS u32x2v*)(rowp + k0 + 16 + 4 * g4);
    return __builtin_bit_cast(bf16x8, (v4u){a.x, a.y, b.x, b.y});
}
__device__ __forceinline__ void gdn_scan_item(Frame& F, const GdnP& W, int bh) {
    int tid = F.tid; asm volatile("" : "+v"(tid));
    const int lane = tid & 63, w = __builtin_amdgcn_readfirstlane(tid >> 6), g4 = lane >> 4, l15 = lane & 15;
    const unsigned char* gb0 = W.gch + (size_t)(bh * 32) * GCH_BYTES;
    f32x4 S[8];
#pragma unroll
    for (int mt = 0; mt < 8; ++mt) S[mt] = (f32x4){0.f, 0.f, 0.f, 0.f};
    const float gev = W.GE[bh * 32 + (lane & 31)];
    WG_SYNC();
    v4u stA[4], stB[4]; u32x2v btA[8], btB[8];
#define GS_LD_MS(set_, n_) do { const unsigned char* g_ = gb0 + (size_t)((n_) < 32 ? (n_) : 31) * GCH_BYTES + GCH_MS + (unsigned)tid * 16u; \
        _Pragma("unroll") for (int i = 0; i < 4; ++i) set_[i] = *(const GAS v4u*)(g_ + (size_t)i * 8192); } while (0)
#define GS_ST_MS(set_, buf_) do { _Pragma("unroll") for (int i = 0; i < 4; ++i) { const int idx = tid + 512 * i, row = idx >> 4, cchunk = idx & 15; *(LAS v4u*)(F.lds + (buf_) * GS_BUF + row * 272 + cchunk * 16) = set_[i]; } } while (0)
#define GS_LD_BT(set_, n_) do { const bf16* b_ = (const bf16*)(gb0 + (size_t)((n_) < 32 ? (n_) : 31) * GCH_BYTES + GCH_BT) + (size_t)(16 * w + l15) * 128 + 4 * g4; \
        _Pragma("unroll") for (int mt = 0; mt < 8; ++mt) set_[mt] = *(const GAS u32x2v*)(b_ + 16 * mt); } while (0)
#define GS_STEP(n_, bt_) do { const int n = (n_); \
        const LAS bf16* MSl = (const LAS bf16*)(F.lds + (n & 1) * GS_BUF); \
        const float ge = __builtin_bit_cast(float, __builtin_amdgcn_readlane(__builtin_bit_cast(int, gev), n)); \
        bf16x8 Sb[4]; \
        { bf16* sn = W.SN + ((size_t)(bh * 32 + n) * 128 + 16 * w + l15) * 128 + 4 * g4; \
          _Pragma("unroll") for (int ks = 0; ks < 4; ++ks) { \
              const u32x2v lo = (u32x2v){pk2(S[2 * ks][0], S[2 * ks][1]), pk2(S[2 * ks][2], S[2 * ks][3])}, hi = (u32x2v){pk2(S[2 * ks + 1][0], S[2 * ks + 1][1]), pk2(S[2 * ks + 1][2], S[2 * ks + 1][3])}; \
              Sb[ks] = __builtin_bit_cast(bf16x8, (v4u){lo.x, lo.y, hi.x, hi.y}); \
              *(GAS u32x2v*)(sn + 32 * ks) = lo; *(GAS u32x2v*)(sn + 32 * ks + 16) = hi; } } \
        _Pragma("unroll") for (int mp = 0; mp < 4; ++mp) { \
            bf16x8 fr[8]; \
            _Pragma("unroll") for (int m2 = 0; m2 < 2; ++m2) _Pragma("unroll") for (int ks = 0; ks < 4; ++ks) fr[m2 * 4 + ks] = permfrag(MSl + (16 * (2 * mp + m2) + l15) * 136, 32 * ks, g4); \
            __builtin_amdgcn_sched_barrier(0); \
            f32x4 acc[2]; \
            _Pragma("unroll") for (int m2 = 0; m2 < 2; ++m2) { const u32x2v bv = bt_[2 * mp + m2]; acc[m2] = S[2 * mp + m2] * ge + (f32x4){bflo(bv.x), bfhi(bv.x), bflo(bv.y), bfhi(bv.y)}; } \
            _Pragma("unroll") for (int ks = 0; ks < 4; ++ks) _Pragma("unroll") for (int m2 = 0; m2 < 2; ++m2) acc[m2] = mfma16(fr[m2 * 4 + ks], Sb[ks], acc[m2]); \
            S[2 * mp] = acc[0]; S[2 * mp + 1] = acc[1]; } \
        asm volatile("" ::: "memory"); } while (0)
    GS_LD_MS(stA, 0); GS_LD_MS(stB, 1); GS_LD_BT(btA, 0); GS_LD_BT(btB, 1);
    GS_ST_MS(stA, 0);
    WG_SYNC();
#pragma unroll 1
    for (int n2 = 0; n2 < 32; n2 += 2) {
        GS_LD_MS(stA, n2 + 2);
        GS_STEP(n2, btA);
        GS_LD_BT(btA, n2 + 2);
        GS_ST_MS(stB, 1);
        WG_SYNC();
        GS_LD_MS(stB, n2 + 3);
        GS_STEP(n2 + 1, btB);
        GS_LD_BT(btB, n2 + 3);
        GS_ST_MS(stA, 0);
        WG_SYNC();
    }
#undef GS_LD_MS
#undef GS_ST_MS
#undef GS_LD_BT
#undef GS_STEP
    float* So = W.out + O_GSP + (size_t)bh * 128 * 128;
#pragma unroll
    for (int mt = 0; mt < 8; ++mt)
#pragma unroll
        for (int r = 0; r < 4; ++r) So[(size_t)(16 * mt + 4 * g4 + r) * 128 + 16 * w + l15] = S[mt][r];
    WG_SYNC();
}
struct GdnO { const bf16* Y1; const float* g_gnorm; const unsigned char* gch; const bf16* SN; bf16* OG; unsigned char* dbg; };
struct GdnOPre { v4u qe[2], zq[2], sn[4], ol[2]; };
__device__ __forceinline__ void gdn_out_load(const GdnO& W, int ci, int tid, GdnOPre& P) {
    const int lane = tid & 63, w = __builtin_amdgcn_readfirstlane(tid >> 6), g4 = lane >> 4, l15 = lane & 15, bh = ci >> 5, n = ci & 31, b = bh >> 3, h = bh & 7;
    const int row = tid >> 3, cc = (tid & 7) * 16;
    const unsigned char* gb = W.gch + (size_t)ci * GCH_BYTES;
    const bf16* QEg = (const bf16*)(gb + GCH_QE) + (size_t)row * 128 + cc;
    P.qe[0] = *(const GAS v4u*)QEg; P.qe[1] = *(const GAS v4u*)(QEg + 8);
    const bf16* zg = W.Y1 + (size_t)(b * TP + n * 64 + row) * NIN + C_Z + h * 128 + cc;
    P.zq[0] = *(const GAS v4u*)zg; P.zq[1] = *(const GAS v4u*)(zg + 8);
#pragma unroll
    for (int i = 0; i < 4; ++i) { const int p = tid + 512 * i; P.sn[i] = *(const GAS v4u*)(W.SN + ((size_t)ci * 128 + (p >> 4)) * 128 + 8 * (p & 15)); }
#pragma unroll
    for (int i = 0; i < 2; ++i) { const int p = tid + 512 * i; P.ol[i] = *(const GAS v4u*)((const bf16*)(gb + GCH_OLT) + (size_t)(p >> 3) * 64 + 8 * (p & 7)); }
    (void)w; (void)g4; (void)l15;
}
__device__ __forceinline__ void gdn_out_item(Frame& F, const GdnO& W, int ci, int ci_next, GdnOPre& P) {
    int tid = F.tid; asm volatile("" : "+v"(tid));
    const int lane = tid & 63, w = __builtin_amdgcn_readfirstlane(tid >> 6), g4 = lane >> 4, l15 = lane & 15;
    const int bh = ci >> 5, n = ci & 31, b = bh >> 3, h = bh & 7;
    const int row = tid >> 3, cc = (tid & 7) * 16;
    LAS float* part = (LAS float*)F.lds;
    LAS bf16* QEs = (LAS bf16*)(F.lds + 2048);
    LAS bf16* Zs = QEs + 64 * 136;
    LAS bf16* Os = Zs + 64 * 136;
    const float gdv = W.g_gnorm[16 * w + l15];
    *(LAS v4u*)(QEs + row * 136 + cc) = P.qe[0]; *(LAS v4u*)(QEs + row * 136 + cc + 8) = P.qe[1];
    *(LAS v4u*)(Zs + row * 136 + cc) = P.zq[0]; *(LAS v4u*)(Zs + row * 136 + cc + 8) = P.zq[1];
    LAS bf16* SNs = Os + 64 * 136;
    LAS bf16* OLs = SNs + 128 * 136;
#pragma unroll
    for (int i = 0; i < 4; ++i) { const int p = tid + 512 * i; *(LAS v4u*)(SNs + (p >> 4) * 136 + 8 * (p & 15)) = P.sn[i]; }
#pragma unroll
    for (int i = 0; i < 2; ++i) { const int p = tid + 512 * i; *(LAS v4u*)(OLs + (p >> 3) * 72 + 8 * (p & 7)) = P.ol[i]; }
    WG_SYNC();
    if (ci_next < 1024) gdn_out_load(W, ci_next, tid, P);
    f32x4 o[4];
#pragma unroll
    for (int ct = 0; ct < 4; ++ct) { const u32x2v ov = *(const LAS u32x2v*)(OLs + (16 * w + l15) * 72 + 16 * ct + 4 * g4); o[ct] = (f32x4){bflo(ov.x), bfhi(ov.x), bflo(ov.y), bfhi(ov.y)}; }
    bf16x8 fb[4];
#pragma unroll
    for (int ks = 0; ks < 4; ++ks) fb[ks] = *(const LAS bf16x8*)(SNs + (16 * w + l15) * 136 + 32 * ks + 8 * g4);
#pragma unroll
    for (int ks = 0; ks < 4; ++ks) {
        bf16x8 fa[4];
#pragma unroll
        for (int ct = 0; ct < 4; ++ct) fa[ct] = *(const LAS bf16x8*)(QEs + (16 * ct + l15) * 136 + 32 * ks + 8 * g4);
#pragma unroll
        for (int ct = 0; ct < 4; ++ct) o[ct] = mfma16(fa[ct], fb[ks], o[ct]);
    }
#pragma unroll
    for (int ct = 0; ct < 4; ++ct) {
#if defined(MK_DIAG)
        { float* dbg = (float*)(W.dbg) + (size_t)(b * TP + n * 64) * 1024 + h * 128 + 16 * w + l15;
          for (int r = 0; r < 4; ++r) dbg[(size_t)(16 * ct + 4 * g4 + r) * 1024] = o[ct][r]; }
#endif
        f32x4 sq = o[ct] * o[ct];
        sq.x = row16_sum(sq.x); sq.y = row16_sum(sq.y); sq.z = row16_sum(sq.z); sq.w = row16_sum(sq.w);
        if (l15 == 0) *(LAS f32x4*)(part + w * 64 + 16 * ct + 4 * g4) = sq;
    }
    WG_SYNC();
#pragma unroll
    for (int ct = 0; ct < 4; ++ct) {
        f32x4 tot = (f32x4){0.f, 0.f, 0.f, 0.f};
#pragma unroll
        for (int ww = 0; ww < 8; ++ww) tot += *(const LAS f32x4*)(part + ww * 64 + 16 * ct + 4 * g4);
#pragma unroll
        for (int r = 0; r < 4; ++r) { const float rstd = __builtin_amdgcn_rsqf(tot[r] * (1.0f / 128.0f) + NORM_EPS);
            const int c = 16 * ct + 4 * g4 + r; const float zf = bf2f(Zs[c * 136 + 16 * w + l15]);
            Os[c * 136 + 16 * w + l15] = (bf16)f2bf(o[ct][r] * rstd * gdv * silu_f(zf)); }
    }
    WG_SYNC();
    { bf16* og = W.OG + (size_t)(b * TP + n * 64 + row) * 2048 + h * 128 + cc;
      const v4u a0 = *(const LAS v4u*)(Os + row * 136 + cc), a1 = *(const LAS v4u*)(Os + row * 136 + cc + 8);
      *(GAS v4u*)og = a0; *(GAS v4u*)(og + 8) = a1; }
}
typedef float f32x16 __attribute__((ext_vector_type(16)));
__device__ __forceinline__ f32x16 mfma32(bf16x8 a, bf16x8 b, f32x16 c) { return __builtin_amdgcn_mfma_f32_32x32x16_bf16(a, b, c, 0, 0, 0); }
__device__ __forceinline__ unsigned sortkey(float x) { const unsigned u = __float_as_uint(x); return u ^ ((u >> 31) ? 0xFFFFFFFFu : 0x80000000u); }
__device__ __forceinline__ unsigned ld_sc1(const unsigned* p) { return __hip_atomic_load(p, __ATOMIC_RELAXED, __HIP_MEMORY_SCOPE_AGENT); }
constexpr int DSA_TOPK = 256;
constexpr int DL_K = 0;
constexpr int DL_V = 34816;
constexpr int DL_SET = 69632;
constexpr int DL_MASK = 139264;
constexpr int DL_END = 147456;
__device__ __forceinline__ int wave_sum_dpp(int v) {
    v += __builtin_amdgcn_update_dpp(0, v, 0xB1, 0xf, 0xf, false);
    v += __builtin_amdgcn_update_dpp(0, v, 0x4E, 0xf, 0xf, false);
    v += __builtin_amdgcn_update_dpp(0, v, 0x141, 0xf, 0xf, false);
    v += __builtin_amdgcn_update_dpp(0, v, 0x140, 0xf, 0xf, false);
    v += __builtin_amdgcn_update_dpp(0, v, 0x142, 0xa, 0xf, false);
    v += __builtin_amdgcn_update_dpp(0, v, 0x143, 0xc, 0xf, false);
    return __builtin_amdgcn_readlane(v, 63);
}
template <int J, unsigned M> __device__ __forceinline__ void bt_stage(unsigned (&a)[32]) {
#pragma unroll
    for (int base = 0; base < 32; base += 2 * J)
#pragma unroll
        for (int o = 0; o < J; ++o) { const int k = base + o; const unsigned t = (a[k] ^ (a[k + J] >> J)) & M; a[k] ^= t; a[k + J] ^= (t << J); }
}
template <bool EXTRA>
__device__ __forceinline__ unsigned topk_bits(const unsigned (&u)[32], unsigned x, bool& xsel, int lane) {
    unsigned P[32]; unsigned A = 0u;
#pragma unroll
    for (int i = 0; i < 32; ++i) { P[i] = u[i]; A |= (u[i] != 0u) ? (0x80000000u >> i) : 0u; }
    bt_stage<16, 0x0000FFFFu>(P); bt_stage<8, 0x00FF00FFu>(P); bt_stage<4, 0x0F0F0F0Fu>(P); bt_stage<2, 0x33333333u>(P); bt_stage<1, 0x55555555u>(P);
    unsigned G = 0u; int above = 0; bool xa = EXTRA && (x != 0u), xg = false;
#pragma unroll
    for (int b = 31; b >= 0; --b) {
        const unsigned pl = P[31 - b], Mm = A & pl;
        const bool xb = EXTRA && xa && ((x >> b) & 1u);
        const int c1 = wave_sum_dpp(__builtin_popcount(Mm) + (xb ? 1 : 0));
        const bool take = (above + c1) >= DSA_TOPK;
        if (take) { A = Mm; if (EXTRA) xa = xb; }
        else { above += c1; G |= Mm; A &= ~pl; if (EXTRA) { xg = xg || xb; xa = xa && !xb; } }
    }
    const int need = DSA_TOPK - above;
    const int ties = wave_sum_dpp(__builtin_popcount(A) + ((EXTRA && xa) ? 1 : 0));
    unsigned SEL = G | A; xsel = xg || xa;
    if (ties > need) {
        int run = 0; const unsigned long long lt = (1ull << lane) - 1ull;
        SEL = G;
#pragma unroll 1
        for (int i = 0; i < 32; ++i) {
            const bool eq = (A >> (31 - i)) & 1u; const unsigned long long me = __ballot(eq);
            const int pre = run + __builtin_popcountll(me & lt); run += __builtin_popcountll(me);
            if (eq && pre < need) SEL |= (0x80000000u >> i);
        }
        if (EXTRA) { const unsigned long long me = __ballot(xa); const int pre = run + __builtin_popcountll(me & lt); xsel = xg || (xa && pre < need); }
    }
    return SEL;
}
struct DsaP { const bf16 *QB, *KB, *VT, *IQ, *IK; const float* IW; float* SCR; bf16* OD; };
__device__ __forceinline__ void dsa_prompt_item(Frame& F, const DsaP& W, int b, int qb) {
    int tid = F.tid; asm volatile("" : "+v"(tid));
    const int lane = tid & 63, w = __builtin_amdgcn_readfirstlane(tid >> 6), r32 = lane & 31, hh = lane >> 5;
    const int t0 = 32 * qb, m0 = b * TP + t0, nk = t0 + 32, ntile = (nk + 63) >> 6;
    LAS unsigned* maskb = (LAS unsigned*)(F.lds + DL_MASK);
    float* scr = W.SCR + (size_t)F.bid * 32 * 2048;
    WG_SYNC();
    {
        bf16x8 aq[4];
#pragma unroll
        for (int ks = 0; ks < 4; ++ks) aq[ks] = *(const GAS bf16x8*)(W.IQ + (size_t)(m0 + 4 * w + (r32 >> 3)) * 512 + (r32 & 7) * 64 + 16 * ks + 8 * hh);
        float wq[4][4];
#pragma unroll
        for (int g = 0; g < 4; ++g) { const f32x4 t = *(const f32x4*)(W.IW + (size_t)(m0 + 4 * w + g) * 8 + 4 * hh); wq[g][0] = t.x; wq[g][1] = t.y; wq[g][2] = t.z; wq[g][3] = t.w; }
        const int nkt = nk >> 5, nch = (nk + 511) >> 9;
        const bf16* ikb = W.IK + (size_t)(b * TP) * 64 + (size_t)tid * 8;
        LAS unsigned char* ikl = F.lds + ((tid >> 3) * 144 + (tid & 7) * 16);
        v4u pf8[8];
#pragma unroll
        for (int i = 0; i < 8; ++i) pf8[i] = *(const GAS v4u*)(ikb + (size_t)i * 64 * 64);
#pragma unroll 1
        for (int ch = 0; ch < nch; ++ch) {
            WG_SYNC();
#pragma unroll
            for (int i = 0; i < 8; ++i) *(LAS v4u*)(ikl + i * 64 * 144) = pf8[i];
            WG_SYNC();
            if (ch + 1 < nch) {
#pragma unroll
                for (int i = 0; i < 8; ++i) pf8[i] = *(const GAS v4u*)(ikb + (size_t)((ch + 1) * 512 + i * 64) * 64);
            }
            const int t1 = (nkt - 16 * ch) < 16 ? (nkt - 16 * ch) : 16;
#pragma unroll 1
            for (int tp = 0; tp < t1; tp += 2) {
                bf16x8 bk[2][4];
#pragma unroll
                for (int t2 = 0; t2 < 2; ++t2)
#pragma unroll
                    for (int ks = 0; ks < 4; ++ks) bk[t2][ks] = *(const LAS bf16x8*)(F.lds + (32 * (tp + t2) + r32) * 144 + 32 * ks + 16 * hh);
                __builtin_amdgcn_sched_barrier(0);
                f32x16 acc[2] = {{}, {}};
#pragma unroll
                for (int ks = 0; ks < 4; ++ks) { acc[0] = mfma32(aq[ks], bk[0][ks], acc[0]); acc[1] = mfma32(aq[ks], bk[1][ks], acc[1]); }
#pragma unroll
                for (int t2 = 0; t2 < 2; ++t2) {
                    const int kt = 16 * ch + tp + t2;
#pragma unroll
                    for (int g = 0; g < 4; ++g) {
                        float s = wq[g][0] * fmaxf(acc[t2][4 * g], 0.f) + wq[g][1] * fmaxf(acc[t2][4 * g + 1], 0.f) + wq[g][2] * fmaxf(acc[t2][4 * g + 2], 0.f) + wq[g][3] * fmaxf(acc[t2][4 * g + 3], 0.f);
                        s = xh_sum(s);
                        if (hh == (g >> 1) && kt < nkt) scr[(size_t)(4 * w + g) * 2048 + 32 * kt + r32] = s;
                    }
                }
            }
        }
    }
    asm volatile("s_waitcnt vmcnt(0)" ::: "memory");
    unsigned xr[32];
    { const unsigned* srow = (const unsigned*)(scr + (size_t)(4 * w) * 2048);
#pragma unroll
      for (int i = 0; i < 32; ++i) xr[i] = ld_sc1(srow + i * 64 + lane); }
#pragma unroll 1
    for (int g = 0; g < 4; ++g) {
        const int q = 4 * w + g, p = t0 + q;
        unsigned u[32];
#pragma unroll
        for (int i = 0; i < 32; ++i) { const int s = i * 64 + lane; u[i] = (s <= p) ? sortkey(__uint_as_float(xr[i])) : 0u; }
        if (g < 3) { const unsigned* srow = (const unsigned*)(scr + (size_t)(q + 1) * 2048);
#pragma unroll
            for (int i = 0; i < 32; ++i) xr[i] = ld_sc1(srow + i * 64 + lane); }
        unsigned SEL;
        if (p + 1 <= DSA_TOPK) {
            SEL = 0u;
#pragma unroll
            for (int i = 0; i < 32; ++i) SEL |= (u[i] != 0u) ? (0x80000000u >> i) : 0u;
        } else { bool xs_; SEL = topk_bits<false>(u, 0u, xs_, lane); }
#pragma unroll
        for (int i = 0; i < 32; ++i) { const unsigned long long mk = __ballot((SEL >> (31 - i)) & 1u); if (lane == 0) { maskb[(q * 32 + i) * 2] = (unsigned)mk; maskb[(q * 32 + i) * 2 + 1] = (unsigned)(mk >> 32); } }
    }
    const int kvh = w >> 2;
    bf16x8 qf[8];
#pragma unroll
    for (int ks = 0; ks < 8; ++ks) qf[ks] = *(const GAS bf16x8*)(W.QB + (size_t)(m0 + r32) * 1024 + w * 128 + 16 * ks + 8 * hh);
    f32x16 o[4];
#pragma unroll
    for (int d = 0; d < 4; ++d) o[d] = (f32x16){};
    float mrun = -1e30f, lrun = 0.f;
    v4u pre[8];
    const unsigned koff = (unsigned)((tid >> 4) * 256 + (tid & 15) * 8), voff = (unsigned)((tid >> 3) * TP + (tid & 7) * 8);
    const unsigned klds = (unsigned)(DL_K + (tid >> 4) * 272 + (tid & 15) * 16), vlds = (unsigned)(DL_V + (tid >> 3) * 136 + (tid & 7) * 16);
#define DSA_LOAD_TILE(kt_) do { \
        const bf16* kb_ = W.KB + (size_t)(b * TP + 64 * (kt_)) * 256; const bf16* vb_ = W.VT + (size_t)(b * 2) * 128 * TP + 64 * (kt_); \
        _Pragma("unroll") for (int i = 0; i < 4; ++i) { \
            pre[i] = *(const GAS v4u*)(kb_ + ((i & 1) * 32 * 256 + (i >> 1) * 128) + koff); \
            pre[4 + i] = *(const GAS v4u*)(vb_ + (size_t)((i >> 1) * 128 + (i & 1) * 64) * TP + voff); } } while (0)
    DSA_LOAD_TILE(0);
    const LAS bf16* Kl0 = (const LAS bf16*)(F.lds + DL_K) + kvh * 64 * 136;
    const LAS bf16* Vl0 = (const LAS bf16*)(F.lds + DL_V) + kvh * 128 * 68;
#define DSA_STORE_TILE(set_) do { const unsigned so_ = (unsigned)(set_) * DL_SET; \
        _Pragma("unroll") for (int i = 0; i < 4; ++i) { \
            *(LAS v4u*)(F.lds + so_ + klds + ((i >> 1) * 64 + (i & 1) * 32) * 272) = pre[i]; \
            { LAS u32x2v* vd_ = (LAS u32x2v*)(F.lds + so_ + vlds + ((i >> 1) * 128 + (i & 1) * 64) * 136); vd_[0] = (u32x2v){pre[4 + i].x, pre[4 + i].y}; vd_[1] = (u32x2v){pre[4 + i].z, pre[4 + i].w}; } } } while (0)
    WG_SYNC();
    DSA_STORE_TILE(0);
    WG_SYNC();
    if (1 < ntile) DSA_LOAD_TILE(1);
#pragma unroll 1
    for (int kt = 0; kt < ntile; ++kt) {
        const LAS bf16* Kl = Kl0 + (kt & 1) * (DL_SET / 2); const LAS bf16* Vl = Vl0 + (kt & 1) * (DL_SET / 2);
        f32x16 p0 = {}, p1 = {};
#pragma unroll
        for (int kh = 0; kh < 2; ++kh) {
            bf16x8 fr[8];
#pragma unroll
            for (int k4 = 0; k4 < 4; ++k4) { fr[2 * k4] = *(const LAS bf16x8*)(Kl + r32 * 136 + 16 * (4 * kh + k4) + 8 * hh); fr[2 * k4 + 1] = *(const LAS bf16x8*)(Kl + (32 + r32) * 136 + 16 * (4 * kh + k4) + 8 * hh); }
            __builtin_amdgcn_sched_barrier(0);
#pragma unroll
            for (int k4 = 0; k4 < 4; ++k4) { p0 = mfma32(fr[2 * k4], qf[4 * kh + k4], p0); p1 = mfma32(fr[2 * k4 + 1], qf[4 * kh + k4], p1); }
        }
        const unsigned mlo = maskb[(r32 * 32 + kt) * 2] >> (4 * hh), mhi = maskb[(r32 * 32 + kt) * 2 + 1] >> (4 * hh);
        float mx = -INFINITY;
#pragma unroll
        for (int r = 0; r < 16; ++r) { const int pos = (r & 3) + 8 * (r >> 2);
            p0[r] = ((mlo >> pos) & 1u) ? p0[r] : -INFINITY; p1[r] = ((mhi >> pos) & 1u) ? p1[r] : -INFINITY;
            mx = fmaxf(mx, fmaxf(p0[r], p1[r])); }
        mx = xh_max(mx);
        const float mnew = fmaxf(mrun, mx), alpha = __builtin_amdgcn_exp2f(mrun - mnew);
        mrun = mnew;
        float ls = 0.f;
#pragma unroll
        for (int r = 0; r < 16; ++r) { p0[r] = __builtin_amdgcn_exp2f(p0[r] - mnew); p1[r] = __builtin_amdgcn_exp2f(p1[r] - mnew); ls += p0[r] + p1[r]; }
        ls = xh_sum(ls);
        lrun = lrun * alpha + ls;
        if (__builtin_amdgcn_ballot_w64(alpha != 1.0f)) {
#pragma unroll
            for (int d = 0; d < 4; ++d) o[d] = o[d] * alpha;
        }
        bf16x8 pf[4];
        pf[0] = __builtin_bit_cast(bf16x8, (v4u){pk2(p0[0], p0[1]), pk2(p0[2], p0[3]), pk2(p0[4], p0[5]), pk2(p0[6], p0[7])});
        pf[1] = __builtin_bit_cast(bf16x8, (v4u){pk2(p0[8], p0[9]), pk2(p0[10], p0[11]), pk2(p0[12], p0[13]), pk2(p0[14], p0[15])});
        pf[2] = __builtin_bit_cast(bf16x8, (v4u){pk2(p1[0], p1[1]), pk2(p1[2], p1[3]), pk2(p1[4], p1[5]), pk2(p1[6], p1[7])});
        pf[3] = __builtin_bit_cast(bf16x8, (v4u){pk2(p1[8], p1[9]), pk2(p1[10], p1[11]), pk2(p1[12], p1[13]), pk2(p1[14], p1[15])});
#pragma unroll
        for (int dd = 0; dd < 4; ++dd) {
            bf16x8 fr[4];
            const LAS bf16* vr = Vl + (32 * dd + r32) * 68 + 4 * hh;
#pragma unroll
            for (int s = 0; s < 4; ++s) { const u32x2v a = *(const LAS u32x2v*)(vr + 16 * s), c = *(const LAS u32x2v*)(vr + 16 * s + 8); fr[s] = __builtin_bit_cast(bf16x8, (v4u){a.x, a.y, c.x, c.y}); }
            __builtin_amdgcn_sched_barrier(0);
#pragma unroll
            for (int s = 0; s < 4; ++s) o[dd] = mfma32(fr[s], pf[s], o[dd]);
        }
        if (kt + 1 < ntile) DSA_STORE_TILE((kt + 1) & 1);
        WG_SYNC();
        if (kt + 2 < ntile) DSA_LOAD_TILE(kt + 2);
    }
#undef DSA_STORE_TILE
#undef DSA_LOAD_TILE
    const float inv = 1.0f / lrun;
    bf16* od = W.OD + (size_t)(m0 + r32) * 2048 + 1024 + w * 128;
#pragma unroll
    for (int d = 0; d < 4; ++d)
#pragma unroll
        for (int rg = 0; rg < 4; ++rg) gst4bf(od + 32 * d + 8 * rg + 4 * hh, o[d][4 * rg] * inv, o[d][4 * rg + 1] * inv, o[d][4 * rg + 2] * inv, o[d][4 * rg + 3] * inv);
}
struct DsaS { const bf16 *QB, *IQ, *IK; const float* IW; const float *cache_k, *cache_v, *cache_ik; const int* page_table; const float* knew; const float* vnew; bf16* OD; };
constexpr int SL_SC = 0;
constexpr int SL_LIST = 33792;
constexpr int SL_Q = 37888;
constexpr int SL_P = 54272;
constexpr int SL_KT = 87040;
constexpr int SL_SN = 121856;
constexpr int SL_END = 87040;
__device__ __forceinline__ void dsa_sample_item(Frame& F, const DsaS& W, int db) {
    int tid = F.tid; asm volatile("" : "+v"(tid));
    const int lane = tid & 63, w = __builtin_amdgcn_readfirstlane(tid >> 6), r32 = lane & 31, hh = lane >> 5;
    const int m0 = NPR + 4 * db;
    LAS float* sc = (LAS float*)(F.lds + SL_SC);
    LAS unsigned* list = (LAS unsigned*)(F.lds + SL_LIST);
    const int* pt = W.page_table + db * 16;
    WG_SYNC();
    {
        bf16x8 aq[4];
#pragma unroll
        for (int ks = 0; ks < 4; ++ks) aq[ks] = *(const GAS bf16x8*)(W.IQ + (size_t)(m0 + (r32 >> 3)) * 512 + (r32 & 7) * 64 + 16 * ks + 8 * hh);
        float wq[4][4];
#pragma unroll
        for (int g = 0; g < 4; ++g) { const f32x4 t = *(const f32x4*)(W.IW + (size_t)(m0 + g) * 8 + 4 * hh); wq[g][0] = t.x; wq[g][1] = t.y; wq[g][2] = t.z; wq[g][3] = t.w; }
        f32x4 raw[3][8];
#define SMP_LOAD(sl_, kt_) do { const int s_ = 32 * (kt_) + r32; const float* src_ = W.cache_ik + ((size_t)pt[s_ >> 7] * 128 + (s_ & 127)) * 64 + 8 * hh; \
        _Pragma("unroll") for (int ks = 0; ks < 4; ++ks) { raw[sl_][2 * ks] = *(const GAS f32x4*)(src_ + 16 * ks); raw[sl_][2 * ks + 1] = *(const GAS f32x4*)(src_ + 16 * ks + 4); } } while (0)
#define SMP_SCORE(kt_) do { f32x16 acc = {}; \
        _Pragma("unroll") for (int ks = 0; ks < 4; ++ks) acc = mfma32(aq[ks], bk[ks], acc); \
        _Pragma("unroll") for (int g = 0; g < 4; ++g) { \
            float v = wq[g][0] * fmaxf(acc[4 * g], 0.f) + wq[g][1] * fmaxf(acc[4 * g + 1], 0.f) + wq[g][2] * fmaxf(acc[4 * g + 2], 0.f) + wq[g][3] * fmaxf(acc[4 * g + 3], 0.f); \
            v = xh_sum(v); \
            if (hh == (g >> 1)) sc[g * 2112 + 32 * (kt_) + r32] = v; } } while (0)
        SMP_LOAD(0, w); SMP_LOAD(1, w + 8); SMP_LOAD(2, w + 16);
#pragma unroll
        for (int i = 0; i < 8; ++i) {
            const int kt = w + 8 * i;
            bf16x8 bk[4];
#pragma unroll
            for (int ks = 0; ks < 4; ++ks) bk[ks] = __builtin_bit_cast(bf16x8, (v4u){pk2(raw[i % 3][2 * ks].x, raw[i % 3][2 * ks].y), pk2(raw[i % 3][2 * ks].z, raw[i % 3][2 * ks].w), pk2(raw[i % 3][2 * ks + 1].x, raw[i % 3][2 * ks + 1].y), pk2(raw[i % 3][2 * ks + 1].z, raw[i % 3][2 * ks + 1].w)});
            if (i < 5) SMP_LOAD(i % 3, kt + 24);
            SMP_SCORE(kt);
        }
        if (w < 2) {
            const int kt = 64 + w; const int s = 32 * kt + r32;
            bf16x8 bk[4];
#pragma unroll
            for (int ks = 0; ks < 4; ++ks) bk[ks] = (s < 2052) ? *(const GAS bf16x8*)(W.IK + (size_t)(m0 + s - 2048) * 64 + 16 * ks + 8 * hh) : (bf16x8){0, 0, 0, 0, 0, 0, 0, 0};
            SMP_SCORE(kt);
        }
#undef SMP_LOAD
#undef SMP_SCORE
        { const int q = w >> 1, kvh = w & 1; LAS float* qs = (LAS float*)(F.lds + SL_Q) + w * 512;
#pragma unroll
          for (int i = 0; i < 8; ++i) { const int idx = lane + 64 * i; qs[idx] = bf2f(W.QB[(size_t)(m0 + q) * 1024 + kvh * 512 + idx]); } }
    }
    WG_SYNC();
    if (w < 4) {
        const int p = 2048 + w;
        unsigned u[32];
#pragma unroll
        for (int i = 0; i < 32; ++i) u[i] = sortkey(sc[w * 2112 + i * 64 + lane]);
        const unsigned x = (2048 + lane <= p) ? sortkey(sc[w * 2112 + 2048 + lane]) : 0u;
        bool xsel; const unsigned SEL = topk_bits<true>(u, x, xsel, lane);
        int base = 0; const unsigned long long lt = (1ull << lane) - 1ull;
#pragma unroll
        for (int i = 0; i < 32; ++i) {
            const bool sel = (SEL >> (31 - i)) & 1u; const unsigned long long mk = __ballot(sel);
            if (sel) { const int s = i * 64 + lane; list[w * 256 + base + __builtin_popcountll(mk & lt)] = (unsigned)(pt[s >> 7] * 128 + (s & 127)); }
            base += __builtin_popcountll(mk);
        }
        { const unsigned long long mk = __ballot(xsel); if (xsel) list[w * 256 + base + __builtin_popcountll(mk & lt)] = 0x80000000u | (unsigned)lane; }
    }
    WG_SYNC();
    {
        const int q = w >> 1, kvh = w & 1, l15 = lane & 15, g4 = lane >> 4;
        const LAS float* qs = (const LAS float*)(F.lds + SL_Q) + w * 512;
        LAS float* pl = (LAS float*)(F.lds + SL_P) + w * 1024;
        const LAS unsigned* lq = list + q * 256;
        LAS bf16* kt = (LAS bf16*)(F.lds + SL_KT) + w * (16 * 136);
        LAS float* sn = (LAS float*)(F.lds + SL_SN) + w * 32;
        bf16x8 aq[4];
#pragma unroll
        for (int ks = 0; ks < 4; ++ks) aq[ks] = *(const GAS bf16x8*)(W.QB + (size_t)(m0 + q) * 1024 + kvh * 512 + (l15 & 3) * 128 + 32 * ks + 8 * g4);
        f32x4 rg[4][8];
#define G_LD(base_, sl_, b_) do { const v4u e0_ = *(const LAS v4u*)(lq + 16 * (b_) + 8 * hh), e1_ = *(const LAS v4u*)(lq + 16 * (b_) + 8 * hh + 4); \
            const unsigned oo_ = 16u * (unsigned)r32; \
            rg[sl_][0] = *(const GAS f32x4*)((base_) + (((e0_.x & 0x7fffffffu) << 10) + oo_)); rg[sl_][1] = *(const GAS f32x4*)((base_) + (((e0_.y & 0x7fffffffu) << 10) + oo_)); \
            rg[sl_][2] = *(const GAS f32x4*)((base_) + (((e0_.z & 0x7fffffffu) << 10) + oo_)); rg[sl_][3] = *(const GAS f32x4*)((base_) + (((e0_.w & 0x7fffffffu) << 10) + oo_)); \
            rg[sl_][4] = *(const GAS f32x4*)((base_) + (((e1_.x & 0x7fffffffu) << 10) + oo_)); rg[sl_][5] = *(const GAS f32x4*)((base_) + (((e1_.y & 0x7fffffffu) << 10) + oo_)); \
            rg[sl_][6] = *(const GAS f32x4*)((base_) + (((e1_.z & 0x7fffffffu) << 10) + oo_)); rg[sl_][7] = *(const GAS f32x4*)((base_) + (((e1_.w & 0x7fffffffu) << 10) + oo_)); \
            __builtin_amdgcn_sched_barrier(0); } while (0)
        {
            const GAS char* kbase = (const GAS char*)(W.cache_k + kvh * 128);
#define K_USE(sl_, b_) do { _Pragma("unroll") for (int jj = 0; jj < 8; ++jj) *(LAS u32x2v*)(kt + (8 * hh + jj) * 136 + 4 * r32) = (u32x2v){pk2(rg[sl_][jj].x, rg[sl_][jj].y), pk2(rg[sl_][jj].z, rg[sl_][jj].w)}; \
            bf16x8 bk_[4]; _Pragma("unroll") for (int ks = 0; ks < 4; ++ks) bk_[ks] = *(const LAS bf16x8*)(kt + l15 * 136 + 32 * ks + 8 * g4); \
            f32x4 sa_ = (f32x4){0.f, 0.f, 0.f, 0.f}; _Pragma("unroll") for (int ks = 0; ks < 4; ++ks) sa_ = mfma16(aq[ks], bk_[ks], sa_); \
            if (g4 == 0) { pl[16 * (b_) + l15] = sa_.x; pl[256 + 16 * (b_) + l15] = sa_.y; pl[512 + 16 * (b_) + l15] = sa_.z; pl[768 + 16 * (b_) + l15] = sa_.w; } \
            __builtin_amdgcn_sched_barrier(0); } while (0)
            G_LD(kbase, 0, 0); G_LD(kbase, 1, 1); G_LD(kbase, 2, 2);
#pragma unroll 1
            for (int b = 0; b < 16; b += 4) {
                G_LD(kbase, 3, b + 3); K_USE(0, b);
                G_LD(kbase, 0, (b + 4) & 15); K_USE(1, b + 1);
                G_LD(kbase, 1, (b + 5) & 15); K_USE(2, b + 2);
                G_LD(kbase, 2, (b + 6) & 15); K_USE(3, b + 3);
            }
#undef K_USE
        }
        { const int n = lane >> 4; const float* kn = W.knew + (size_t)(4 * db + n) * 256 + kvh * 128 + 8 * l15;
          const f32x4 k0 = *(const GAS f32x4*)kn, k1 = *(const GAS f32x4*)(kn + 4);
          if (lane < 16) sn[16 + lane] = 0.f;
#pragma unroll
          for (int h = 0; h < 4; ++h) { const f32x4 q0 = *(const LAS f32x4*)(qs + h * 128 + 8 * l15), q1 = *(const LAS f32x4*)(qs + h * 128 + 8 * l15 + 4);
              float s = k0.x * q0.x + k0.y * q0.y + k0.z * q0.z + k0.w * q0.w + k1.x * q1.x + k1.y * q1.y + k1.z * q1.z + k1.w * q1.w;
              s = row16_sum(s); if (l15 == 0) sn[h * 4 + n] = s; } }
        { const unsigned ro3 = lq[192 + lane]; const bool fl = (ro3 >> 31) != 0u; const int nn = (int)(ro3 & 3u);
#pragma unroll
          for (int h = 0; h < 4; ++h) {
            const float s0 = pl[h * 256 + lane], s1 = pl[h * 256 + 64 + lane], s2 = pl[h * 256 + 128 + lane]; float s3 = pl[h * 256 + 192 + lane];
            const float sx = sn[h * 4 + nn]; s3 = fl ? sx : s3;
            float mx = fmaxf(fmaxf(s0, s1), fmaxf(s2, s3));
#pragma unroll
            for (int o = 1; o < 64; o <<= 1) mx = fmaxf(mx, __shfl_xor(mx, o));
            const float e0 = __builtin_amdgcn_exp2f(s0 - mx), e1 = __builtin_amdgcn_exp2f(s1 - mx), e2 = __builtin_amdgcn_exp2f(s2 - mx), e3 = __builtin_amdgcn_exp2f(s3 - mx);
            const float inv = 1.0f / wave_sum(e0 + e1 + e2 + e3);
            pl[h * 256 + lane] = e0 * inv; pl[h * 256 + 64 + lane] = e1 * inv; pl[h * 256 + 128 + lane] = e2 * inv; pl[h * 256 + 192 + lane] = fl ? 0.f : e3 * inv;
            if (fl) sn[16 + h * 4 + nn] = e3 * inv;
          } }
        asm volatile("s_waitcnt lgkmcnt(0)" ::: "memory");
        f32x4 o0 = (f32x4){0.f, 0.f, 0.f, 0.f}, o1 = o0, o2 = o0, o3 = o0;
        {
            const GAS char* vbase = (const GAS char*)(W.cache_v + kvh * 128);
#define V_USE(sl_, b_) do { const LAS float* pp_ = pl + 16 * (b_) + 8 * hh; \
            const f32x4 pa0 = *(const LAS f32x4*)pp_, pb0 = *(const LAS f32x4*)(pp_ + 4), pa1 = *(const LAS f32x4*)(pp_ + 256), pb1 = *(const LAS f32x4*)(pp_ + 260); \
            const f32x4 pa2 = *(const LAS f32x4*)(pp_ + 512), pb2 = *(const LAS f32x4*)(pp_ + 516), pa3 = *(const LAS f32x4*)(pp_ + 768), pb3 = *(const LAS f32x4*)(pp_ + 772); \
            _Pragma("unroll") for (int jj = 0; jj < 4; ++jj) { o0 += rg[sl_][jj] * pa0[jj]; o1 += rg[sl_][jj] * pa1[jj]; o2 += rg[sl_][jj] * pa2[jj]; o3 += rg[sl_][jj] * pa3[jj]; } \
            _Pragma("unroll") for (int jj = 0; jj < 4; ++jj) { o0 += rg[sl_][4 + jj] * pb0[jj]; o1 += rg[sl_][4 + jj] * pb1[jj]; o2 += rg[sl_][4 + jj] * pb2[jj]; o3 += rg[sl_][4 + jj] * pb3[jj]; } \
            __builtin_amdgcn_sched_barrier(0); } while (0)
            G_LD(vbase, 0, 0); G_LD(vbase, 1, 1); G_LD(vbase, 2, 2);
#pragma unroll 1
            for (int b = 0; b < 16; b += 4) {
                G_LD(vbase, 3, b + 3); V_USE(0, b);
                G_LD(vbase, 0, (b + 4) & 15); V_USE(1, b + 1);
                G_LD(vbase, 1, (b + 5) & 15); V_USE(2, b + 2);
                G_LD(vbase, 2, (b + 6) & 15); V_USE(3, b + 3);
            }
#undef V_USE
#undef G_LD
#pragma unroll
            for (int t = 0; t < 2; ++t) { const int n = 2 * hh + t; const f32x4 vn = *(const GAS f32x4*)(W.vnew + (size_t)(4 * db + n) * 256 + kvh * 128 + 4 * r32);
                o0 += vn * sn[16 + n]; o1 += vn * sn[16 + 4 + n]; o2 += vn * sn[16 + 8 + n]; o3 += vn * sn[16 + 12 + n]; }
        }
#define XH(v_) do { v_.x = xh_sum(v_.x); v_.y = xh_sum(v_.y); v_.z = xh_sum(v_.z); v_.w = xh_sum(v_.w); } while (0)
        XH(o0); XH(o1); XH(o2); XH(o3);
#undef XH
        bf16* od = W.OD + (size_t)(m0 + q) * 2048 + 1024 + kvh * 512 + 4 * r32;
        if (hh == 0) { gst4bf(od, o0.x, o0.y, o0.z, o0.w); gst4bf(od + 128, o1.x, o1.y, o1.z, o1.w); }
        else { gst4bf(od + 256, o2.x, o2.y, o2.z, o2.w); gst4bf(od + 384, o3.x, o3.y, o3.z, o3.w); }
    }
}
#ifndef MK_N_LAUNCHES
#define MK_N_LAUNCHES 1
#endif
constexpr int N_PHASES = 13;
__global__ void __launch_bounds__(NWAVES * 64, 2) mk_fwd(Args args) {
    extern __shared__ __attribute__((aligned(16))) unsigned char lds[];
    Frame F;
    F.lds = (LAS unsigned char*)lds;
    F.tid = threadIdx.x; F.lane = F.tid & 63; F.wave = __builtin_amdgcn_readfirstlane(F.tid >> 6);
    F.G = gridDim.x; F.bid = blockIdx.x;
    unsigned char* ws = args.ws;
    F.ctl = (gu32*)(ws + WS_CTL);
    volatile LAS unsigned* MISC = (volatile LAS unsigned*)(F.lds + MISC_OFF);
    for (int u = F.tid; u < (LDS_BYTES - LDSCTL_OFF) / 4; u += NWAVES * 64) ((LAS unsigned*)(F.lds + LDSCTL_OFF))[u] = 0u;
    __syncthreads();
    XcdBarrier bar; bar.bar = (unsigned*)(F.ctl + CW_BAR); bar.x = 0; bar.st = nullptr;
    if (MK_N_LAUNCHES == 1) bar = xcd_barrier_post((unsigned*)(F.ctl + CW_BAR), MISC + 8);
    const int lo = args.ph_lo, hi = args.ph_hi;
#if defined(MK_STAMP)
    if (F.bid == 0 && F.tid == 0) ((volatile LAS unsigned long long*)(F.lds + LDSCTL_OFF + 512))[0] = __builtin_amdgcn_s_memrealtime();
#endif
#define IN(k) (lo <= (k) && (k) < hi)
#define PHASE_BEGIN() do { int t_ = F.tid; asm volatile("" : "+v"(t_)); F.tid = t_; F.lane = t_ & 63; } while (0)
#if defined(MK_STAMP)
#define SEAM(k) do { if (IN(k) && IN((k) + 1)) xcd_barrier(bar); if (F.bid == 0 && F.tid == 0) ((volatile LAS unsigned long long*)(F.lds + LDSCTL_OFF + 512))[(k) + 1] = __builtin_amdgcn_s_memrealtime(); } while (0)
#else
#define SEAM(k) do { if (IN(k) && IN((k) + 1)) xcd_barrier(bar); } while (0)
#endif
    const float* x_prompt = args.in[0]; const float* x_sample = args.in[1]; const float* c_prompt = args.in[2]; const float* c_sample = args.in[3];
    const float* cache_k = args.in[4]; const float* cache_v = args.in[5]; const float* cache_ik = args.in[6]; const int* page_table = (const int*)args.in[7];
    const float* state_gdn = args.in[8]; const float* state_gconv = args.in[9]; const float* state_fconv = args.in[10];
    const float* w_ada = args.in[11]; const float* b_ada = args.in[12]; const float* g_norm1 = args.in[13]; const float* w_in = args.in[14];
    const float* w_gconv = args.in[15]; const float* a_log = args.in[16]; const float* dt_bias = args.in[17]; const float* g_gnorm = args.in[18];
    const float* w_gout = args.in[19]; const float* w_dout = args.in[20]; const float* w_o = args.in[21]; const float* g_norm2 = args.in[22];
    const float* w_up = args.in[23]; const float* w_fconv = args.in[24]; const float* b_fconv = args.in[25]; const float* w_down = args.in[26]; const float* g_final = args.in[27];
    float* out = args.out;
    f32x2v* ROPE = (f32x2v*)(ws + WS_ROPE); float* ADA = (float*)(ws + WS_ADA);
    bf16* WIN = (bf16*)(ws + WS_WIN); bf16* WG = (bf16*)(ws + WS_WG); bf16* WD = (bf16*)(ws + WS_WD); bf16* WO = (bf16*)(ws + WS_WO);
    bf16* WUP = (bf16*)(ws + WS_WUP); bf16* WDN = (bf16*)(ws + WS_WDN);
    bf16* H = (bf16*)(ws + WS_H); bf16* Y1 = (bf16*)(ws + WS_Y1);
    bf16* QB = (bf16*)(ws + WS_QB); bf16* KB = (bf16*)(ws + WS_KB); bf16* VT = (bf16*)(ws + WS_VT); bf16* IQ = (bf16*)(ws + WS_IQ); bf16* IK = (bf16*)(ws + WS_IK);
    float* IW = (float*)(ws + WS_IW);
    bf16* OG = (bf16*)(ws + WS_OG); bf16* OD = (bf16*)(ws + WS_OD); bf16* MIX = (bf16*)(ws + WS_MIX); bf16* X1 = (bf16*)(ws + WS_X1);
    bf16* U = (bf16*)(ws + WS_U); bf16* ACT = (bf16*)(ws + WS_ACT);
#if defined(MK_DIAG)
    bf16* H2 = (bf16*)(ws + (size_t)1000 * MiB); bf16* X2 = (bf16*)(ws + (size_t)1040 * MiB);
#else
    bf16* H2 = H; bf16* X2 = (bf16*)(ws + WS_Y1);
#endif
    const int gw = F.bid * NWAVES + F.wave, NGW = F.G * NWAVES;
    (void)cache_k; (void)cache_v; (void)cache_ik; (void)page_table; (void)state_gdn; (void)state_gconv; (void)w_gconv; (void)a_log; (void)dt_bias; (void)g_gnorm;
    (void)QB; (void)KB; (void)VT; (void)IQ; (void)IK; (void)IW;

    if (IN(0)) {
        PHASE_BEGIN();
        SUB0(); p0_silu(F, c_prompt, c_sample, (bf16*)(ws + WS_ABF), (unsigned*)(F.ctl + CW_ABF));
        p0_rope(F, args, ROPE);
        transpose_all(F, w_in, DM, 10328, NIN, WIN, MapIn()); SUB(1);
        p0_ada(F, (const bf16*)(ws + WS_ABF), (unsigned*)(F.ctl + CW_ABF), (unsigned*)(F.ctl + CW_BAR), w_ada, b_ada, ADA); SUB(0);
    }
    SEAM(0);
    if (IN(1)) {
        PHASE_BEGIN();
        SUB0();
        norm_mod_pass<false>(F, [&](int m) { return (const void*)(m < NPR ? x_prompt + (size_t)m * DM : x_sample + (size_t)(m - NPR) * DM); }, g_norm1, ADA, 0, 2048, H);
        SUB(2);
    }
    SEAM(1);
#define WDN_DRAIN(maxp_) do { volatile LAS unsigned* qs_ = (volatile LAS unsigned*)(F.lds + LDSCTL_OFF); LAS float* scr_ = (LAS float*)(F.lds + RING_OFF + F.wave * 16640); \
        for (int np_ = 0; np_ < (maxp_); ++np_) { WG_SYNC(); if (F.tid == 0) qs_[0] = __hip_atomic_fetch_add(F.ctl + CW_QUEUE + 448, 1u, RLX_AGENT); WG_SYNC(); \
            const int it_ = 8 * (int)qs_[0] + F.wave; if (it_ - F.wave >= 2816) break; \
            transpose_item(w_down, FF, DM, WDN, scr_, it_ / 32, it_ % 32, F.lane, MapId()); } } while (0)
    if (IN(2)) {
        PHASE_BEGIN();
        pg8::Gemm g{H, WIN, NTOK, NIN - P2_DEFER, DM}; pg8::StaticOrder S; S.init(NTOK, NIN - P2_DEFER, F.G, F.bid);
        pg8::EpiBf16<0> E{Y1, NIN, nullptr, 0, 0, 1.f};
        GS_ON(1);
        pg8::gemm_phase<pg8::EpiBf16<0>, pg8::StaticOrder, true, true>(F.lds + RING_OFF, g, S, E);
        GS_OFF(1);
        if ((long)(NTOK / 256) * ((NIN - P2_DEFER) / 256) / F.G * F.G + F.bid >= (long)(NTOK / 256) * ((NIN - P2_DEFER) / 256)) WDN_DRAIN(7);
    }
    SEAM(2);
    if (IN(3)) {
        PHASE_BEGIN();
        P3Bufs P{Y1, ROPE, QB, KB, IQ, IK, IW, out};
        SUBL0(); for (int m = gw; m < NTOK; m += NGW) p3_rot_row(P, m, F.lane); SUBL(4);
        p3_vt(F, Y1, VT); SUBL(5);
        { GdnW Wp{Y1, w_gconv, a_log, dt_bias, ws + WS_GCH, (float*)(ws + WS_GE)};
          GdnS Wsm{Y1, w_gconv, a_log, dt_bias, g_gnorm, state_gdn, state_gconv, OG, out};
          if (F.bid & 1) { GdnSPre sp_; gdn_sample_load(Wsm, F.bid, F.tid, sp_); for (int it = F.bid; it < 1024; it += F.G) gdn_sample_item(F, Wsm, it, it + F.G, sp_); }
          { v4u xr_[11]; f32x4 wg_[8]; if (F.bid < 1024) gdn_prep_load(Wp, F.bid, F.wave, F.lane, xr_, wg_);
            for (int ci = F.bid; ci < 1024; ci += F.G) gdn_chunk_prep(F, Wp, ci, ci + F.G, xr_, wg_); }
          if (!(F.bid & 1)) { GdnSPre sp_; gdn_sample_load(Wsm, F.bid, F.tid, sp_); for (int it = F.bid; it < 1024; it += F.G) gdn_sample_item(F, Wsm, it, it + F.G, sp_); } }
    }
    SEAM(3);
    if (IN(4)) {
        PHASE_BEGIN();
        { GdnP Wq{ws + WS_GCH, (const float*)(ws + WS_GE), (bf16*)(ws + WS_SN), out};
          if (F.bid < 32) gdn_scan_item(F, Wq, F.bid); }
        { volatile LAS unsigned* qslot = (volatile LAS unsigned*)(F.lds + LDSCTL_OFF);
          constexpr int QSPLIT = 120;
          if (F.bid >= 32) for (;;) {
              WG_SYNC();
              if (F.tid == 0) qslot[0] = __hip_atomic_fetch_add(F.ctl + CW_QUEUE, 1u, RLX_AGENT);
              WG_SYNC();
              const int item = (int)qslot[0];
              if (item >= 384) break;
              unsigned wlo = (unsigned)(size_t)ws, whi = (unsigned)((size_t)ws >> 32);
              asm volatile("" : "+v"(wlo), "+v"(whi));
              unsigned char* wl = (unsigned char*)(((size_t)(unsigned)__builtin_amdgcn_readfirstlane(whi) << 32) | (unsigned)__builtin_amdgcn_readfirstlane(wlo));
              if (item >= QSPLIT && item < QSPLIT + 128) {
                  DsaS Wsd{(const bf16*)(wl + WS_QB), (const bf16*)(wl + WS_IQ), (const bf16*)(wl + WS_IK), (const float*)(wl + WS_IW), cache_k, cache_v, cache_ik, page_table, out + O_KS, out + O_VS, (bf16*)(wl + WS_OG)};
                  dsa_sample_item(F, Wsd, item - QSPLIT);
              } else {
                  DsaP Wd{(const bf16*)(wl + WS_QB), (const bf16*)(wl + WS_KB), (const bf16*)(wl + WS_VT), (const bf16*)(wl + WS_IQ), (const bf16*)(wl + WS_IK), (const float*)(wl + WS_IW), (float*)(wl + WS_SCR), (bf16*)(wl + WS_OG)};
                  const int k = item < QSPLIT ? item : item - 128; dsa_prompt_item(F, Wd, k & 3, 63 - (k >> 2));
              }
          } }
        { volatile LAS unsigned* qslot = (volatile LAS unsigned*)(F.lds + LDSCTL_OFF);
          LAS float* scr = (LAS float*)(F.lds + RING_OFF + F.wave * 16640);
          constexpr int P2_UNITS = (NTOK / 256) * (P2_DEFER / 256);
          for (;;) {
              WG_SYNC();
              if (F.tid == 0) qslot[0] = __hip_atomic_fetch_add(F.ctl + CW_QUEUE + 192, 1u, RLX_AGENT);
              WG_SYNC();
              const int pop = (int)qslot[0];
              if (pop < P2_UNITS) {
                  pg8::Gemm g{H, WIN + (size_t)(NIN - P2_DEFER) * DM, NTOK, P2_DEFER, DM}; pg8::OneUnit S1{pop % (NTOK / 256), pop / (NTOK / 256)};
                  pg8::EpiBf16<0> E{Y1 + (NIN - P2_DEFER), NIN, nullptr, 0, 0, 1.f};
                  pg8::gemm_phase<pg8::EpiBf16<0>, pg8::OneUnit, true, true>(F.lds + RING_OFF, g, S1, E);
                  continue;
              }
              int it = 8 * (pop - P2_UNITS) + F.wave;
              if (it >= 7680) break;
              if (it < 512) transpose_item(w_gout, DM, DM, WG, scr, it / 32, it % 32, F.lane, MapId());
              else if ((it -= 512) < 512) transpose_item(w_dout, DM, DM, WG + 1024, scr, it / 32, it % 32, F.lane, MapId());
              else if ((it -= 512) < 1024) transpose_item(w_o, DM, DM, WO, scr, it / 32, it % 32, F.lane, MapId());
              else { it -= 1024; transpose_item(w_up, DM, FF2, WUP, scr, it / 176, it % 176, F.lane, MapUp()); }
          } }
    }
    SEAM(4);
#define P6_SMALL() do { const bf16* gq = Y1 + (size_t)NPR * NIN; bf16* mx = MIX + (size_t)NPR * DM; \
          small_gemm<true>(F, OG + (size_t)NPR * DM, DM, WG, DM, [&](int row, int col, f32x4 a0, f32x4 a1, f32x4 b0, f32x4 b1) { \
              const v4u g1 = *(const GAS v4u*)(gq + (size_t)row * NIN + C_G1 + col), g2 = *(const GAS v4u*)(gq + (size_t)row * NIN + C_G2 + col); \
              v4u o; \
              o.x = pk2(sigm_f(bflo(g1.x)) * a0.x + sigm_f(bflo(g2.x)) * b0.x, sigm_f(bfhi(g1.x)) * a0.y + sigm_f(bfhi(g2.x)) * b0.y); \
              o.y = pk2(sigm_f(bflo(g1.y)) * a0.z + sigm_f(bflo(g2.y)) * b0.z, sigm_f(bfhi(g1.y)) * a0.w + sigm_f(bfhi(g2.y)) * b0.w); \
              o.z = pk2(sigm_f(bflo(g1.z)) * a1.x + sigm_f(bflo(g2.z)) * b1.x, sigm_f(bfhi(g1.z)) * a1.y + sigm_f(bfhi(g2.z)) * b1.y); \
              o.w = pk2(sigm_f(bflo(g1.w)) * a1.z + sigm_f(bflo(g2.w)) * b1.z, sigm_f(bfhi(g1.w)) * a1.w + sigm_f(bfhi(g2.w)) * b1.w); \
              *(GAS v4u*)(mx + (size_t)row * DM + col) = o; }); } while (0)
#define P7_SMALL() do { small_gemm(F, MIX + (size_t)NPR * DM, DM, WO, DM, [&](int row, int col, f32x4 s0, f32x4 s1) { \
            const float* xs = x_sample + (size_t)row * DM + col; const float* ga = ADA + (size_t)(4 + (row >> 2)) * ADAW + 4096 + col; \
            const f32x4 y0 = *(const GAS f32x4*)xs + *(const GAS f32x4*)ga * s0, y1 = *(const GAS f32x4*)(xs + 4) + *(const GAS f32x4*)(ga + 4) * s1; \
            *(GAS v4u*)(X1 + (size_t)(NPR + row) * DM + col) = (v4u){pk2(y0.x, y0.y), pk2(y0.z, y0.w), pk2(y1.x, y1.y), pk2(y1.z, y1.w)}; }); } while (0)
    if (IN(5)) {
        PHASE_BEGIN();
        GdnO Wo_{Y1, g_gnorm, ws + WS_GCH, (const bf16*)(ws + WS_SN), OG, ws + (size_t)1120 * MiB};
        if (F.bid & 1) P6_SMALL();
        { GdnOPre Pp; if (F.bid < 1024) gdn_out_load(Wo_, F.bid, F.tid, Pp);
          for (int ci = F.bid; ci < 1024; ci += F.G) gdn_out_item(F, Wo_, ci, ci + F.G, Pp); }
        if (!(F.bid & 1)) P6_SMALL();
    }
    SEAM(5);
    if (IN(6)) {
        PHASE_BEGIN();
#define P6_BIG() do { pg8::Gemm g{OG, WG, NPR, DM, DM}; pg8::StaticOrder S; S.init(NPR, DM, F.G, F.bid);        \
          pg8::EpiGate2 E{MIX, DM, Y1 + C_G1, Y1 + C_G2, NIN}; \
          pg8::gemm_phase<pg8::EpiGate2, pg8::StaticOrder, true, true>(F.lds + RING_OFF, g, S, E); } while (0)
        if (F.bid & 1) { P7_SMALL(); P6_BIG(); } else { P6_BIG(); P7_SMALL(); }
#undef P6_BIG
    }
    SEAM(6);
    if (IN(7)) {
        PHASE_BEGIN();
#define P7_BIG() do { pg8::Gemm g{MIX, WO, NPR, DM, DM}; pg8::StaticOrder S; S.init(NPR, DM, F.G, F.bid); \
          pg8::EpiResid2<false, true> E{x_prompt, X1, ADA + 4096, ADAW}; \
          pg8::gemm_phase<pg8::EpiResid2<false, true>, pg8::StaticOrder, true, true>(F.lds + RING_OFF, g, S, E); } while (0)
        P7_BIG();
#undef P7_BIG
    }
    SEAM(7);
    if (IN(8)) {
        PHASE_BEGIN();
        norm_mod_pass<true>(F, [&](int m) { return (const void*)(X1 + (size_t)m * DM); }, g_norm2, ADA, 6144, 8192, H2);
    }
    SEAM(8);
    if (IN(9)) {
        PHASE_BEGIN();
        pg8::Gemm g{H2, WUP, NTOK, FF2, DM}; pg8::StaticOrder S; S.init(NTOK, FF2, F.G, F.bid);
        pg8::EpiConv E{ACT, U, (bf16*)(ws + WS_HB), w_fconv, b_fconv};
        GS_ON(2);
        pg8::gemm_phase<pg8::EpiConv, pg8::StaticOrder, true, true>(F.lds + RING_OFF, g, S, E);
        if ((long)(NTOK / 256) * (FF2 / 256) / F.G * F.G + F.bid >= (long)(NTOK / 256) * (FF2 / 256)) WDN_DRAIN(7);
        GS_OFF(2);
    }
    SEAM(9);
    if (IN(10)) { PHASE_BEGIN(); WDN_DRAIN(1 << 20); p9_conv(F, U, state_fconv, w_fconv, b_fconv, ACT, out); p10_fixup(F, (const bf16*)(ws + WS_HB), w_fconv, b_fconv, ACT, out); }
    SEAM(10);
    if (IN(11)) {
        PHASE_BEGIN();
#define P11_BIG() do { pg8::Gemm g{ACT, WDN, NPR, DM, FF}; pg8::StaticOrder S; S.init(NPR, DM, F.G, F.bid); \
          pg8::EpiResid2<true, true> E{X1, X2, ADA + 10240, ADAW}; \
          pg8::gemm_phase<pg8::EpiResid2<true, true>, pg8::StaticOrder, true, true>(F.lds + RING_OFF, g, S, E); } while (0)
#define P11_SMALL() do { small_gemm(F, ACT + (size_t)NPR * FF, FF, WDN, FF, [&](int row, int col, f32x4 s0, f32x4 s1) { \
            const size_t o_ = (size_t)(NPR + row) * DM + col; const float* ga = ADA + (size_t)(4 + (row >> 2)) * ADAW + 10240 + col; \
            const v4u xb = *(const GAS v4u*)(X1 + o_); \
            const f32x4 y0 = (f32x4){bflo(xb.x), bfhi(xb.x), bflo(xb.y), bfhi(xb.y)} + *(const GAS f32x4*)ga * s0, y1 = (f32x4){bflo(xb.z), bfhi(xb.z), bflo(xb.w), bfhi(xb.w)} + *(const GAS f32x4*)(ga + 4) * s1; \
            *(GAS v4u*)(X2 + o_) = (v4u){pk2(y0.x, y0.y), pk2(y0.z, y0.w), pk2(y1.x, y1.y), pk2(y1.z, y1.w)}; }); } while (0)
        if (F.bid & 1) { P11_SMALL(); P11_BIG(); } else { P11_BIG(); P11_SMALL(); }
#undef P11_BIG
#undef P11_SMALL
    }
    SEAM(11);
    if (IN(12)) {
        PHASE_BEGIN();
        for (int m = gw; m < NTOK; m += NGW) final_norm_row_bf(X2 + (size_t)m * DM, g_final, out + O_Y + (size_t)m * DM, F.lane);
    }
#undef IN
#undef SEAM
}

extern "C" void kernel_launch(void* const* d_in, const int* in_sizes, int n_in, void* d_out, int out_size, void* d_ws, size_t ws_size, hipStream_t stream) {
    static int grid = 0;
    if (grid == 0) {
        if (n_in != 28 || (size_t)out_size != O_END || ws_size < WS_END) { fprintf(stderr, "kernel_launch: unexpected sizes n_in %d out %d ws %zu (need %zu)\n", n_in, out_size, ws_size, (size_t)WS_END); grid = -1; return; }
        int dev = 0, cus = 0, per_cu = 0;
        if (hipGetDevice(&dev) != hipSuccess || hipDeviceGetAttribute(&cus, hipDeviceAttributeMultiprocessorCount, dev) != hipSuccess) { grid = -1; return; }
        if (hipFuncSetAttribute((const void*)mk_fwd, hipFuncAttributeMaxDynamicSharedMemorySize, LDS_BYTES) != hipSuccess) { fprintf(stderr, "kernel_launch: hipFuncSetAttribute failed\n"); grid = -1; return; }
        if (hipOccupancyMaxActiveBlocksPerMultiprocessor(&per_cu, (const void*)mk_fwd, NWAVES * 64, LDS_BYTES) != hipSuccess || per_cu < 1)
            fprintf(stderr, "kernel_launch: occupancy query reports %d\n", per_cu);
        (void)hipGetLastError();
        grid = cus;
    }
    if (grid < 0) return;
    if (hipMemsetAsync((char*)d_ws + WS_CTL, 0, CTL_ZERO_BYTES, stream) != hipSuccess) return;
    Args a{};
    for (int i = 0; i < 28; ++i) a.in[i] = (const float*)d_in[i];
    a.out = (float*)d_out; a.ws = (unsigned char*)d_ws;
    for (int i = 0; i < 16; ++i) a.invf[i] = pow(500000.0, -(double)i / 16.0);
    for (int i = 0; i < 8; ++i) a.invf[16 + i] = pow(500000.0, -(double)i / 8.0);
    if (MK_N_LAUNCHES == 1) {
        a.ph_lo = 0; a.ph_hi = N_PHASES;
        hipLaunchKernelGGL(mk_fwd, dim3(grid), dim3(NWAVES * 64), LDS_BYTES, stream, a);
    } else {
        for (int p = 0; p < N_PHASES; ++p) { a.ph_lo = p; a.ph_hi = p + 1; hipLaunchKernelGGL(mk_fwd, dim3(grid), dim3(NWAVES * 64), LDS_BYTES, stream, a); }
    }
}
```

```cpp
#include <hip/hip_runtime.h>
#include <cstdio>
#include <cstdint>
#include <cmath>
namespace pg8 {
#define PG8_LAS __attribute__((address_space(3)))
typedef unsigned short bf16_t;
typedef short bf16x8 __attribute__((ext_vector_type(8)));
typedef float f32x4 __attribute__((ext_vector_type(4)));
typedef unsigned u32x4 __attribute__((ext_vector_type(4)));
constexpr int BM = 256, BK = 64, HALF = 128, HTB = HALF * BK * 2  , STAGE_BYTES = 8 * HTB, NXCD = 8, WGM = 8;

__host__ __device__ __forceinline__ int lds_byte(int r, int c) { const int st = (r >> 4) * 2 + (c >> 5), rr = r & 15, cc = c & 31, ob = rr * 64 + cc * 2; return st * 1024 + (ob ^ (((ob >> 9) & 1) << 5)); }
__host__ __device__ __forceinline__ void stage_rc(int b, int& R, int& C) { const int st = b / 1024, sb = b % 1024, swz = sb ^ (((sb >> 9) & 1) << 5); R = (st >> 1) * 16 + swz / 64; C = (st & 1) * 32 + (swz % 64) / 2; }
__host__ __device__ __forceinline__ int perm32(int rho) { const int n = rho >> 4, i = rho & 15; return 8 * (i >> 2) + 4 * n + (i & 3); }

struct Unit { int pm, pn; };
struct Gemm { const bf16_t* A; const bf16_t* Bt; int M, N, K; };

struct StaticOrder {
    int nM, nN, nwg, G, c;
    __host__ __device__ void init(int M, int N, int G_, int c_) { nM = M / BM; nN = N / BM; nwg = nM * nN; G = G_; c = c_; }
    __host__ __device__ bool next(int i, Unit& u) const {
        const long L = (long)i * G + c; if (L >= nwg) return false;
        int wgid = (int)L; { const int q = nwg / NXCD, r = nwg % NXCD, xcd = wgid % NXCD, off = wgid / NXCD; wgid = (xcd < r ? xcd * (q + 1) : r * (q + 1) + (xcd - r) * q) + off; }
        const int nig = WGM * nN, gid = wgid / nig, fm = gid * WGM, gsz = (nM - fm) < WGM ? (nM - fm) : WGM;
        u.pm = fm + ((wgid % nig) % gsz); u.pn = (wgid % nig) / gsz; return true;
    }
    __device__ __forceinline__ void a_ready(const Unit&) const {}
    __device__ __forceinline__ void done(const Unit&) const {}
};

struct OneUnit {
    int pm, pn;
    __device__ __forceinline__ bool next(int i, Unit& u) const { if (i) return false; u.pm = pm; u.pn = pn; return true; }
    __device__ __forceinline__ void a_ready(const Unit&) const {}
    __device__ __forceinline__ void done(const Unit&) const {}
};

typedef float f32x2_c2 __attribute__((ext_vector_type(2))); typedef __bf16 bf16x2_c2 __attribute__((ext_vector_type(2)));
__device__ __forceinline__ unsigned cvt_pk_bf16(float lo, float hi) { const f32x2_c2 v = {lo, hi}; const bf16x2_c2 b = __builtin_convertvector(v, bf16x2_c2); return __builtin_bit_cast(unsigned, b); }
typedef float f32x2 __attribute__((ext_vector_type(2)));
__device__ __forceinline__ f32x2 gelu_pk(f32x2 v) {
    const f32x2 av = __builtin_elementwise_abs(v), d = av * 0.2316418882f + 1.0f;
    f32x2 t; t.x = __builtin_amdgcn_rcpf(d.x); t.y = __builtin_amdgcn_rcpf(d.y);
    f32x2 q = t * 0.5307027145f + (-0.7265760135f); q = q * t + 0.7107068705f; q = q * t + (-0.142248368f); q = q * t + 0.127414796f; q = q * t;
    const f32x2 s = (v * v) * (-0.72134752044f);
    f32x2 e; e.x = __builtin_amdgcn_exp2f(s.x); e.y = __builtin_amdgcn_exp2f(s.y);
    const f32x2 m = v * (q * e), r = v - m;
    f32x2 o; o.x = v.x < 0.f ? m.x : r.x; o.y = v.y < 0.f ? m.y : r.y; return o;
}

template <int ACT  > struct EpiBf16 {
    static constexpr bool PERM = true, AFTER_DRAIN = false, HAS_MID = false; static_assert(ACT == 0 || ACT == 1, "EpiBf16: ACT is 0 (none) or 1 (gelu_pk)");
    bf16_t* O; int ldc; const float* bias; int split_cols; size_t split_stride; float scale0;
    __device__ __forceinline__ void operator()(const f32x4 (&acc)[2][2][4][2], const Unit& u, int wr, int wc, int fr, int fq) const {
        const int row0 = u.pm * BM + wr * 64 + fr; int colt = u.pn * BM; bf16_t* base = O;
        float sc = 1.f; if (split_cols) { const int t = colt / split_cols; base += (size_t)t * split_stride; colt -= t * split_cols; if (t == 0) sc = scale0; }
        const int col0 = colt + wc * 32 + 8 * fq, bcol0 = u.pn * BM + wc * 32 + 8 * fq;
        f32x4 bv[2][2];
#pragma unroll
        for (int bj = 0; bj < 2; ++bj)
#pragma unroll
            for (int n = 0; n < 2; ++n) bv[bj][n] = bias ? *(const f32x4*)(bias + bcol0 + bj * HALF + 4 * n) : (f32x4){0.f, 0.f, 0.f, 0.f};
#pragma unroll
        for (int ai = 0; ai < 2; ++ai)
#pragma unroll
            for (int m = 0; m < 4; ++m) { bf16_t* rowp = base + (size_t)(row0 + ai * HALF + m * 16) * ldc + col0;
#pragma unroll
                for (int bj = 0; bj < 2; ++bj) { f32x4 v0 = acc[ai][bj][m][0] + bv[bj][0], v1 = acc[ai][bj][m][1] + bv[bj][1];
                    if (ACT == 1) { f32x2 a = gelu_pk((f32x2){v0[0], v0[1]}), b = gelu_pk((f32x2){v0[2], v0[3]}), c = gelu_pk((f32x2){v1[0], v1[1]}), d = gelu_pk((f32x2){v1[2], v1[3]});
                        v0 = (f32x4){a.x, a.y, b.x, b.y}; v1 = (f32x4){c.x, c.y, d.x, d.y}; }
                    v0 = v0 * sc; v1 = v1 * sc; u32x4 w; w.x = cvt_pk_bf16(v0[0], v0[1]); w.y = cvt_pk_bf16(v0[2], v0[3]); w.z = cvt_pk_bf16(v1[0], v1[1]); w.w = cvt_pk_bf16(v1[2], v1[3]);
                    *(u32x4*)(rowp + bj * HALF) = w; } }
    }
};
__device__ __forceinline__ float bf2f(unsigned short b) { return __uint_as_float(((unsigned)b) << 16); }
__device__ __forceinline__ float sigmoidf_(float x) { return __builtin_amdgcn_rcpf(1.0f + __expf(-x)); }
template <bool ACCUM> struct EpiGate {
    static constexpr bool PERM = true, AFTER_DRAIN = false, HAS_MID = false;
    bf16_t* O; int ldc; const bf16_t* G; int ldg;
    __device__ __forceinline__ void operator()(const f32x4 (&acc)[2][2][4][2], const Unit& u, int wr, int wc, int fr, int fq) const {
        const int row0 = u.pm * BM + wr * 64 + fr, col0 = u.pn * BM + wc * 32 + 8 * fq;
#pragma unroll
        for (int ai = 0; ai < 2; ++ai)
#pragma unroll
            for (int m = 0; m < 4; ++m) { const size_t row = (size_t)(row0 + ai * HALF + m * 16);
#pragma unroll
                for (int bj = 0; bj < 2; ++bj) {
                    const u32x4 g = *(const u32x4*)(G + row * ldg + col0 + bj * HALF);
                    bf16_t* op = O + row * ldc + col0 + bj * HALF;
                    u32x4 prev = (u32x4){0u, 0u, 0u, 0u}; if (ACCUM) prev = *(const u32x4*)op;
                    const f32x4 v0 = acc[ai][bj][m][0], v1 = acc[ai][bj][m][1];
                    float r[8];
#pragma unroll
                    for (int e = 0; e < 4; ++e) {
                        const unsigned gw = g[e], pw = prev[e];
                        const float a0 = (e < 2) ? v0[2 * e] : v1[2 * e - 4], a1 = (e < 2) ? v0[2 * e + 1] : v1[2 * e - 3];
                        r[2 * e] = __uint_as_float(pw << 16) + sigmoidf_(__uint_as_float(gw << 16)) * a0;
                        r[2 * e + 1] = __uint_as_float(pw & 0xffff0000u) + sigmoidf_(__uint_as_float(gw & 0xffff0000u)) * a1;
                    }
                    u32x4 w; w.x = cvt_pk_bf16(r[0], r[1]); w.y = cvt_pk_bf16(r[2], r[3]); w.z = cvt_pk_bf16(r[4], r[5]); w.w = cvt_pk_bf16(r[6], r[7]);
                    *(u32x4*)op = w; } }
    }
};
struct EpiResid {
    static constexpr bool PERM = false, AFTER_DRAIN = false, HAS_MID = false;
    const float* base; float* out; const float* gate; int gpitch;
    __device__ __forceinline__ void operator()(const f32x4 (&acc)[2][2][4][2], const Unit& u, int wr, int wc, int fr, int fq) const {
        const int row0 = u.pm * BM + wr * 64 + fr, col0 = u.pn * BM + wc * 32 + 4 * fq;
        const float* gp = gate + (size_t)((u.pm * BM) >> 11) * gpitch + col0;
        f32x4 gv[2][2];
#pragma unroll
        for (int bj = 0; bj < 2; ++bj)
#pragma unroll
            for (int n = 0; n < 2; ++n) gv[bj][n] = *(const f32x4*)(gp + bj * HALF + n * 16);
#pragma unroll
        for (int ai = 0; ai < 2; ++ai) {
            f32x4 bs[4][2][2];
#pragma unroll
            for (int m = 0; m < 4; ++m) { const size_t off = (size_t)(row0 + ai * HALF + m * 16) * 2048 + col0;
#pragma unroll
                for (int bj = 0; bj < 2; ++bj)
#pragma unroll
                    for (int n = 0; n < 2; ++n) bs[m][bj][n] = *(const f32x4*)(base + off + bj * HALF + n * 16); }
            __builtin_amdgcn_sched_barrier(0);
#pragma unroll
            for (int m = 0; m < 4; ++m) { const size_t off = (size_t)(row0 + ai * HALF + m * 16) * 2048 + col0;
#pragma unroll
                for (int bj = 0; bj < 2; ++bj)
#pragma unroll
                    for (int n = 0; n < 2; ++n) *(f32x4*)(out + off + bj * HALF + n * 16) = bs[m][bj][n] + gv[bj][n] * acc[ai][bj][m][n]; }
        }
    }
};
template <bool BF_BASE, bool BF_OUT> struct EpiResid2 {
    static constexpr bool PERM = true, AFTER_DRAIN = false, HAS_MID = false;
    const void* base; void* out; const float* gate; int gpitch;
    __device__ __forceinline__ void operator()(const f32x4 (&acc)[2][2][4][2], const Unit& u, int wr, int wc, int fr, int fq) const {
        const int row0 = u.pm * BM + wr * 64 + fr, col0 = u.pn * BM + wc * 32 + 8 * fq;
        const float* gp = gate + (size_t)((u.pm * BM) >> 11) * gpitch + col0;
        f32x4 gv[2][2];
#pragma unroll
        for (int bj = 0; bj < 2; ++bj)
#pragma unroll
            for (int n = 0; n < 2; ++n) gv[bj][n] = *(const f32x4*)(gp + bj * HALF + 4 * n);
#pragma unroll
        for (int ai = 0; ai < 2; ++ai) {
            f32x4 bs[4][2][2];
#pragma unroll
            for (int m = 0; m < 4; ++m) { const size_t off = (size_t)(row0 + ai * HALF + m * 16) * 2048 + col0;
#pragma unroll
                for (int bj = 0; bj < 2; ++bj) {
                    if constexpr (BF_BASE) { const u32x4 w = *(const u32x4*)((const bf16_t*)base + off + bj * HALF);
                        bs[m][bj][0] = (f32x4){__uint_as_float(w.x << 16), __uint_as_float(w.x & 0xffff0000u), __uint_as_float(w.y << 16), __uint_as_float(w.y & 0xffff0000u)};
                        bs[m][bj][1] = (f32x4){__uint_as_float(w.z << 16), __uint_as_float(w.z & 0xffff0000u), __uint_as_float(w.w << 16), __uint_as_float(w.w & 0xffff0000u)}; }
                    else { bs[m][bj][0] = *(const f32x4*)((const float*)base + off + bj * HALF); bs[m][bj][1] = *(const f32x4*)((const float*)base + off + bj * HALF + 4); } } }
            __builtin_amdgcn_sched_barrier(0);
#pragma unroll
            for (int m = 0; m < 4; ++m) { const size_t off = (size_t)(row0 + ai * HALF + m * 16) * 2048 + col0;
#pragma unroll
                for (int bj = 0; bj < 2; ++bj) {
                    const f32x4 v0 = bs[m][bj][0] + gv[bj][0] * acc[ai][bj][m][0], v1 = bs[m][bj][1] + gv[bj][1] * acc[ai][bj][m][1];
                    if constexpr (BF_OUT) { u32x4 w; w.x = cvt_pk_bf16(v0[0], v0[1]); w.y = cvt_pk_bf16(v0[2], v0[3]); w.z = cvt_pk_bf16(v1[0], v1[1]); w.w = cvt_pk_bf16(v1[2], v1[3]);
                        *(u32x4*)((bf16_t*)out + off + bj * HALF) = w; }
                    else { *(f32x4*)((float*)out + off + bj * HALF) = v0; *(f32x4*)((float*)out + off + bj * HALF + 4) = v1; } } }
        }
    }
};
__device__ __forceinline__ float dpp_ror1(float v) { return __builtin_bit_cast(float, __builtin_amdgcn_update_dpp(0, __builtin_bit_cast(int, v), 0x121, 0xf, 0xf, false)); }
__device__ __forceinline__ float dpp_ror2(float v) { return __builtin_bit_cast(float, __builtin_amdgcn_update_dpp(0, __builtin_bit_cast(int, v), 0x122, 0xf, 0xf, false)); }
typedef unsigned u32x2 __attribute__((ext_vector_type(2)));
struct EpiConv {
    static constexpr bool PERM = true, AFTER_DRAIN = false, HAS_MID = false;
    bf16_t* ACT; bf16_t* U; bf16_t* HB; const float* wcv; const float* bcv;
    __device__ __forceinline__ void operator()(const f32x4 (&acc)[2][2][4][2], const Unit& u, int wr, int wc, int fr, int fq) const {
        const int j0 = u.pn * 128 + wc * 32 + 8 * fq;
        if (u.pm >= 32) {
#pragma unroll
            for (int ai = 0; ai < 2; ++ai)
#pragma unroll
                for (int m = 0; m < 4; ++m) { bf16_t* rowp = U + (size_t)(u.pm * BM + ai * HALF + wr * 64 + m * 16 + fr) * 11264 + j0;
#pragma unroll
                    for (int bj = 0; bj < 2; ++bj) { const f32x4 v0 = acc[ai][bj][m][0], v1 = acc[ai][bj][m][1];
                        u32x4 w; w.x = cvt_pk_bf16(v0[0], v0[1]); w.y = cvt_pk_bf16(v0[2], v0[3]); w.z = cvt_pk_bf16(v1[0], v1[1]); w.w = cvt_pk_bf16(v1[2], v1[3]);
                        *(u32x4*)(rowp + bj * 5632) = w; } }
            return;
        }
        f32x4 wg[2][3], wv[2][3], bg[2], bv[2];
#pragma unroll
        for (int n = 0; n < 2; ++n) { const int jn = j0 + 4 * n;
#pragma unroll
            for (int i = 0; i < 3; ++i) { wg[n][i] = *(const f32x4*)(wcv + i * 11264 + jn); wv[n][i] = *(const f32x4*)(wcv + i * 11264 + 5632 + jn); }
            bg[n] = *(const f32x4*)(bcv + jn); bv[n] = *(const f32x4*)(bcv + 5632 + jn); }
#pragma unroll
        for (int ai = 0; ai < 2; ++ai)
#pragma unroll
            for (int m = 0; m < 4; ++m) {
                const size_t row = (size_t)(u.pm * BM + ai * HALF + wr * 64 + m * 16 + fr);
                float r[8];
#pragma unroll
                for (int n = 0; n < 2; ++n)
#pragma unroll
                    for (int c = 0; c < 4; ++c) {
                        const float g0 = acc[ai][0][m][n][c], v0 = acc[ai][1][m][n][c];
                        float g1, g2, v1, v2;
                        if (m > 0) {
                            const float pg = acc[ai][0][m > 0 ? m - 1 : 0][n][c], pv = acc[ai][1][m > 0 ? m - 1 : 0][n][c];
                            g1 = dpp_ror1(fr == 15 ? pg : g0); v1 = dpp_ror1(fr == 15 ? pv : v0);
                            g2 = dpp_ror2(fr >= 14 ? pg : g0); v2 = dpp_ror2(fr >= 14 ? pv : v0);
                        } else { g1 = dpp_ror1(g0); g2 = dpp_ror2(g0); v1 = dpp_ror1(v0); v2 = dpp_ror2(v0); }
                        const float gg = bg[n][c] + wg[n][0][c] * g2 + wg[n][1][c] * g1 + wg[n][2][c] * g0;
                        const float vv = bv[n][c] + wv[n][0][c] * v2 + wv[n][1][c] * v1 + wv[n][2][c] * v0;
                        r[4 * n + c] = gg * __builtin_amdgcn_rcpf(1.0f + __expf(-gg)) * vv;
                    }
                if (m > 0 || fr >= 2) { u32x4 w; w.x = cvt_pk_bf16(r[0], r[1]); w.y = cvt_pk_bf16(r[2], r[3]); w.z = cvt_pk_bf16(r[4], r[5]); w.w = cvt_pk_bf16(r[6], r[7]); *(u32x4*)(ACT + row * 5632 + j0) = w; }
            }
#pragma unroll
        for (int ai = 0; ai < 2; ++ai) {
            const int blk = u.pm * 4 + ai * 2 + wr;
            bf16_t* hb = HB + (size_t)blk * 4 * 11264 + j0;
#pragma unroll
            for (int m = 0; m < 4; m += 3) {
                const int slot = (m == 3 && fr >= 14) ? fr - 14 : ((m == 0 && fr < 2) ? 2 + fr : -1);
                if (slot >= 0) {
#pragma unroll
                    for (int bj = 0; bj < 2; ++bj) { const f32x4 v0 = acc[ai][bj][m][0], v1 = acc[ai][bj][m][1];
                        u32x4 w; w.x = cvt_pk_bf16(v0[0], v0[1]); w.y = cvt_pk_bf16(v0[2], v0[3]); w.z = cvt_pk_bf16(v1[0], v1[1]); w.w = cvt_pk_bf16(v1[2], v1[3]);
                        *(u32x4*)(hb + (size_t)slot * 11264 + bj * 5632) = w; }
                }
            }
        }
    }
};

struct EpiGate2 {
    static constexpr bool PERM = true, AFTER_DRAIN = false, HAS_MID = true;
    bf16_t* O; int ldc; const bf16_t* G1; const bf16_t* G2; int ldg;
    __device__ __forceinline__ void mid(f32x4 (&acc)[2][2][4][2], const Unit& u, int wr, int wc, int fr, int fq) const {
        asm volatile("" : "+v"(fr), "+v"(fq));
        const int row0 = u.pm * BM + wr * 64 + fr, col0 = u.pn * BM + wc * 32 + 8 * fq;
#pragma unroll
        for (int ai = 0; ai < 2; ++ai)
#pragma unroll
            for (int mp = 0; mp < 2; ++mp) {
                u32x4 ga[2][2], gb[2][2];
#pragma unroll
                for (int m2 = 0; m2 < 2; ++m2) { const size_t row = (size_t)(row0 + ai * HALF + (2 * mp + m2) * 16);
#pragma unroll
                    for (int bj = 0; bj < 2; ++bj) { ga[m2][bj] = *(const u32x4*)(G1 + row * ldg + col0 + bj * HALF); gb[m2][bj] = *(const u32x4*)(G2 + row * ldg + col0 + bj * HALF); } }
                __builtin_amdgcn_sched_barrier(0);
#pragma unroll
                for (int m2 = 0; m2 < 2; ++m2) { const int m = 2 * mp + m2;
#pragma unroll
                    for (int bj = 0; bj < 2; ++bj)
#pragma unroll
                        for (int e = 0; e < 4; ++e) {
                            const unsigned g1 = ga[m2][bj][e], g2 = gb[m2][bj][e];
                            const float r0 = (1.0f + __expf(-__uint_as_float(g2 << 16))) * __builtin_amdgcn_rcpf(1.0f + __expf(-__uint_as_float(g1 << 16)));
                            const float r1 = (1.0f + __expf(-__uint_as_float(g2 & 0xffff0000u))) * __builtin_amdgcn_rcpf(1.0f + __expf(-__uint_as_float(g1 & 0xffff0000u)));
                            acc[ai][bj][m][e >> 1][(e & 1) * 2] *= r0; acc[ai][bj][m][e >> 1][(e & 1) * 2 + 1] *= r1;
                        } }
                asm volatile("" ::: "memory");
            }
    }
    __device__ __forceinline__ void operator()(const f32x4 (&acc)[2][2][4][2], const Unit& u, int wr, int wc, int fr, int fq) const {
        const int row0 = u.pm * BM + wr * 64 + fr, col0 = u.pn * BM + wc * 32 + 8 * fq;
#pragma unroll
        for (int ai = 0; ai < 2; ++ai) {
            u32x4 gg[4][2];
#pragma unroll
            for (int m = 0; m < 4; ++m)
#pragma unroll
                for (int bj = 0; bj < 2; ++bj) gg[m][bj] = *(const u32x4*)(G2 + (size_t)(row0 + ai * HALF + m * 16) * ldg + col0 + bj * HALF);
            __builtin_amdgcn_sched_barrier(0);
#pragma unroll
            for (int m = 0; m < 4; ++m) { const size_t row = (size_t)(row0 + ai * HALF + m * 16);
#pragma unroll
                for (int bj = 0; bj < 2; ++bj) {
                    const u32x4 g = gg[m][bj];
                    const f32x4 v0 = acc[ai][bj][m][0], v1 = acc[ai][bj][m][1];
                    float r[8];
#pragma unroll
                    for (int e = 0; e < 4; ++e) {
                        const float a0 = (e < 2) ? v0[2 * e] : v1[2 * e - 4], a1 = (e < 2) ? v0[2 * e + 1] : v1[2 * e - 3];
                        r[2 * e] = sigmoidf_(__uint_as_float(g[e] << 16)) * a0; r[2 * e + 1] = sigmoidf_(__uint_as_float(g[e] & 0xffff0000u)) * a1;
                    }
                    u32x4 w; w.x = cvt_pk_bf16(r[0], r[1]); w.y = cvt_pk_bf16(r[2], r[3]); w.z = cvt_pk_bf16(r[4], r[5]); w.w = cvt_pk_bf16(r[6], r[7]);
                    *(u32x4*)(O + row * ldc + col0 + bj * HALF) = w; } }
        }
    }
};
template <class Epi, class Sched, bool ALIGN_EPI = false, bool SP2 = false>
__device__ __forceinline__ void gemm_phase(PG8_LAS unsigned char* lds, const Gemm g, const Sched& S, const Epi& E) {
    const int tid = threadIdx.x, wid = __builtin_amdgcn_readfirstlane(tid >> 6), lane = tid & 63, wr = wid >> 2, wc = wid & 3, fr = lane & 15, fq = lane >> 4;
    const int K = g.K, nt = K / BK;
    unsigned voffA[2], voffB[2];
#pragma unroll
    for (int i = 0; i < 2; ++i) { int R, C; stage_rc(tid * 16 + i * 8192, R, C); const int Rb = Epi::PERM ? ((R & ~31) + perm32(R & 31)) : R;
        voffA[i] = (unsigned)(R * K + C) * 2u; voffB[i] = (unsigned)(Rb * K + C) * 2u; }
    const size_t kstep = (size_t)(BK * 2);
    const size_t hstep = (size_t)HALF * K * 2;
    const size_t tstep = 2 * hstep;
    const unsigned ldsw = (unsigned)wid * 1024u;
    const int aoff = lds_byte(wr * 64 + fr, fq * 8), boff = lds_byte(wc * 32 + fr, fq * 8);
#define PG8_SA(b, h) (((b) * 2 + (h)) * HTB)
#define PG8_SB(b, h) ((4 + (b) * 2 + (h)) * HTB)
#define PG8_STAGE(bufoff, gbase, voff) do { _Pragma("unroll") for (int _i = 0; _i < 2; ++_i) \
        __builtin_amdgcn_global_load_lds((const unsigned*)((const char*)(gbase) + (voff)[_i]), (PG8_LAS unsigned*)(lds + (bufoff) + ldsw + _i * 8192), 16, 0, 0); } while (0)
#define PG8_LDA(dst, b, h) do { _Pragma("unroll") for (int m = 0; m < 4; ++m) _Pragma("unroll") for (int k = 0; k < 2; ++k) dst[m][k] = *(const PG8_LAS bf16x8*)(lds + PG8_SA(b, h) + aoff + m * 2048 + k * 1024); } while (0)
#define PG8_LDB(dst, b, h) do { _Pragma("unroll") for (int n = 0; n < 2; ++n) _Pragma("unroll") for (int k = 0; k < 2; ++k) dst[n][k] = *(const PG8_LAS bf16x8*)(lds + PG8_SB(b, h) + boff + n * 2048 + k * 1024); } while (0)
#define PG8_MMA(ai, bj, At, Bt) do { __builtin_amdgcn_s_setprio(1); _Pragma("unroll") for (int m = 0; m < 4; ++m) _Pragma("unroll") for (int n = 0; n < 2; ++n) _Pragma("unroll") for (int k = 0; k < 2; ++k) \
        acc[ai][bj][m][n] = __builtin_amdgcn_mfma_f32_16x16x32_bf16(Bt[n][k], At[m][k], acc[ai][bj][m][n], 0, 0, 0); __builtin_amdgcn_s_setprio(0); } while (0)
#define PG8_WAIT_V(n) asm volatile("s_waitcnt vmcnt(" #n ")" ::: "memory")
#define PG8_WAIT_L(n) asm volatile("s_waitcnt lgkmcnt(" #n ")" ::: "memory")
#define PG8_BAR __builtin_amdgcn_s_barrier()
#define PG8_SCHED __builtin_amdgcn_sched_barrier(0)
    Unit cur, nxt; int ui = 0;
#if defined(MK_SUB)
#define GS_L3 volatile __attribute__((address_space(3)))
    if (threadIdx.x == 0) *(GS_L3 unsigned long long*)(lds + 149504 + 1088) = __builtin_amdgcn_s_memrealtime();
#define GSUB(i) do { if (threadIdx.x == 0) { const unsigned en_ = *(GS_L3 unsigned*)(lds + 149504 + 1096); if (en_) { const unsigned long long n_ = __builtin_amdgcn_s_memrealtime(); GS_L3 unsigned long long* t_ = (GS_L3 unsigned long long*)(lds + 149504 + 1088); \
        GS_L3 unsigned* a_ = (GS_L3 unsigned*)(lds + 149504 + 1104); a_[(en_ - 1) * 4 + (i)] += (unsigned)(n_ - t_[0]); t_[0] = n_; } } } while (0)
#define GSUBC() do { if (threadIdx.x == 0) { const unsigned en_ = *(GS_L3 unsigned*)(lds + 149504 + 1096); if (en_) { GS_L3 unsigned* a_ = (GS_L3 unsigned*)(lds + 149504 + 1104); a_[(en_ - 1) * 4 + 3] += 1u; } } } while (0)
#else
#define GSUB(i) do {} while (0)
#define GSUBC() do {} while (0)
#endif
    if (!S.next(0, cur)) return;
    f32x4 acc[2][2][4][2];
#pragma unroll
    for (int a = 0; a < 2; ++a)
#pragma unroll
        for (int b = 0; b < 2; ++b)
#pragma unroll
            for (int m = 0; m < 4; ++m)
#pragma unroll
                for (int n = 0; n < 2; ++n) acc[a][b][m][n] = (f32x4){0.f, 0.f, 0.f, 0.f};
    bf16x8 At[4][2], B0[2][2], B1[2][2];
    const char* cA = (const char*)g.A + (size_t)cur.pm * tstep; const char* cB = (const char*)g.Bt + (size_t)cur.pn * tstep;
    S.a_ready(cur);
    if constexpr (SP2) {
        PG8_STAGE(PG8_SB(0, 0), cB, voffB); PG8_STAGE(PG8_SB(0, 1), cB + hstep, voffB); PG8_STAGE(PG8_SA(0, 0), cA, voffA); PG8_STAGE(PG8_SA(0, 1), cA + hstep, voffA);
        if (wr == 1) PG8_BAR;
        PG8_WAIT_V(2); PG8_BAR;
        PG8_STAGE(PG8_SB(1, 0), cB + kstep, voffB); PG8_STAGE(PG8_SA(1, 0), cA + kstep, voffA); PG8_STAGE(PG8_SB(1, 1), cB + hstep + kstep, voffB);
        PG8_WAIT_V(6); PG8_BAR;
    } else {
        PG8_STAGE(PG8_SB(0, 0), cB, voffB); PG8_STAGE(PG8_SA(0, 0), cA, voffA); PG8_STAGE(PG8_SB(0, 1), cB + hstep, voffB); PG8_STAGE(PG8_SA(0, 1), cA + hstep, voffA);
        if (wr == 1) PG8_BAR;
        PG8_WAIT_V(4); PG8_BAR;
        PG8_STAGE(PG8_SB(1, 0), cB + kstep, voffB); PG8_STAGE(PG8_SA(1, 0), cA + kstep, voffA); PG8_STAGE(PG8_SB(1, 1), cB + hstep + kstep, voffB);
        PG8_WAIT_V(6); PG8_BAR;
    }
    for (;;) {
        const bool has_next = S.next(ui + 1, nxt);
        const char* nA = has_next ? (const char*)g.A + (size_t)nxt.pm * tstep : cA; const char* nB = has_next ? (const char*)g.Bt + (size_t)nxt.pn * tstep : cB;
        for (int t = 0; t < nt; t += 2) {
            if constexpr (Epi::HAS_MID) { if (t == (nt >> 1)) E.mid(acc, cur, wr, wc, fr, fq); }
            const bool last = (t == nt - 2);
            const char* a1 = cA + (size_t)(t + 1) * kstep;
            const char* a2 = last ? nA : cA + (size_t)(t + 2) * kstep; const char* b2 = last ? nB : cB + (size_t)(t + 2) * kstep;
            const char* a3 = a2 + kstep; const char* b3 = b2 + kstep;
            if (last && has_next) S.a_ready(nxt);
            if constexpr (SP2) {
            PG8_LDB(B0, 0, 0); PG8_LDB(B1, 0, 1); PG8_SCHED; PG8_LDA(At, 0, 0); PG8_STAGE(PG8_SA(1, 1), a1 + hstep, voffA);
            PG8_WAIT_V(8); PG8_WAIT_L(0); PG8_BAR; PG8_MMA(0, 0, At, B0); PG8_MMA(0, 1, At, B1); PG8_BAR; PG8_SCHED;
            PG8_LDA(At, 0, 1); PG8_STAGE(PG8_SB(0, 0), b2, voffB); PG8_STAGE(PG8_SB(0, 1), b2 + hstep, voffB); PG8_STAGE(PG8_SA(0, 0), a2, voffA);
            PG8_WAIT_V(8); PG8_WAIT_L(0); PG8_BAR; PG8_MMA(1, 0, At, B0); PG8_MMA(1, 1, At, B1); PG8_BAR; PG8_SCHED;
            PG8_LDB(B0, 1, 0); PG8_LDB(B1, 1, 1); PG8_SCHED; PG8_LDA(At, 1, 0); PG8_STAGE(PG8_SA(0, 1), a2 + hstep, voffA);
            PG8_WAIT_V(8); PG8_WAIT_L(0); PG8_BAR; PG8_MMA(0, 0, At, B0); PG8_MMA(0, 1, At, B1); PG8_BAR; PG8_SCHED;
            PG8_LDA(At, 1, 1); PG8_STAGE(PG8_SB(1, 0), b3, voffB); PG8_STAGE(PG8_SB(1, 1), b3 + hstep, voffB); PG8_STAGE(PG8_SA(1, 0), a3, voffA);
            PG8_WAIT_V(8); PG8_WAIT_L(0); PG8_BAR; PG8_MMA(1, 0, At, B0); PG8_MMA(1, 1, At, B1); PG8_BAR; PG8_SCHED;
            if (t == 0) GSUB(0);
            } else {
            PG8_LDB(B0, 0, 0); PG8_SCHED; PG8_LDA(At, 0, 0); PG8_STAGE(PG8_SA(1, 1), a1 + hstep, voffA);
            PG8_WAIT_L(8); PG8_BAR; PG8_WAIT_L(0); PG8_MMA(0, 0, At, B0); PG8_BAR; PG8_SCHED;
            PG8_LDB(B1, 0, 1); PG8_STAGE(PG8_SB(0, 0), b2, voffB);
            PG8_BAR; PG8_WAIT_L(0); PG8_MMA(0, 1, At, B1); PG8_BAR;
            PG8_LDA(At, 0, 1); PG8_STAGE(PG8_SA(0, 0), a2, voffA);
            PG8_BAR; PG8_WAIT_L(0); PG8_MMA(1, 0, At, B0); PG8_BAR; PG8_SCHED;
            PG8_STAGE(PG8_SB(0, 1), b2 + hstep, voffB);
            PG8_WAIT_V(6); PG8_BAR; PG8_MMA(1, 1, At, B1); PG8_BAR;
            PG8_LDB(B0, 1, 0); PG8_SCHED; PG8_LDA(At, 1, 0); PG8_STAGE(PG8_SA(0, 1), a2 + hstep, voffA);
            PG8_WAIT_L(8); PG8_BAR; PG8_WAIT_L(0); PG8_MMA(0, 0, At, B0); PG8_BAR; PG8_SCHED;
            PG8_LDB(B1, 1, 1); PG8_STAGE(PG8_SB(1, 0), b3, voffB);
            PG8_BAR; PG8_WAIT_L(0); PG8_MMA(0, 1, At, B1); PG8_BAR;
            PG8_LDA(At, 1, 1); PG8_STAGE(PG8_SA(1, 0), a3, voffA);
            PG8_BAR; PG8_WAIT_L(0); PG8_MMA(1, 0, At, B0); PG8_BAR; PG8_SCHED;
            PG8_STAGE(PG8_SB(1, 1), b3 + hstep, voffB);
            PG8_WAIT_V(6); PG8_BAR; PG8_MMA(1, 1, At, B1); PG8_BAR;
            }
        }
        GSUB(1);
        if constexpr (ALIGN_EPI) { if (wr == 0) PG8_BAR; }
        if constexpr (!Epi::AFTER_DRAIN) { E(acc, cur, wr, wc, fr, fq); S.done(cur); }
        GSUB(2); GSUBC();
        if (!has_next) break;
#pragma unroll
        for (int a = 0; a < 2; ++a)
#pragma unroll
            for (int b = 0; b < 2; ++b)
#pragma unroll
                for (int m = 0; m < 4; ++m)
#pragma unroll
                    for (int n = 0; n < 2; ++n) acc[a][b][m][n] = (f32x4){0.f, 0.f, 0.f, 0.f};
        cur = nxt; cA = nA; cB = nB; ++ui;
        if constexpr (ALIGN_EPI) { if (wr == 1) PG8_BAR; }
    }
    PG8_WAIT_V(0);
    if constexpr (!ALIGN_EPI) { if (wr == 0) PG8_BAR; }
    PG8_BAR;
    if constexpr (Epi::AFTER_DRAIN) { E.fused(acc, cur, wr, wc, fr, fq, lds, wid, lane); S.done(cur); }
#undef PG8_SA
#undef PG8_SB
#undef PG8_STAGE
#undef PG8_LDA
#undef PG8_LDB
#undef PG8_MMA
#undef PG8_WAIT_V
#undef PG8_WAIT_L
#undef PG8_BAR
#undef PG8_SCHED
}
}
#define GAS __attribute__((address_space(1)))
#define LAS __attribute__((address_space(3)))
typedef unsigned short bf16;
typedef unsigned v4u __attribute__((ext_vector_type(4)));
typedef float f32x4 __attribute__((ext_vector_type(4)));
typedef short bf16x8 __attribute__((ext_vector_type(8)));
typedef GAS unsigned gu32;
typedef GAS unsigned long long gu64;
#define RLX_AGENT __ATOMIC_RELAXED, __HIP_MEMORY_SCOPE_AGENT
#define LDS_WAIT() asm volatile("s_waitcnt lgkmcnt(0)" ::: "memory")
#define VM_WAIT() asm volatile("s_waitcnt vmcnt(0)" ::: "memory")
__device__ __forceinline__ unsigned long long rt() { return __builtin_amdgcn_s_memrealtime(); }
__device__ __forceinline__ unsigned f2bf(float f) { unsigned u = __builtin_bit_cast(unsigned, f); return (u + 0x7fffu + ((u >> 16) & 1u)) >> 16; }
typedef float f32x2_cv __attribute__((ext_vector_type(2))); typedef __bf16 bf16x2_cv __attribute__((ext_vector_type(2)));
__device__ __forceinline__ unsigned pk2(float lo, float hi) { const f32x2_cv v = {lo, hi}; const bf16x2_cv b = __builtin_convertvector(v, bf16x2_cv); return __builtin_bit_cast(unsigned, b); }

#define XB_TMO      128
#define XB_XCNT(j)  (256  + 64 * (j))
#define XB_XSUB(j)  (1280 + 64 * (j))
#define XB_XGEN(j)  (2304 + 64 * (j))
#define XB_TOP      3328
#define XB_TOPGEN   3392
#define XCD_BAR_WORDS 3456
#define XB_SPIN_CAP (1u << 18)

__device__ __forceinline__ unsigned xb_ld(unsigned* p)              { return __hip_atomic_load(p, __ATOMIC_RELAXED, __HIP_MEMORY_SCOPE_AGENT); }
__device__ __forceinline__ unsigned xb_add(unsigned* p, unsigned v) { return __hip_atomic_fetch_add(p, v, __ATOMIC_RELAXED, __HIP_MEMORY_SCOPE_AGENT); }
__device__ __forceinline__ unsigned xb_xcc_id() { return (unsigned)__builtin_amdgcn_s_getreg((3 << 11) | 20) & 0xFu; }
#define XB_SPIN(cond, bar) do { unsigned _sp = 0; while (cond) { __builtin_amdgcn_s_sleep(1); \
    if ((++_sp & 255u) == 0u) { if (xb_ld(&(bar)[XB_TMO])) break; if (_sp > XB_SPIN_CAP) { atomicAdd(&(bar)[XB_TMO], 1u); break; } } } } while (0)

struct XcdBarrier {
    unsigned* bar; unsigned x;
    volatile LAS unsigned* st;
};

__device__ __forceinline__ XcdBarrier xcd_barrier_post(unsigned* bar, volatile LAS unsigned* st) {
    XcdBarrier b; b.bar = bar; b.x = xb_xcc_id(); b.st = st;
    if (threadIdx.x == 0) (void)xb_add(&bar[XB_XCNT(b.x)], 1u);
    return b;
}
__device__ __forceinline__ void xcd_barrier_complete(unsigned* bar, unsigned x, unsigned& nloc, unsigned& nx) {
    const unsigned G = gridDim.x * gridDim.y * gridDim.z;
    unsigned sum, cnt, mine, sp = 0u;
    for (;;) {
        sum = 0u; cnt = 0u; mine = 0u;
#pragma unroll
        for (unsigned j = 0; j < 16; ++j) { const unsigned c = xb_ld(&bar[XB_XCNT(j)]); sum += c; cnt += (c > 0u) ? 1u : 0u; mine = (j == x) ? c : mine; }
        if (sum == G) break;
        __builtin_amdgcn_s_sleep(1);
        if ((++sp & 255u) == 0u) { if (xb_ld(&bar[XB_TMO])) break; if (sp > XB_SPIN_CAP) { atomicAdd(&bar[XB_TMO], 1u); break; } }
    }
    nloc = mine > 0u ? mine : 1u; nx = cnt > 0u ? cnt : 1u;
}

__device__ __forceinline__ void xcd_barrier(const XcdBarrier& b) {
    asm volatile("s_waitcnt vmcnt(0)" ::: "memory");
    __syncthreads();
    if (threadIdx.x == 0) {
        unsigned* bar = b.bar;
        __builtin_amdgcn_s_waitcnt(0);
        unsigned nloc = b.st[0], nx = b.st[1];
        if (nloc == 0u) { xcd_barrier_complete(bar, b.x, nloc, nx); b.st[0] = nloc; b.st[1] = nx; }
        const unsigned old = xb_add(&bar[XB_XSUB(b.x)], 1u);
        const unsigned gen = old / nloc;
        if (old + 1u == (gen + 1u) * nloc) {
            __builtin_amdgcn_fence(__ATOMIC_RELEASE, "agent");
            asm volatile("s_waitcnt vmcnt(0)" ::: "memory");
            const unsigned og = xb_add(&bar[XB_TOP], 1u);
            const unsigned tg = og / nx;
            if (og + 1u == (tg + 1u) * nx) xb_add(&bar[XB_TOPGEN], 1u);
            else XB_SPIN(xb_ld(&bar[XB_TOPGEN]) == tg, bar);
            __builtin_amdgcn_fence(__ATOMIC_ACQUIRE, "agent");
            xb_add(&bar[XB_XGEN(b.x)], 1u);
            asm volatile("s_waitcnt vmcnt(0)" ::: "memory");
        } else {
            XB_SPIN(xb_ld(&bar[XB_XGEN(b.x)]) == gen, bar);
            __builtin_amdgcn_fence(__ATOMIC_ACQUIRE, "agent");
            asm volatile("s_waitcnt vmcnt(0)" ::: "memory");
        }
    }
    __syncthreads();
}
#define WG_SYNC() asm volatile("s_waitcnt lgkmcnt(0)\n\ts_barrier" ::: "memory")
constexpr int NWAVES = 8;
constexpr int DM = 2048, NPR = 8192, NSM = 512, NTOK = 8704, TP = 2048, NB = 4, NDB = 128, TS = 4;
constexpr int NIN = 10496, FF = 5632, FF2 = 11264, ADAW = 12288, NADA = 132;
constexpr int C_QKV = 0, C_Z = 3072, C_DQ = 4096, C_DK = 5120, C_DV = 5376, C_IQ = 5632, C_IK = 6144, C_A = 6208, C_B = 6216, C_IW = 6224, C_G1 = 6400, C_G2 = 8448;
constexpr float NORM_EPS = 1e-6f;
constexpr float QSCALE = 0.08838834764831845f * 1.4426950408889634f;
constexpr float IDX_SCALE = 0.35355339059327373f * 0.125f;
constexpr size_t O_Y = 0, O_KP = 17825792, O_VP = O_KP + 2097152, O_IKP = O_VP + 2097152, O_GSP = O_IKP + 524288, O_GCP = O_GSP + 524288, O_FCP = O_GCP + 36864,
                 O_KS = O_FCP + 90112, O_VS = O_KS + 131072, O_IKS = O_VS + 131072, O_GSS = O_IKS + 32768, O_GCS = O_GSS + 16777216, O_FCS = O_GCS + 1179648, O_END = O_FCS + 2883584;
constexpr size_t MiB = 1u << 20;
constexpr size_t al(size_t x) { return (x + MiB - 1) / MiB * MiB; }
constexpr size_t WS_CTL = 0, CTL_ZERO_BYTES = 1 * MiB;
constexpr size_t WS_ROPE = 1 * MiB;
constexpr size_t WS_ADA  = WS_ROPE + al(2052 * 24 * 8);
constexpr size_t WS_WIN  = WS_ADA + al((size_t)NADA * ADAW * 4);
constexpr size_t WS_WG   = WS_WIN + al((size_t)NIN * DM * 2);
constexpr size_t WS_WD   = WS_WG + al((size_t)DM * 1024 * 2);
constexpr size_t WS_WO   = WS_WD + al((size_t)DM * 1024 * 2);
constexpr size_t WS_WUP  = WS_WO + al((size_t)DM * DM * 2);
constexpr size_t WS_WDN  = WS_WUP + al((size_t)FF2 * DM * 2);
constexpr size_t WS_H    = WS_WDN + al((size_t)DM * FF * 2);
constexpr size_t WS_Y1   = WS_H + al((size_t)NTOK * DM * 2);
constexpr size_t WS_QB   = WS_Y1 + al((size_t)NTOK * NIN * 2);
constexpr size_t WS_KB   = WS_QB + al((size_t)NTOK * 1024 * 2);
constexpr size_t WS_VT   = WS_KB + al((size_t)NTOK * 256 * 2);
constexpr size_t WS_IQ   = WS_VT + al((size_t)NPR * 256 * 2);
constexpr size_t WS_IK   = WS_IQ + al((size_t)NTOK * 512 * 2);
constexpr size_t WS_IW   = WS_IK + al((size_t)NTOK * 64 * 2);
constexpr size_t WS_GCH  = WS_IW + al((size_t)NTOK * 8 * 4);
constexpr size_t GCH_BYTES = 98304, GCH_MS = 0, GCH_BT = 32768, GCH_QE = 65536, GCH_OLT = 81920;
constexpr size_t WS_GE   = WS_GCH + al((size_t)1024 * GCH_BYTES);
constexpr size_t WS_OG   = WS_GE + MiB;
constexpr size_t WS_OD   = WS_OG + al((size_t)NTOK * 1024 * 2);
constexpr size_t WS_MIX  = WS_OD + al((size_t)NTOK * 1024 * 2);
constexpr size_t WS_X1   = WS_MIX + al((size_t)NTOK * DM * 2);
constexpr size_t WS_U    = WS_X1 + al((size_t)NTOK * DM * 4);
constexpr size_t WS_ACT  = WS_U + al((size_t)NTOK * FF2 * 2);
constexpr size_t WS_SCR  = WS_ACT + al((size_t)NTOK * FF * 2);
constexpr size_t WS_SN   = WS_SCR + al((size_t)256 * 32 * 2048 * 4);
constexpr size_t WS_HB   = WS_SN + al((size_t)1024 * 128 * 128 * 2);
constexpr size_t WS_ABF  = WS_HB + al((size_t)128 * 4 * 11264 * 2);
constexpr size_t WS_END  = WS_ABF + al((size_t)144 * 2048 * 2);
constexpr int CW_BAR = 4096;
constexpr int CW_ABF = 12288;
constexpr int CW_QUEUE = 16384;
constexpr int RING_OFF = 0, RING_BYTES = 131072;
constexpr int P2_DEFER = 1024;
constexpr int LDSCTL_OFF = 149504, MISC_OFF = LDSCTL_OFF + 320;
constexpr int LDS_BYTES = 151552;

struct Args {
    const float* in[28]; float* out; unsigned char* ws;
    double invf[24];
    int ph_lo, ph_hi;
};
struct Frame {
    LAS unsigned char* lds;
    gu32* ctl;
    int tid, lane, wave, G, bid;
};
typedef unsigned short bf16;
typedef unsigned u32x2v __attribute__((ext_vector_type(2)));
typedef float f32x2v __attribute__((ext_vector_type(2)));
__device__ __forceinline__ float wave_sum(float v) {
#pragma unroll
    for (int o = 1; o < 64; o <<= 1) v += __shfl_xor(v, o);
    return v;
}
__device__ __forceinline__ float xh_sum(float v) { auto rr = __builtin_amdgcn_permlane32_swap(__float_as_uint(v), __float_as_uint(v), false, false); return __uint_as_float(rr[0]) + __uint_as_float(rr[1]); }
__device__ __forceinline__ float xh_max(float v) { auto rr = __builtin_amdgcn_permlane32_swap(__float_as_uint(v), __float_as_uint(v), false, false); return fmaxf(__uint_as_float(rr[0]), __uint_as_float(rr[1])); }
__device__ __forceinline__ float bf2f(unsigned short b) { return __uint_as_float(((unsigned)b) << 16); }
__device__ __forceinline__ float bflo(unsigned w) { return __uint_as_float(w << 16); }
__device__ __forceinline__ float bfhi(unsigned w) { return __uint_as_float(w & 0xffff0000u); }
__device__ __forceinline__ float silu_f(float x) { return x * __builtin_amdgcn_rcpf(1.0f + __expf(-x)); }
__device__ __forceinline__ float sigm_f(float x) { return __builtin_amdgcn_rcpf(1.0f + __expf(-x)); }
__device__ __forceinline__ f32x4 mfma16(bf16x8 a, bf16x8 b, f32x4 c) { return __builtin_amdgcn_mfma_f32_16x16x32_bf16(a, b, c, 0, 0, 0); }
__device__ __forceinline__ int ada_row(int m) { return m < NPR ? (m >> 11) : 4 + ((m - NPR) >> 2); }

__device__ __forceinline__ void p0_silu(Frame& F, const float* c_prompt, const float* c_sample, bf16* ABF, unsigned* cnt) {
    for (int r = F.bid; r < 144; r += F.G) {
        const float* rp = (r < 4) ? c_prompt + (size_t)r * DM : c_sample + (size_t)(r - 4) * DM;
        f32x4 v = (f32x4){0.f, 0.f, 0.f, 0.f};
        if (r < NADA) v = *(const GAS f32x4*)(rp + 4 * F.tid);
        u32x2v o; o.x = (r < NADA) ? pk2(silu_f(v.x), silu_f(v.y)) : 0u; o.y = (r < NADA) ? pk2(silu_f(v.z), silu_f(v.w)) : 0u;
        *(GAS u32x2v*)(ABF + (size_t)r * DM + 4 * F.tid) = o;
        asm volatile("s_waitcnt vmcnt(0)" ::: "memory");
        __syncthreads();
        if (F.tid == 0) {
            __builtin_amdgcn_fence(__ATOMIC_RELEASE, "agent");
            asm volatile("s_waitcnt vmcnt(0)" ::: "memory");
            (void)xb_add(cnt, 1u);
        }
    }
}
__device__ __forceinline__ void p0_ada(Frame& F, const bf16* ABF, unsigned* cnt, unsigned* tmo, const float* w_ada, const float* b_ada, float* ADA) {
    LAS bf16* Bs = (LAS bf16*)(F.lds);
    const int tid = F.tid, lane = F.lane, w = F.wave;
    if (tid == 0) {
        XB_SPIN(xb_ld(cnt) < 144u, tmo);
        __builtin_amdgcn_fence(__ATOMIC_ACQUIRE, "agent");
        asm volatile("s_waitcnt vmcnt(0)" ::: "memory");
    }
    __syncthreads();
    for (int j = F.bid; j < 256; j += F.G) {
        const int n0 = 48 * j;
        f32x4 acc[2][3];
#pragma unroll
        for (int a = 0; a < 2; ++a)
#pragma unroll
            for (int b = 0; b < 3; ++b) acc[a][b] = (f32x4){0.f, 0.f, 0.f, 0.f};
        f32x4 vb[7]; v4u pa[9];
        const unsigned boff = (unsigned)((tid / 12) * ADAW + (tid % 12) * 4);
        const int bkk = tid / 12, bn4 = tid % 12;
        LAS bf16* As = (LAS bf16*)(F.lds + 25344);
        const bf16* ap0 = ABF + (size_t)(tid >> 5) * DM + 8 * (tid & 31);
#define ADA_LOAD(k0_) do { \
        _Pragma("unroll") for (int i = 0; i < 6; ++i) vb[i] = (tid < 504) ? *(const GAS f32x4*)(w_ada + (size_t)((k0_) + 42 * i) * ADAW + n0 + boff) : (f32x4){0.f, 0.f, 0.f, 0.f}; \
        vb[6] = (tid < 48) ? *(const GAS f32x4*)(w_ada + (size_t)((k0_) + 252) * ADAW + n0 + boff) : (f32x4){0.f, 0.f, 0.f, 0.f}; \
        _Pragma("unroll") for (int i = 0; i < 9; ++i) pa[i] = *(const GAS v4u*)(ap0 + (size_t)(16 * i) * DM + (k0_)); } while (0)
        ADA_LOAD(0);
        for (int kc = 0; kc < 8; ++kc) {
            const int k0 = 256 * kc;
            WG_SYNC();
#pragma unroll
            for (int i = 0; i < 7; ++i) { const int kk = bkk + 42 * i;
                if ((i < 6 && tid < 504) || (i == 6 && tid < 48)) {
                    Bs[(4 * bn4 + 0) * 264 + kk] = (bf16)f2bf(vb[i].x); Bs[(4 * bn4 + 1) * 264 + kk] = (bf16)f2bf(vb[i].y);
                    Bs[(4 * bn4 + 2) * 264 + kk] = (bf16)f2bf(vb[i].z); Bs[(4 * bn4 + 3) * 264 + kk] = (bf16)f2bf(vb[i].w); } }
#pragma unroll
            for (int i = 0; i < 9; ++i) *(LAS v4u*)(As + ((tid >> 5) + 16 * i) * 264 + 8 * (tid & 31)) = pa[i];
            if (kc < 7) ADA_LOAD(k0 + 256);
            WG_SYNC();
#pragma unroll
            for (int kh = 0; kh < 4; ++kh) {
                bf16x8 fb[3][2];
#pragma unroll
                for (int nt = 0; nt < 3; ++nt)
#pragma unroll
                    for (int k4 = 0; k4 < 2; ++k4) fb[nt][k4] = *(const LAS bf16x8*)(Bs + (nt * 16 + (lane & 15)) * 264 + (2 * kh + k4) * 32 + 8 * (lane >> 4));
                bf16x8 fa0[2];
#pragma unroll
                for (int k4 = 0; k4 < 2; ++k4) fa0[k4] = *(const LAS bf16x8*)(As + (w * 16 + (lane & 15)) * 264 + (2 * kh + k4) * 32 + 8 * (lane >> 4));
                __builtin_amdgcn_sched_barrier(0);
#pragma unroll
                for (int k4 = 0; k4 < 2; ++k4)
#pragma unroll
                    for (int nt = 0; nt < 3; ++nt) acc[0][nt] = mfma16(fa0[k4], fb[nt][k4], acc[0][nt]);
                if (w == 0) {
                    bf16x8 fa1[2];
#pragma unroll
                    for (int k4 = 0; k4 < 2; ++k4) fa1[k4] = *(const LAS bf16x8*)(As + (128 + (lane & 15)) * 264 + (2 * kh + k4) * 32 + 8 * (lane >> 4));
#pragma unroll
                    for (int k4 = 0; k4 < 2; ++k4)
#pragma unroll
                        for (int nt = 0; nt < 3; ++nt) acc[1][nt] = mfma16(fa1[k4], fb[nt][k4], acc[1][nt]);
                }
            }
        }
#pragma unroll
        for (int mi = 0; mi < 2; ++mi) {
            const int mt = w + 8 * mi;
            if (mt < 9) {
#pragma unroll
                for (int nt = 0; nt < 3; ++nt) {
                    const int col = n0 + nt * 16 + (lane & 15); const float bb = b_ada[col];
#pragma unroll
                    for (int r = 0; r < 4; ++r) { const int row = mt * 16 + 4 * (lane >> 4) + r; if (row < NADA) ADA[(size_t)row * ADAW + col] = acc[mi][nt][r] + bb; }
                }
            }
        }
    }
#undef ADA_LOAD
    WG_SYNC();
}
template <class Map>
__device__ __forceinline__ void transpose_item(const float* W, int K, int N, bf16* WT, LAS float* scr, int kb, int nb, int lane, const Map& map) {
    const int k0 = 64 * kb, n0 = 64 * nb;
    const int src = map(n0 + 4 * (lane & 15));
    f32x4 v[16];
#pragma unroll
    for (int i = 0; i < 16; ++i) { const int kk = 4 * i + (lane >> 4); v[i] = (src >= 0) ? *(const GAS f32x4*)(W + (size_t)(k0 + kk) * N + src) : (f32x4){0.f, 0.f, 0.f, 0.f}; }
#pragma unroll
    for (int i = 0; i < 16; ++i) { const int kk = 4 * i + (lane >> 4); LAS float* d = scr + kk * 65 + 4 * (lane & 15); d[0] = v[i].x; d[1] = v[i].y; d[2] = v[i].z; d[3] = v[i].w; }
    LDS_WAIT(); asm volatile("" ::: "memory");
    const int c = lane & 7;
#pragma unroll
    for (int j = 0; j < 8; ++j) { const int n = (lane >> 3) + 8 * j; const LAS float* s = scr + (8 * c) * 65 + n;
        v4u o; o.x = pk2(s[0 * 65], s[1 * 65]); o.y = pk2(s[2 * 65], s[3 * 65]); o.z = pk2(s[4 * 65], s[5 * 65]); o.w = pk2(s[6 * 65], s[7 * 65]);
        *(GAS v4u*)(WT + (size_t)(n0 + n) * K + k0 + 8 * c) = o; }
    LDS_WAIT(); asm volatile("" ::: "memory");
}
struct MapIn { __device__ __forceinline__ int operator()(int n) const {
    if (n < 4096) return n; if (n < 6208) return n + 16; if (n < 6224) return n - 6208 + 4096; if (n < 6232) return n; if (n < 6400) return -1; return n - 168; } };
struct MapId { __device__ __forceinline__ int operator()(int n) const { return n; } };
struct MapUp { __device__ __forceinline__ int operator()(int n) const { return ((n >> 7) & 1) * 5632 + (n >> 8) * 128 + (n & 127); } };
template <class Map>
__device__ __forceinline__ void transpose_all(Frame& F, const float* W, int K, int N, int Nd, bf16* WT, const Map& map) {
    LAS float* scr = (LAS float*)(F.lds + RING_OFF + F.wave * 16640);
    const int gw = F.bid * NWAVES + F.wave, NGW = F.G * NWAVES;
    const int nblk = Nd / 64, items = (K / 64) * nblk;
    for (int it = gw; it < items; it += NGW) transpose_item(W, K, N, WT, scr, it / nblk, it % nblk, F.lane, map);
}
__device__ __forceinline__ void p0_rope(Frame& F, const Args& args, f32x2v* ROPE) {
    const int gt = F.bid * 512 + F.tid, NT = F.G * 512;
    for (int i = gt; i < 2052 * 24; i += NT) {
        const int pos = i / 24, f = i % 24;
        double rev = (double)pos * args.invf[f] * 0.15915494309189535;
        rev -= __builtin_floor(rev);
        const float r = (float)rev;
        ROPE[i] = (f32x2v){__builtin_amdgcn_cosf(r), __builtin_amdgcn_sinf(r)};
    }
}
__device__ __forceinline__ void norm_mod_row(const float* xrow, const float* g, const float* sh, const float* sc, bf16* orow, int lane) {
    const GAS f32x4* xr = (const GAS f32x4*)xrow + lane;
    f32x4 v[8], gg[8], s1[8], s0[8]; float s = 0.f;
#pragma unroll
    for (int j = 0; j < 8; ++j) v[j] = xr[64 * j];
#pragma unroll
    for (int j = 0; j < 8; ++j) { const int idx = 4 * lane + 256 * j; gg[j] = *(const GAS f32x4*)(g + idx); s1[j] = *(const GAS f32x4*)(sc + idx); s0[j] = *(const GAS f32x4*)(sh + idx); }
#pragma unroll
    for (int j = 0; j < 8; ++j) s += (v[j].x * v[j].x + v[j].y * v[j].y) + (v[j].z * v[j].z + v[j].w * v[j].w);
    const float rstd = __builtin_amdgcn_rsqf(wave_sum(s) * (1.0f / DM) + NORM_EPS);
    GAS u32x2v* o8 = (GAS u32x2v*)orow + lane;
#pragma unroll
    for (int j = 0; j < 8; ++j) {
        const f32x4 y = v[j] * rstd * gg[j] * (s1[j] + 1.0f) + s0[j];
        u32x2v o; o.x = pk2(y.x, y.y); o.y = pk2(y.z, y.w); o8[64 * j] = o;
    }
}
template <bool XBF, class XRow>
__device__ __forceinline__ void norm_mod_pass(Frame& F, const XRow& xrow, const float* g, const float* ADA, int sh_off, int sc_off, bf16* O) {
    int tid = F.tid; asm volatile("" : "+v"(tid));
    const int lane = tid & 63, w = __builtin_amdgcn_readfirstlane(tid >> 6), NGW = F.G * NWAVES;
    LAS float* Gs = (LAS float*)F.lds;
    LAS float* Sh = Gs + 2048;
    LAS float* Sc = Sh + 4096;
#define NM_LOAD(mb_, v_, st_) do { const int m_ = (mb_) + w; \
        if constexpr (XBF) { const GAS v4u* xr_ = (const GAS v4u*)xrow(m_ < NTOK ? m_ : NTOK - 1) + lane; \
          _Pragma("unroll") for (int jj = 0; jj < 4; ++jj) { const v4u t_ = xr_[64 * jj]; v_[2 * jj] = (f32x4){bflo(t_.x), bfhi(t_.x), bflo(t_.y), bfhi(t_.y)}; v_[2 * jj + 1] = (f32x4){bflo(t_.z), bfhi(t_.z), bflo(t_.w), bfhi(t_.w)}; } } \
        else { const GAS f32x4* xr_ = (const GAS f32x4*)xrow(m_ < NTOK ? m_ : NTOK - 1) + lane; \
          _Pragma("unroll") for (int j = 0; j < 8; ++j) v_[j] = xr_[64 * j]; } \
        const int r0_ = ada_row(mb_), r1_ = ada_row((mb_) + 4 < NTOK ? (mb_) + 4 : NTOK - 1); \
        st_[0] = *(const GAS f32x4*)(ADA + (size_t)r0_ * ADAW + sh_off + 4 * tid); st_[1] = *(const GAS f32x4*)(ADA + (size_t)r1_ * ADAW + sh_off + 4 * tid); \
        st_[2] = *(const GAS f32x4*)(ADA + (size_t)r0_ * ADAW + sc_off + 4 * tid); st_[3] = *(const GAS f32x4*)(ADA + (size_t)r1_ * ADAW + sc_off + 4 * tid); } while (0)
    f32x4 v[8], st[4];
    WG_SYNC();
    *(LAS f32x4*)(Gs + 4 * tid) = *(const GAS f32x4*)(g + 4 * tid);
    if (8 * F.bid < NTOK) NM_LOAD(8 * F.bid, v, st);
#pragma unroll 1
    for (int mb = 8 * F.bid; mb < NTOK; mb += NGW) {
        const int m = mb + w;
        WG_SYNC();
        *(LAS f32x4*)(Sh + 4 * tid) = st[0]; *(LAS f32x4*)(Sh + 2048 + 4 * tid) = st[1]; *(LAS f32x4*)(Sc + 4 * tid) = st[2]; *(LAS f32x4*)(Sc + 2048 + 4 * tid) = st[3];
        WG_SYNC();
        f32x4 nv[8], nst[4];
        const bool more = mb + NGW < NTOK;
        if (more) NM_LOAD(mb + NGW, nv, nst);
        __builtin_amdgcn_sched_barrier(0);
        if (m < NTOK) {
            const LAS float* sh = Sh + (w >> 2) * 2048; const LAS float* sc = Sc + (w >> 2) * 2048;
            float s = 0.f;
#pragma unroll
            for (int j = 0; j < 8; ++j) s += (v[j].x * v[j].x + v[j].y * v[j].y) + (v[j].z * v[j].z + v[j].w * v[j].w);
            const float rstd = __builtin_amdgcn_rsqf(wave_sum(s) * (1.0f / DM) + NORM_EPS);
#pragma unroll
            for (int j = 0; j < 8; ++j) {
                const int idx = XBF ? 8 * lane + 512 * (j >> 1) + 4 * (j & 1) : 4 * lane + 256 * j;
                const f32x4 gg = *(const LAS f32x4*)(Gs + idx), s1 = *(const LAS f32x4*)(sc + idx), s0 = *(const LAS f32x4*)(sh + idx);
                const f32x4 y = v[j] * rstd * gg * (s1 + 1.0f) + s0;
                u32x2v o; o.x = pk2(y.x, y.y); o.y = pk2(y.z, y.w); *(GAS u32x2v*)(O + (size_t)m * DM + idx) = o;
            }
        }
        if (more) {
#pragma unroll
            for (int j = 0; j < 8; ++j) v[j] = nv[j];
#pragma unroll
            for (int j = 0; j < 4; ++j) st[j] = nst[j];
        }
    }
#undef NM_LOAD
    WG_SYNC();
}
template <bool SPLIT2 = false, class Epi>
__device__ __forceinline__ void small_gemm(Frame& F, const bf16* A, int lda, const bf16* Bt, int K, const Epi& epi) {
    int tid = F.tid; asm volatile("" : "+v"(tid));
    const int lane = tid & 63, w = __builtin_amdgcn_readfirstlane(tid >> 6), l15 = lane & 15, g4 = lane >> 4;
    LAS float* red = (LAS float*)F.lds;
    const int kw = K >> 3, nks = kw >> 5;
    for (int tile = F.bid; tile < 256; tile += F.G) {
        const int tm = tile >> 5, tn = tile & 31;
        const bf16* ap = A + (size_t)(64 * tm + l15) * lda + w * kw + 16 * g4;
        const bf16* bp = Bt + (size_t)(64 * tn + l15) * K + w * kw + 16 * g4;
        f32x4 acc[4][4];
#pragma unroll
        for (int i = 0; i < 4; ++i)
#pragma unroll
            for (int j = 0; j < 4; ++j) acc[i][j] = (f32x4){0.f, 0.f, 0.f, 0.f};
        {
            LAS unsigned char* wl = F.lds + w * 18432;
            const int lr = lane >> 3, lc = lane & 7;
            const bf16* apc = A + (size_t)(64 * tm + lr) * lda + w * kw + 8 * lc;
            const bf16* bpc = Bt + (size_t)(64 * tn + lr) * K + w * kw + 8 * lc;
            const int nd = nks >> 1;
            v4u la[8], lb[8];
#pragma unroll
            for (int i = 0; i < 8; ++i) { la[i] = *(const GAS v4u*)(apc + (size_t)(8 * i) * lda); lb[i] = *(const GAS v4u*)(bpc + (size_t)(8 * i) * K); }
            WG_SYNC();
#pragma unroll 1
            for (int d = 0; d < nd; ++d) {
#pragma unroll
                for (int i = 0; i < 8; ++i) { *(LAS v4u*)(wl + (8 * i + lr) * 144 + 16 * lc) = la[i]; *(LAS v4u*)(wl + 9216 + (8 * i + lr) * 144 + 16 * lc) = lb[i]; }
                if (d + 1 < nd) {
#pragma unroll
                    for (int i = 0; i < 8; ++i) { la[i] = *(const GAS v4u*)(apc + (size_t)(8 * i) * lda + 64 * (d + 1)); lb[i] = *(const GAS v4u*)(bpc + (size_t)(8 * i) * K + 64 * (d + 1)); }
                }
#pragma unroll
                for (int sst = 0; sst < 2; ++sst) {
                    bf16x8 fa[4], fbq[4];
#pragma unroll
                    for (int i = 0; i < 4; ++i) { fa[i] = *(const LAS bf16x8*)(wl + (16 * i + l15) * 144 + 64 * sst + 16 * g4); fbq[i] = *(const LAS bf16x8*)(wl + 9216 + (16 * i + l15) * 144 + 64 * sst + 16 * g4); }
                    __builtin_amdgcn_sched_barrier(0);
#pragma unroll
                    for (int i = 0; i < 4; ++i)
#pragma unroll
                        for (int j = 0; j < 4; ++j) acc[i][j] = mfma16(fa[i], fbq[j], acc[i][j]);
                }
            }
        }
        WG_SYNC();
#pragma unroll
        for (int i = 0; i < 4; ++i)
#pragma unroll
            for (int j = 0; j < 4; ++j)
#pragma unroll
                for (int r = 0; r < 4; ++r) red[(w * 64 + 16 * i + 4 * g4 + r) * 64 + 16 * j + l15] = acc[i][j][r];
        WG_SYNC();
        { const int row = tid >> 3, c0 = (tid & 7) * 8;
          const int grow = 64 * tm + row, gcol = 64 * tn + c0;
          if constexpr (!SPLIT2) {
              f32x4 s0 = (f32x4){0.f, 0.f, 0.f, 0.f}, s1 = s0;
#pragma unroll
              for (int ww = 0; ww < 8; ++ww) { s0 += *(const LAS f32x4*)(red + (ww * 64 + row) * 64 + c0); s1 += *(const LAS f32x4*)(red + (ww * 64 + row) * 64 + c0 + 4); }
              epi(grow, gcol, s0, s1);
          } else {
              f32x4 a0 = (f32x4){0.f, 0.f, 0.f, 0.f}, a1 = a0, b0 = a0, b1 = a0;
#pragma unroll
              for (int ww = 0; ww < 4; ++ww) { a0 += *(const LAS f32x4*)(red + (ww * 64 + row) * 64 + c0); a1 += *(const LAS f32x4*)(red + (ww * 64 + row) * 64 + c0 + 4);
                  b0 += *(const LAS f32x4*)(red + ((ww + 4) * 64 + row) * 64 + c0); b1 += *(const LAS f32x4*)(red + ((ww + 4) * 64 + row) * 64 + c0 + 4); }
              epi(grow, gcol, a0, a1, b0, b1);
          } }
    }
    WG_SYNC();
}
__device__ __forceinline__ void unpack8(const v4u w, float (&f)[8]) {
    f[0] = bflo(w.x); f[1] = bfhi(w.x); f[2] = bflo(w.y); f[3] = bfhi(w.y); f[4] = bflo(w.z); f[5] = bfhi(w.z); f[6] = bflo(w.w); f[7] = bfhi(w.w); }
struct P3Bufs { const bf16* Y1; const f32x2v* ROPE; bf16 *QB, *KB, *IQ, *IK; float* IW; float* out; };
template <int HC>
__device__ __forceinline__ void rot_apply8(int dc, const f32x2v* cs8, const v4u vw, const v4u pw, float (&v)[8]) {
    unpack8(vw, v);
    if (dc < 2 * HC) {
        float p[8]; unpack8(pw, p);
        const bool first = dc < HC;
#pragma unroll
        for (int e = 0; e < 8; ++e) { const f32x2v cs = cs8[e]; v[e] = first ? v[e] * cs.x - p[e] * cs.y : v[e] * cs.x + p[e] * cs.y; }
    }
}
__device__ __forceinline__ v4u pack8(const float (&v)[8]) { return (v4u){pk2(v[0], v[1]), pk2(v[2], v[3]), pk2(v[4], v[5]), pk2(v[6], v[7])}; }
__device__ __forceinline__ void p3_rot_row(const P3Bufs& P, int m, int lane) {
    asm volatile("" : "+v"(lane));
    const bf16* y = P.Y1 + (size_t)m * NIN;
    const bool pr = m < NPR;
    const int pos = pr ? (m & (TP - 1)) : TP + ((m - NPR) & 3);
    const f32x2v* rp = P.ROPE + pos * 24;
    float* kout = pr ? P.out + O_KP + (size_t)m * 256 : P.out + O_KS + (size_t)(m - NPR) * 256;
    float* vout = pr ? P.out + O_VP + (size_t)m * 256 : P.out + O_VS + (size_t)(m - NPR) * 256;
    float* ikout = pr ? P.out + O_IKP + (size_t)m * 64 : P.out + O_IKS + (size_t)(m - NPR) * 64;
    const int c0 = lane, c1 = lane + 64, ck = lane & 31;
    const v4u q0 = *(const GAS v4u*)(y + C_DQ + 8 * c0), q0p = *(const GAS v4u*)(y + C_DQ + 8 * (c0 ^ 2)), q1 = *(const GAS v4u*)(y + C_DQ + 8 * c1), q1p = *(const GAS v4u*)(y + C_DQ + 8 * (c1 ^ 2));
    const v4u kv = *(const GAS v4u*)(y + (lane < 32 ? C_DK : C_DV) + 8 * ck), kvp = *(const GAS v4u*)(y + (lane < 32 ? C_DK : C_DV) + 8 * (ck ^ 2));
    const v4u iqv = *(const GAS v4u*)(y + C_IQ + 8 * c0), iqp = *(const GAS v4u*)(y + C_IQ + 8 * (c0 ^ 1));
    const v4u ikv = *(const GAS v4u*)(y + C_IK + 8 * (lane & 7)), ikp = *(const GAS v4u*)(y + C_IK + 8 * ((lane & 7) ^ 1)), iwv = *(const GAS v4u*)(y + C_IW);
    f32x2v csA[8], csB[8];
#pragma unroll
    for (int e = 0; e < 8; ++e) { csA[e] = rp[8 * (c0 & 1) + e]; csB[e] = rp[16 + e]; }
    float v[8];
    rot_apply8<2>(c0 & 15, csA, q0, q0p, v);
#pragma unroll
    for (int e = 0; e < 8; ++e) v[e] *= QSCALE;
    *(GAS v4u*)(P.QB + (size_t)m * 1024 + 8 * c0) = pack8(v);
    rot_apply8<2>(c1 & 15, csA, q1, q1p, v);
#pragma unroll
    for (int e = 0; e < 8; ++e) v[e] *= QSCALE;
    *(GAS v4u*)(P.QB + (size_t)m * 1024 + 8 * c1) = pack8(v);
    if (lane < 32) {
        rot_apply8<2>(ck & 15, csA, kv, kvp, v);
        *(GAS v4u*)(P.KB + (size_t)m * 256 + 8 * ck) = pack8(v);
        *(f32x4*)(kout + 8 * ck) = (f32x4){v[0], v[1], v[2], v[3]}; *(f32x4*)(kout + 8 * ck + 4) = (f32x4){v[4], v[5], v[6], v[7]};
    } else {
        unpack8(kv, v);
        *(f32x4*)(vout + 8 * ck) = (f32x4){v[0], v[1], v[2], v[3]}; *(f32x4*)(vout + 8 * ck + 4) = (f32x4){v[4], v[5], v[6], v[7]};
    }
    rot_apply8<1>(c0 & 7, csB, iqv, iqp, v);
    *(GAS v4u*)(P.IQ + (size_t)m * 512 + 8 * c0) = pack8(v);
    if (lane < 8) {
        rot_apply8<1>(lane, csB, ikv, ikp, v);
        *(GAS v4u*)(P.IK + (size_t)m * 64 + 8 * lane) = pack8(v);
        *(f32x4*)(ikout + 8 * lane) = (f32x4){v[0], v[1], v[2], v[3]}; *(f32x4*)(ikout + 8 * lane + 4) = (f32x4){v[4], v[5], v[6], v[7]};
    } else if (lane == 8) {
        unpack8(iwv, v);
        *(f32x4*)(P.IW + (size_t)m * 8) = (f32x4){v[0], v[1], v[2], v[3]} * IDX_SCALE; *(f32x4*)(P.IW + (size_t)m * 8 + 4) = (f32x4){v[4], v[5], v[6], v[7]} * IDX_SCALE;
    }
    int crow = -1; float* cout = nullptr;
    if (pr) { const int t = m & (TP - 1); if (t >= TP - 3) { crow = t - (TP - 3); cout = P.out + O_GCP + (size_t)((m >> 11) * 3 + crow) * 3072; } }
    else { const int ts = (m - NPR) & 3; if (ts >= 1) { crow = ts - 1; cout = P.out + O_GCS + (size_t)(((m - NPR) >> 2) * 3 + crow) * 3072; } }
    if (crow >= 0) {
#pragma unroll
        for (int i = 0; i < 6; ++i) { const int c = lane + 64 * i; unpack8(*(const GAS v4u*)(y + C_QKV + 8 * c), v);
            *(f32x4*)(cout + 8 * c) = (f32x4){v[0], v[1], v[2], v[3]}; *(f32x4*)(cout + 8 * c + 4) = (f32x4){v[4], v[5], v[6], v[7]}; }
    }
}
__device__ __forceinline__ void p3_vt(Frame& F, const bf16* Y1, bf16* VT) {
    LAS bf16* T = (LAS bf16*)F.lds;
    for (int it = F.bid; it < 256; it += F.G) {
        const int b = it >> 6, kvh = (it >> 5) & 1, tt = it & 31;
        WG_SYNC();
        { const int t = F.tid >> 3, c = F.tid & 7;
          const bf16* src = Y1 + (size_t)(b * TP + tt * 64 + t) * NIN + C_DV + kvh * 128 + c * 16;
          const v4u a = *(const GAS v4u*)src, bq = *(const GAS v4u*)(src + 8);
          LAS unsigned* dst = (LAS unsigned*)(T + t * 130 + c * 16);
          dst[0] = a.x; dst[1] = a.y; dst[2] = a.z; dst[3] = a.w; dst[4] = bq.x; dst[5] = bq.y; dst[6] = bq.z; dst[7] = bq.w; }
        WG_SYNC();
        { const int d = F.tid >> 2, q = F.tid & 3;
          unsigned w[8];
#pragma unroll
          for (int e = 0; e < 8; ++e) w[e] = (unsigned)T[(q * 16 + 2 * e) * 130 + d] | ((unsigned)T[(q * 16 + 2 * e + 1) * 130 + d] << 16);
          bf16* dst = VT + ((size_t)((b * 2 + kvh) * 128 + d)) * TP + tt * 64 + q * 16;
          *(GAS v4u*)dst = (v4u){w[0], w[1], w[2], w[3]}; *(GAS v4u*)(dst + 8) = (v4u){w[4], w[5], w[6], w[7]}; }
    }
    WG_SYNC();
}
__device__ __forceinline__ void p9_conv(Frame& F, const bf16* U, const float* state_ffn, const float* wc, const float* bc, bf16* ACT, float* out) {
    const int gw = F.bid * NWAVES + F.wave, NGW = F.G * NWAVES, lane = F.lane;
    for (int it = gw; it < 128 * 11; it += NGW) {
        const int sq = it / 11, ci = it % 11, j0 = ci * 512 + lane * 8, m0 = NPR + 4 * sq;
        v4u ug[4], uv[4];
#pragma unroll
        for (int q = 0; q < 4; ++q) { ug[q] = *(const GAS v4u*)(U + (size_t)(m0 + q) * FF2 + j0); uv[q] = *(const GAS v4u*)(U + (size_t)(m0 + q) * FF2 + FF + j0); }
        const float* sb = state_ffn + (size_t)sq * 2 * FF2 + j0;
        f32x4 sg[2][2], sv[2][2];
#pragma unroll
        for (int r = 0; r < 2; ++r) { sg[r][0] = *(const GAS f32x4*)(sb + (size_t)r * FF2); sg[r][1] = *(const GAS f32x4*)(sb + (size_t)r * FF2 + 4);
            sv[r][0] = *(const GAS f32x4*)(sb + (size_t)r * FF2 + FF); sv[r][1] = *(const GAS f32x4*)(sb + (size_t)r * FF2 + FF + 4); }
        float wgt[8][8];
#pragma unroll
        for (int q = 0; q < 8; ++q) { const float* src = (q & 3) == 3 ? bc + (q >> 2) * FF + j0 : wc + (size_t)(q & 3) * FF2 + (q >> 2) * FF + j0;
            const f32x4 lo = *(const GAS f32x4*)src, hi = *(const GAS f32x4*)(src + 4);
            wgt[q][0] = lo.x; wgt[q][1] = lo.y; wgt[q][2] = lo.z; wgt[q][3] = lo.w; wgt[q][4] = hi.x; wgt[q][5] = hi.y; wgt[q][6] = hi.z; wgt[q][7] = hi.w; }
        float g2[8], g1[8], v2[8], v1[8];
#pragma unroll
        for (int e = 0; e < 4; ++e) { g2[e] = sg[0][0][e]; g2[4 + e] = sg[0][1][e]; g1[e] = sg[1][0][e]; g1[4 + e] = sg[1][1][e];
            v2[e] = sv[0][0][e]; v2[4 + e] = sv[0][1][e]; v1[e] = sv[1][0][e]; v1[4 + e] = sv[1][1][e]; }
#pragma unroll
        for (int q = 0; q < 4; ++q) {
            float g0[8], v0[8], a[8];
            unpack8(ug[q], g0); unpack8(uv[q], v0);
#pragma unroll
            for (int e = 0; e < 8; ++e) {
                const float gg = wgt[3][e] + wgt[0][e] * g2[e] + wgt[1][e] * g1[e] + wgt[2][e] * g0[e];
                const float vv = wgt[7][e] + wgt[4][e] * v2[e] + wgt[5][e] * v1[e] + wgt[6][e] * v0[e];
                a[e] = silu_f(gg) * vv;
            }
            *(GAS v4u*)(ACT + (size_t)(m0 + q) * FF + j0) = (v4u){pk2(a[0], a[1]), pk2(a[2], a[3]), pk2(a[4], a[5]), pk2(a[6], a[7])};
            if (q >= 2) {
                float* co = out + O_FCS + (size_t)(sq * 2 + (q - 2)) * FF2;
                *(f32x4*)(co + j0) = (f32x4){g0[0], g0[1], g0[2], g0[3]}; *(f32x4*)(co + j0 + 4) = (f32x4){g0[4], g0[5], g0[6], g0[7]};
                *(f32x4*)(co + FF + j0) = (f32x4){v0[0], v0[1], v0[2], v0[3]}; *(f32x4*)(co + FF + j0 + 4) = (f32x4){v0[4], v0[5], v0[6], v0[7]};
            }
#pragma unroll
            for (int e = 0; e < 8; ++e) { g2[e] = g1[e]; g1[e] = g0[e]; v2[e] = v1[e]; v1[e] = v0[e]; }
        }
    }
}
__device__ __forceinline__ void p10_fixup(Frame& F, const bf16* HB, const float* wc, const float* bc, bf16* ACT, float* out) {
    const int gw = F.bid * NWAVES + F.wave, NGW = F.G * NWAVES, lane = F.lane;
    for (int it = (gw >= 1408) ? gw - 1408 : gw + (NGW - 1408); it < 128 * 11; it += NGW) {
        const int blk = it / 11, ci = it % 11, j0 = ci * 512 + lane * 8;
        const bf16* hb = HB + (size_t)blk * 4 * FF2 + j0;
        float g[4][8], v[4][8];
        const bool first = (blk & 31) == 0;
#pragma unroll
        for (int s = 0; s < 2; ++s) {
            if (first) {
#pragma unroll
                for (int e = 0; e < 8; ++e) { g[s][e] = 0.f; v[s][e] = 0.f; }
            } else { unpack8(*(const GAS v4u*)(hb - (size_t)4 * FF2 + (size_t)s * FF2), g[s]); unpack8(*(const GAS v4u*)(hb - (size_t)4 * FF2 + (size_t)s * FF2 + FF), v[s]); }
            unpack8(*(const GAS v4u*)(hb + (size_t)(2 + s) * FF2), g[2 + s]); unpack8(*(const GAS v4u*)(hb + (size_t)(2 + s) * FF2 + FF), v[2 + s]);
        }
        float a0[8], a1[8];
        float wgt[8][8];
#pragma unroll
        for (int q = 0; q < 8; ++q) { const float* src = (q & 3) == 3 ? bc + (q >> 2) * FF + j0 : wc + (size_t)(q & 3) * FF2 + (q >> 2) * FF + j0;
            const f32x4 lo = *(const GAS f32x4*)src, hi = *(const GAS f32x4*)(src + 4);
            wgt[q][0] = lo.x; wgt[q][1] = lo.y; wgt[q][2] = lo.z; wgt[q][3] = lo.w; wgt[q][4] = hi.x; wgt[q][5] = hi.y; wgt[q][6] = hi.z; wgt[q][7] = hi.w; }
#pragma unroll
        for (int e = 0; e < 8; ++e) {
            const float w0g = wgt[0][e], w1g = wgt[1][e], w2g = wgt[2][e], bgv = wgt[3][e];
            const float w0v = wgt[4][e], w1v = wgt[5][e], w2v = wgt[6][e], bvv = wgt[7][e];
            a0[e] = silu_f(bgv + w0g * g[0][e] + w1g * g[1][e] + w2g * g[2][e]) * (bvv + w0v * v[0][e] + w1v * v[1][e] + w2v * v[2][e]);
            a1[e] = silu_f(bgv + w0g * g[1][e] + w1g * g[2][e] + w2g * g[3][e]) * (bvv + w0v * v[1][e] + w1v * v[2][e] + w2v * v[3][e]);
        }
        *(GAS v4u*)(ACT + (size_t)(blk * 64) * FF + j0) = pack8(a0);
        *(GAS v4u*)(ACT + (size_t)(blk * 64 + 1) * FF + j0) = pack8(a1);
        if ((blk & 31) == 31) {
            float* co = out + O_FCP + (size_t)((blk >> 5) * 2) * FF2;
#pragma unroll
            for (int s = 0; s < 2; ++s) { float x[8], y[8]; unpack8(*(const GAS v4u*)(hb + (size_t)s * FF2), x); unpack8(*(const GAS v4u*)(hb + (size_t)s * FF2 + FF), y);
                *(f32x4*)(co + (size_t)s * FF2 + j0) = (f32x4){x[0], x[1], x[2], x[3]}; *(f32x4*)(co + (size_t)s * FF2 + j0 + 4) = (f32x4){x[4], x[5], x[6], x[7]};
                *(f32x4*)(co + (size_t)s * FF2 + FF + j0) = (f32x4){y[0], y[1], y[2], y[3]}; *(f32x4*)(co + (size_t)s * FF2 + FF + j0 + 4) = (f32x4){y[4], y[5], y[6], y[7]}; }
        }
    }
}
__device__ __forceinline__ void final_norm_row(const float* xrow, const float* g, float* orow, int lane) {
    const GAS f32x4* xr = (const GAS f32x4*)xrow + lane;
    f32x4 v[8], gg[8]; float s = 0.f;
#pragma unroll
    for (int j = 0; j < 8; ++j) v[j] = xr[64 * j];
#pragma unroll
    for (int j = 0; j < 8; ++j) gg[j] = *(const GAS f32x4*)(g + 4 * lane + 256 * j);
#pragma unroll
    for (int j = 0; j < 8; ++j) s += (v[j].x * v[j].x + v[j].y * v[j].y) + (v[j].z * v[j].z + v[j].w * v[j].w);
    const float rstd = __builtin_amdgcn_rsqf(wave_sum(s) * (1.0f / DM) + NORM_EPS);
#pragma unroll
    for (int j = 0; j < 8; ++j) ((GAS f32x4*)orow)[lane + 64 * j] = v[j] * rstd * gg[j];
}
__device__ __forceinline__ void final_norm_row_bf(const bf16* xrow, const float* g, float* orow, int lane) {
    const GAS v4u* xr = (const GAS v4u*)xrow + lane;
    v4u t[4]; f32x4 v[8], gg[8]; float s = 0.f;
#pragma unroll
    for (int jj = 0; jj < 4; ++jj) t[jj] = xr[64 * jj];
#pragma unroll
    for (int j = 0; j < 8; ++j) gg[j] = *(const GAS f32x4*)(g + 8 * lane + 512 * (j >> 1) + 4 * (j & 1));
#pragma unroll
    for (int jj = 0; jj < 4; ++jj) { v[2 * jj] = (f32x4){bflo(t[jj].x), bfhi(t[jj].x), bflo(t[jj].y), bfhi(t[jj].y)}; v[2 * jj + 1] = (f32x4){bflo(t[jj].z), bfhi(t[jj].z), bflo(t[jj].w), bfhi(t[jj].w)}; }
#pragma unroll
    for (int j = 0; j < 8; ++j) s += (v[j].x * v[j].x + v[j].y * v[j].y) + (v[j].z * v[j].z + v[j].w * v[j].w);
    const float rstd = __builtin_amdgcn_rsqf(wave_sum(s) * (1.0f / DM) + NORM_EPS);
#pragma unroll
    for (int j = 0; j < 8; ++j) *(GAS f32x4*)(orow + 8 * lane + 512 * (j >> 1) + 4 * (j & 1)) = v[j] * rstd * gg[j];
}
#if defined(MK_SUB)
#define SUB0() do { if (F.tid == 0) ((volatile LAS unsigned long long*)(F.lds + LDSCTL_OFF + 1024))[0] = __builtin_amdgcn_s_memrealtime(); } while (0)
#define SUB(idx) do { if (F.tid == 0) { volatile LAS unsigned long long* tp_ = (volatile LAS unsigned long long*)(F.lds + LDSCTL_OFF + 1024); const unsigned long long now_ = __builtin_amdgcn_s_memrealtime(); \
        const unsigned d_ = (unsigned)(now_ - tp_[0]); tp_[0] = now_; atomicMax((unsigned*)(F.ctl + 20000 + (idx)), d_); atomicAdd((unsigned*)(F.ctl + 20100 + (idx)), d_); } } while (0)
#define SUBL0() do { if (F.tid == 0) ((volatile LAS unsigned long long*)(F.lds + LDSCTL_OFF + 1024))[1] = __builtin_amdgcn_s_memrealtime(); } while (0)
#define SUBL(idx) do { if (F.tid == 0) { volatile LAS unsigned long long* tp_ = (volatile LAS unsigned long long*)(F.lds + LDSCTL_OFF + 1024); const unsigned long long now_ = __builtin_amdgcn_s_memrealtime(); \
        const unsigned d_ = (unsigned)(now_ - tp_[1]); tp_[1] = now_; atomicMax((unsigned*)(F.ctl + 20000 + (idx)), d_); atomicAdd((unsigned*)(F.ctl + 20100 + (idx)), d_); } } while (0)
#define GS_ON(e) do { WG_SYNC(); if (F.tid == 0) *(volatile LAS unsigned*)(F.lds + LDSCTL_OFF + 1096) = (e); WG_SYNC(); } while (0)
#define GS_OFF(e) do { WG_SYNC(); if (F.tid == 0) { *(volatile LAS unsigned*)(F.lds + LDSCTL_OFF + 1096) = 0u; volatile LAS unsigned* a_ = (volatile LAS unsigned*)(F.lds + LDSCTL_OFF + 1104); \
        for (int i_ = 0; i_ < 4; ++i_) atomicAdd((unsigned*)(F.ctl + 20100 + 50 + ((e) - 1) * 4 + i_), a_[((e) - 1) * 4 + i_]); } WG_SYNC(); } while (0)
#else
#define GS_ON(e) do {} while (0)
#define GS_OFF(e) do {} while (0)
#define SUBL0() do {} while (0)
#define SUBL(idx) do {} while (0)
#define SUB0() do {} while (0)
#define SUB(idx) do {} while (0)
#endif
constexpr int GP_QS = 0, GP_KS = 17408, GP_KT = 34816, GP_VT = 53248, GP_QK = 71680, GP_PB = 80896, GP_XA = 90112, GP_XT = 99328, GP_UVT = 108544, GP_WKT = 126976, GP_ARR = 145408;
__device__ __forceinline__ bf16x8 ldsfrag(const LAS bf16* base, int pitch, int row0, int k0, int lane) {
    return *(const LAS bf16x8*)(base + (row0 + (lane & 15)) * pitch + k0 + 8 * (lane >> 4));
}
__device__ __forceinline__ float softplus_f(float x) { return x > 20.f ? x : log1pf(__expf(x)); }
__device__ __forceinline__ void st4bf(LAS bf16* p, float a, float b, float c, float d) { *(LAS u32x2v*)p = (u32x2v){pk2(a, b), pk2(c, d)}; }
__device__ __forceinline__ void gst4bf(bf16* p, float a, float b, float c, float d) { *(GAS u32x2v*)p = (u32x2v){pk2(a, b), pk2(c, d)}; }

__device__ __forceinline__ float row16_sum(float v) {
    v += __builtin_bit_cast(float, __builtin_amdgcn_update_dpp(0, __builtin_bit_cast(int, v), 0xB1, 0xf, 0xf, false));
    v += __builtin_bit_cast(float, __builtin_amdgcn_update_dpp(0, __builtin_bit_cast(int, v), 0x4E, 0xf, 0xf, false));
    v += __builtin_bit_cast(float, __builtin_amdgcn_update_dpp(0, __builtin_bit_cast(int, v), 0x141, 0xf, 0xf, false));
    v += __builtin_bit_cast(float, __builtin_amdgcn_update_dpp(0, __builtin_bit_cast(int, v), 0x140, 0xf, 0xf, false));
    return v;
}
struct GdnW { const bf16* Y1; const float* w_gconv; const float* a_log; const float* dt_bias; unsigned char* gch; float* GE; };

__device__ __forceinline__ void gdn_prep_load(const GdnW& W, int ci, int w, int lane, v4u (&xr)[11], f32x4 (&wg)[8]) {
    const int bh = ci >> 5, n = ci & 31, b = bh >> 3, h = bh & 7, r0 = b * TP + n * 64, rb = 8 * w;
    if (lane < 48) {
        const int seg = lane >> 4, cc = (lane & 15) * 8, col = seg * 1024 + h * 128 + cc;
#pragma unroll
        for (int j = 0; j < 11; ++j) xr[j] = (n * 64 + rb - 3 + j >= 0) ? *(const GAS v4u*)(W.Y1 + (size_t)(r0 + rb - 3 + j) * NIN + col) : (v4u){0u, 0u, 0u, 0u};
    } else if (lane < 56) {
        const size_t m = (size_t)(r0 + rb + (lane - 48));
        xr[0] = (v4u){(unsigned)W.Y1[m * NIN + C_A + h], (unsigned)W.Y1[m * NIN + C_B + h], __float_as_uint(W.a_log[h]), __float_as_uint(W.dt_bias[h])};
    }
}
__device__ __forceinline__ void gdn_chunk_prep(Frame& F, const GdnW& W, int ci, int ci_next, v4u (&xr)[11], f32x4 (&wgv)[8]) {
    int tid = F.tid; asm volatile("" : "+v"(tid));
    const int lane = tid & 63, w = __builtin_amdgcn_readfirstlane(tid >> 6), g4 = lane >> 4, l15 = lane & 15;
    const int bh = ci >> 5, n = ci & 31, b = bh >> 3, h = bh & 7;
    const int r0 = b * TP + n * 64;
    LAS bf16* Qs = (LAS bf16*)(F.lds + GP_QS); LAS bf16* Ks = (LAS bf16*)(F.lds + GP_KS); LAS bf16* Kt = (LAS bf16*)(F.lds + GP_KT); LAS bf16* Vt = (LAS bf16*)(F.lds + GP_VT);
    LAS bf16* QKs = (LAS bf16*)(F.lds + GP_QK); LAS bf16* Pb = (LAS bf16*)(F.lds + GP_PB); LAS bf16* Xa = (LAS bf16*)(F.lds + GP_XA); LAS bf16* Xt = (LAS bf16*)(F.lds + GP_XT);
    LAS bf16* UvT = (LAS bf16*)(F.lds + GP_UVT); LAS bf16* WkT = (LAS bf16*)(F.lds + GP_WKT);
    LAS float* garr = (LAS float*)(F.lds + GP_ARR); LAS float* barr = garr + 64; LAS float* gcs = garr + 128; LAS float* eg = garr + 192; LAS float* ek = garr + 256; LAS float* rqa = garr + 320; LAS float* rka = garr + 384;
    WG_SYNC();
    {
        const int rb = 8 * w;
        if (lane < 48) {
            const int seg = lane >> 4, cc = (lane & 15) * 8, col = seg * 1024 + h * 128 + cc;
            float wg[4][8];
#pragma unroll
            for (int i = 0; i < 4; ++i) { wgv[2 * i] = *(const GAS f32x4*)(W.w_gconv + i * 3072 + col); wgv[2 * i + 1] = *(const GAS f32x4*)(W.w_gconv + i * 3072 + col + 4); }
#pragma unroll
            for (int i = 0; i < 4; ++i) { wg[i][0] = wgv[2 * i].x; wg[i][1] = wgv[2 * i].y; wg[i][2] = wgv[2 * i].z; wg[i][3] = wgv[2 * i].w; wg[i][4] = wgv[2 * i + 1].x; wg[i][5] = wgv[2 * i + 1].y; wg[i][6] = wgv[2 * i + 1].z; wg[i][7] = wgv[2 * i + 1].w; }
            float y[8][8];
#pragma unroll
            for (int r = 0; r < 8; ++r) {
                float ss = 0.f;
#pragma unroll
                for (int e = 0; e < 8; ++e) y[r][e] = 0.f;
#pragma unroll
                for (int i = 0; i < 4; ++i) { float x[8]; unpack8(xr[r + i], x);
#pragma unroll
                    for (int e = 0; e < 8; ++e) y[r][e] += wg[i][e] * x[e]; }
#pragma unroll
                for (int e = 0; e < 8; ++e) { y[r][e] = silu_f(y[r][e]); ss += y[r][e] * y[r][e]; }
                ss = row16_sum(ss);
                if (seg < 2 && (lane & 15) == 0) { const float scl = __builtin_amdgcn_rsqf(ss + NORM_EPS) * (seg == 0 ? 0.08838834764831845f : 1.0f); if (seg == 0) rqa[rb + r] = scl; else rka[rb + r] = scl; }
                if (seg == 0) *(LAS v4u*)(Qs + (rb + r) * 136 + cc) = pack8(y[r]);
                else if (seg == 1) *(LAS v4u*)(Ks + (rb + r) * 136 + cc) = pack8(y[r]);
            }
            if (seg >= 1) { LAS bf16* T = (seg == 1) ? Kt : Vt;
#pragma unroll
                for (int e = 0; e < 8; ++e) *(LAS v4u*)(T + (cc + e) * 72 + rb) = (v4u){pk2(y[0][e], y[1][e]), pk2(y[2][e], y[3][e]), pk2(y[4][e], y[5][e]), pk2(y[6][e], y[7][e])}; }
        } else if (lane < 56) {
            const int r = rb + (lane - 48);
            const float ar = bf2f((unsigned short)xr[0].x), br = bf2f((unsigned short)xr[0].y);
            garr[r] = -__expf(__uint_as_float(xr[0].z)) * softplus_f(ar + __uint_as_float(xr[0].w));
            barr[r] = sigm_f(br);
        }
    }
    if (ci_next < 1024) gdn_prep_load(W, ci_next, w, lane, xr, wgv);
    WG_SYNC();
    if (w == 0) {
        float g = garr[lane];
#pragma unroll
        for (int off = 1; off < 64; off <<= 1) { const float t = __shfl_up(g, off); if (lane >= off) g += t; }
        const float gl = __shfl(g, 63);
        gcs[lane] = g; eg[lane] = __expf(g); ek[lane] = __expf(gl - g);
        if (lane == 63) W.GE[ci] = __expf(g);
    }
    WG_SYNC();
    const int mtC = w >> 1, ntC = 2 * (w & 1);
    f32x4 pacc[2];
    {
        f32x4 akk[2], aqk[2];
#pragma unroll
        for (int i = 0; i < 2; ++i) { akk[i] = (f32x4){0.f, 0.f, 0.f, 0.f}; aqk[i] = akk[i]; }
        { bf16x8 aK[4], aQ[4], bK[2][4];
#pragma unroll
          for (int ks = 0; ks < 4; ++ks) { aK[ks] = ldsfrag(Ks, 136, 16 * mtC, 32 * ks, lane); aQ[ks] = ldsfrag(Qs, 136, 16 * mtC, 32 * ks, lane); bK[0][ks] = ldsfrag(Ks, 136, 16 * ntC, 32 * ks, lane); bK[1][ks] = ldsfrag(Ks, 136, 16 * (ntC + 1), 32 * ks, lane); }
          __builtin_amdgcn_sched_barrier(0);
#pragma unroll
          for (int ks = 0; ks < 4; ++ks)
#pragma unroll
              for (int i = 0; i < 2; ++i) { akk[i] = mfma16(aK[ks], bK[i][ks], akk[i]); aqk[i] = mfma16(aQ[ks], bK[i][ks], aqk[i]); } }
#pragma unroll
        for (int i = 0; i < 2; ++i) {
            const int j = 16 * (ntC + i) + l15; const float gj = gcs[j], rkj = rka[j];
            float av[4], qv[4];
#pragma unroll
            for (int r = 0; r < 4; ++r) {
                const int c = 16 * mtC + 4 * g4 + r;
                const float dec = (j <= c) ? __expf(gcs[c] - gj) : 0.f;
                av[r] = (j < c) ? barr[c] * akk[i][r] * (rka[c] * rkj) * dec : 0.f; qv[r] = aqk[i][r] * (rqa[c] * rkj) * dec;
                pacc[i][r] = ((c == j) ? 1.0f : 0.f) - av[r];
                Pb[c * 72 + j] = (bf16)f2bf(pacc[i][r]); Xa[c * 72 + j] = (bf16)f2bf(av[r]); QKs[c * 72 + j] = (bf16)f2bf(qv[r]);
            }
            st4bf(Xt + j * 72 + 16 * mtC + 4 * g4, av[0], av[1], av[2], av[3]);
        }
    }
    WG_SYNC();
    {
        f32x4 xacc[2];
        { bf16x8 fa[2], fb[2][2];
#pragma unroll
          for (int ks = 0; ks < 2; ++ks) { fa[ks] = ldsfrag(Xa, 72, 16 * mtC, 32 * ks, lane); fb[0][ks] = ldsfrag(Xt, 72, 16 * ntC, 32 * ks, lane); fb[1][ks] = ldsfrag(Xt, 72, 16 * (ntC + 1), 32 * ks, lane); }
          __builtin_amdgcn_sched_barrier(0);
#pragma unroll
          for (int i = 0; i < 2; ++i) { xacc[i] = (f32x4){0.f, 0.f, 0.f, 0.f};
#pragma unroll
              for (int ks = 0; ks < 2; ++ks) xacc[i] = mfma16(fa[ks], fb[i][ks], xacc[i]); } }
        WG_SYNC();
#pragma unroll
        for (int i = 0; i < 2; ++i) { const int j = 16 * (ntC + i) + l15;
#pragma unroll
            for (int r = 0; r < 4; ++r) Xa[(16 * mtC + 4 * g4 + r) * 72 + j] = (bf16)f2bf(xacc[i][r]);
            st4bf(Xt + j * 72 + 16 * mtC + 4 * g4, xacc[i][0], xacc[i][1], xacc[i][2], xacc[i][3]); }
        WG_SYNC();
#pragma unroll 1
        for (int it = 1; it <= 5; ++it) {
            { bf16x8 fp[2], fa[2], fb[2][2];
#pragma unroll
              for (int ks = 0; ks < 2; ++ks) { fp[ks] = ldsfrag(Pb, 72, 16 * mtC, 32 * ks, lane); fa[ks] = ldsfrag(Xa, 72, 16 * mtC, 32 * ks, lane); fb[0][ks] = ldsfrag(Xt, 72, 16 * ntC, 32 * ks, lane); fb[1][ks] = ldsfrag(Xt, 72, 16 * (ntC + 1), 32 * ks, lane); }
              __builtin_amdgcn_sched_barrier(0);
#pragma unroll
              for (int i = 0; i < 2; ++i) { xacc[i] = (f32x4){0.f, 0.f, 0.f, 0.f};
#pragma unroll
                  for (int ks = 0; ks < 2; ++ks) { pacc[i] = mfma16(fp[ks], fb[i][ks], pacc[i]); xacc[i] = mfma16(fa[ks], fb[i][ks], xacc[i]); } } }
            WG_SYNC();
#pragma unroll
            for (int i = 0; i < 2; ++i) { const int j = 16 * (ntC + i) + l15;
#pragma unroll
                for (int r = 0; r < 4; ++r) { const int c = 16 * mtC + 4 * g4 + r; Pb[c * 72 + j] = (bf16)f2bf(pacc[i][r]); Xa[c * 72 + j] = (bf16)f2bf(xacc[i][r]); }
                st4bf(Xt + j * 72 + 16 * mtC + 4 * g4, xacc[i][0], xacc[i][1], xacc[i][2], xacc[i][3]); }
            WG_SYNC();
        }
#pragma unroll
        for (int i = 0; i < 2; ++i) { const int j = 16 * (ntC + i) + l15; const float bj = barr[j], bg = bj * eg[j] * rka[j];
#pragma unroll
            for (int r = 0; r < 4; ++r) { const int c = 16 * mtC + 4 * g4 + r; Xa[c * 72 + j] = (bf16)f2bf(pacc[i][r] * bj); Xt[c * 72 + j] = (bf16)f2bf(pacc[i][r] * bg); } }
    }
    WG_SYNC();
    { bf16x8 fv[2], fk[2];
#pragma unroll
      for (int ks = 0; ks < 2; ++ks) { fv[ks] = ldsfrag(Vt, 72, 16 * w, 32 * ks, lane); fk[ks] = ldsfrag(Kt, 72, 16 * w, 32 * ks, lane); }
#pragma unroll
      for (int mp = 0; mp < 2; ++mp) {
          bf16x8 fa[2][2], ft[2][2];
#pragma unroll
          for (int m2 = 0; m2 < 2; ++m2)
#pragma unroll
              for (int ks = 0; ks < 2; ++ks) { fa[m2][ks] = ldsfrag(Xa, 72, 16 * (2 * mp + m2), 32 * ks, lane); ft[m2][ks] = ldsfrag(Xt, 72, 16 * (2 * mp + m2), 32 * ks, lane); }
          __builtin_amdgcn_sched_barrier(0);
#pragma unroll
          for (int m2 = 0; m2 < 2; ++m2) { const int mt = 2 * mp + m2;
              f32x4 au = (f32x4){0.f, 0.f, 0.f, 0.f}, aw = au;
#pragma unroll
              for (int ks = 0; ks < 2; ++ks) { au = mfma16(fa[m2][ks], fv[ks], au); aw = mfma16(ft[m2][ks], fk[ks], aw); }
              st4bf(UvT + (16 * w + l15) * 72 + 16 * mt + 4 * g4, au[0], au[1], au[2], au[3]);
              st4bf(WkT + (16 * w + l15) * 72 + 16 * mt + 4 * g4, aw[0], aw[1], aw[2], aw[3]); }
      } }
    WG_SYNC();
    {
        const int dk = tid >> 2, c0 = (tid & 3) * 16;
#pragma unroll
        for (int q = 0; q < 2; ++q) {
            LAS v4u* p = (LAS v4u*)(Kt + dk * 72 + c0 + 8 * q); float x[8]; unpack8(*p, x);
#pragma unroll
            for (int e = 0; e < 8; ++e) x[e] *= ek[c0 + 8 * q + e] * rka[c0 + 8 * q + e];
            *p = (v4u){pk2(x[0], x[1]), pk2(x[2], x[3]), pk2(x[4], x[5]), pk2(x[6], x[7])};
        }
    }
    WG_SYNC();
    unsigned char* gb = W.gch + (size_t)ci * GCH_BYTES;
    bf16* MS = (bf16*)(gb + GCH_MS); bf16* BT = (bf16*)(gb + GCH_BT); bf16* QE = (bf16*)(gb + GCH_QE); bf16* OLT = (bf16*)(gb + GCH_OLT);
    {
        bf16x8 fw[2], fkw[2], fu[2];
#pragma unroll
        for (int ks = 0; ks < 2; ++ks) { fw[ks] = ldsfrag(WkT, 72, 16 * w, 32 * ks, lane); fkw[ks] = ldsfrag(Kt, 72, 16 * w, 32 * ks, lane); fu[ks] = ldsfrag(UvT, 72, 16 * w, 32 * ks, lane); }
#pragma unroll
        for (int np = 0; np < 4; ++np) {
            bf16x8 fk[2][2], fv[2][2];
#pragma unroll
            for (int n2 = 0; n2 < 2; ++n2)
#pragma unroll
                for (int ks = 0; ks < 2; ++ks) { fk[n2][ks] = ldsfrag(Kt, 72, 16 * (2 * np + n2), 32 * ks, lane); fv[n2][ks] = ldsfrag(UvT, 72, 16 * (2 * np + n2), 32 * ks, lane); }
            __builtin_amdgcn_sched_barrier(0);
#pragma unroll
            for (int n2 = 0; n2 < 2; ++n2) { const int nt = 2 * np + n2;
                f32x4 am = (f32x4){0.f, 0.f, 0.f, 0.f}, ab = am;
#pragma unroll
                for (int ks = 0; ks < 2; ++ks) { am = mfma16(fw[ks], fk[n2][ks], am); ab = mfma16(fkw[ks], fv[n2][ks], ab); }
                gst4bf(MS + (size_t)(16 * nt + l15) * 128 + 16 * w + 4 * g4, -am[0], -am[1], -am[2], -am[3]);
                gst4bf(BT + (size_t)(16 * nt + l15) * 128 + 16 * w + 4 * g4, ab[0], ab[1], ab[2], ab[3]); }
        }
        {
            bf16x8 fq[4][2];
#pragma unroll
            for (int nt = 0; nt < 4; ++nt)
#pragma unroll
                for (int ks = 0; ks < 2; ++ks) fq[nt][ks] = ldsfrag(QKs, 72, 16 * nt, 32 * ks, lane);
            __builtin_amdgcn_sched_barrier(0);
#pragma unroll
            for (int nt = 0; nt < 4; ++nt) {
                f32x4 aq = (f32x4){0.f, 0.f, 0.f, 0.f}, ao = aq;
#pragma unroll
                for (int ks = 0; ks < 2; ++ks) { aq = mfma16(fw[ks], fq[nt][ks], aq); ao = mfma16(fq[nt][ks], fu[ks], ao); }
                const int c = 16 * nt + l15; const float e = eg[c] * rqa[c];
                const u32x2v qq = *(const LAS u32x2v*)(Qs + c * 136 + 16 * w + 4 * g4);
                gst4bf(QE + (size_t)c * 128 + 16 * w + 4 * g4, e * bflo(qq.x) - aq[0], e * bfhi(qq.x) - aq[1], e * bflo(qq.y) - aq[2], e * bfhi(qq.y) - aq[3]);
                gst4bf(OLT + (size_t)(16 * w + l15) * 64 + 16 * nt + 4 * g4, ao[0], ao[1], ao[2], ao[3]);
            }
        }
    }
}

struct GdnS { const bf16* Y1; const float* w_gconv; const float* a_log; const float* dt_bias; const float* g_gnorm; const float* state_gdn; const float* state_gconv; bf16* OG; float* out; };
__device__ __forceinline__ void gdn_sample_group(Frame& F, const GdnS& W, int it0, int stride) {
    int tid = F.tid; asm volatile("" : "+v"(tid));
    const int lane = tid & 63, w = __builtin_amdgcn_readfirstlane(tid >> 6);
    LAS float* cv = (LAS float*)(F.lds);
    LAS float* gb = cv + 4 * 1536;
    LAS float* sq = gb + 32;
    const int ik = w >> 1, half = w & 1, dv = 64 * half + lane;
    const int item = it0 + ik * stride, db = item >> 3, h = item & 7;
    const size_t mrow = (size_t)NPR + 4 * db;
    WG_SYNC();
#pragma unroll
    for (int j = 0; j < 3; ++j) {
        const int p = tid + 512 * j, ii = p / 384, c = p - 384 * ii;
        const int it2 = it0 + ii * stride, db2 = it2 >> 3, h2 = it2 & 7, col = (c >> 7) * 1024 + h2 * 128 + (c & 127);
        const size_t mr2 = (size_t)NPR + 4 * db2;
        float xx[7], wq[4];
#pragma unroll
        for (int i = 0; i < 3; ++i) xx[i] = W.state_gconv[(size_t)(db2 * 3 + i) * 3072 + col];
#pragma unroll
        for (int i = 0; i < 4; ++i) xx[3 + i] = bf2f(W.Y1[(mr2 + i) * NIN + col]);
#pragma unroll
        for (int i = 0; i < 4; ++i) wq[i] = W.w_gconv[i * 3072 + col];
#pragma unroll
        for (int ts = 0; ts < 4; ++ts) cv[(ii * 4 + ts) * 384 + c] = silu_f(wq[0] * xx[ts] + wq[1] * xx[ts + 1] + wq[2] * xx[ts + 2] + wq[3] * xx[ts + 3]);
    }
    if (tid < 16) {
        const int ii = tid >> 2, ts = tid & 3, it2 = it0 + ii * stride, db2 = it2 >> 3, h2 = it2 & 7; const size_t m2 = (size_t)NPR + 4 * db2 + ts;
        const float ar = bf2f(W.Y1[m2 * NIN + C_A + h2]), br = bf2f(W.Y1[m2 * NIN + C_B + h2]);
        gb[ii * 8 + ts] = -__expf(W.a_log[h2]) * softplus_f(ar + W.dt_bias[h2]); gb[ii * 8 + 4 + ts] = sigm_f(br);
    }
    const float* Sg = W.state_gdn + ((size_t)(db * 8 + h) * 128) * 128 + dv;
    float S[128];
#pragma unroll
    for (int r = 0; r < 128; ++r) S[r] = Sg[(size_t)r * 128];
    float zz[4]; const float gn = W.g_gnorm[dv];
#pragma unroll
    for (int ts = 0; ts < 4; ++ts) zz[ts] = bf2f(W.Y1[(mrow + ts) * NIN + C_Z + h * 128 + dv]);
    WG_SYNC();
#pragma unroll
    for (int jj = 0; jj < 4; ++jj) {
        const int job = 4 * w + jj, ii = job >> 3, ts = (job >> 1) & 3, sg = job & 1;
        LAS float* p = cv + (ii * 4 + ts) * 384 + sg * 128;
        const float a = p[lane], b2 = p[lane + 64];
        const float scl = (1.0f / sqrtf(wave_sum(a * a + b2 * b2) + NORM_EPS)) * (sg == 0 ? 0.08838834764831845f : 1.0f);
        p[lane] = a * scl; p[lane + 64] = b2 * scl;
    }
    WG_SYNC();
    float ot[4];
#pragma unroll
    for (int ts = 0; ts < 4; ++ts) {
        const LAS float* q = cv + (ik * 4 + ts) * 384; const LAS float* k = q + 128;
        const float al = __expf(gb[ik * 8 + ts]), be = gb[ik * 8 + 4 + ts], vv = q[256 + dv];
        float kS = 0.f;
#pragma unroll
        for (int rb = 0; rb < 4; ++rb) {
            f32x4 kk[8];
#pragma unroll
            for (int r4 = 0; r4 < 8; ++r4) kk[r4] = *(const LAS f32x4*)(k + 32 * rb + 4 * r4);
#pragma unroll
            for (int r4 = 0; r4 < 8; ++r4) { const int r = 32 * rb + 4 * r4; kS += S[r] * kk[r4].x + S[r + 1] * kk[r4].y + S[r + 2] * kk[r4].z + S[r + 3] * kk[r4].w; }
            __builtin_amdgcn_sched_barrier(0);
        }
        const float dl = (vv - kS * al) * be;
        float o = 0.f;
#pragma unroll
        for (int rb = 0; rb < 8; ++rb) {
            f32x4 kk[4], qq[4];
#pragma unroll
            for (int r4 = 0; r4 < 4; ++r4) { kk[r4] = *(const LAS f32x4*)(k + 16 * rb + 4 * r4); qq[r4] = *(const LAS f32x4*)(q + 16 * rb + 4 * r4); }
#pragma unroll
            for (int r4 = 0; r4 < 4; ++r4) { const int r = 16 * rb + 4 * r4;
                S[r] = S[r] * al + dl * kk[r4].x; S[r + 1] = S[r + 1] * al + dl * kk[r4].y; S[r + 2] = S[r + 2] * al + dl * kk[r4].z; S[r + 3] = S[r + 3] * al + dl * kk[r4].w;
                o += S[r] * qq[r4].x + S[r + 1] * qq[r4].y + S[r + 2] * qq[r4].z + S[r + 3] * qq[r4].w; }
            __builtin_amdgcn_sched_barrier(0);
        }
        ot[ts] = o;
        const float s2 = wave_sum(o * o);
        if (lane == 0) sq[(ik * 4 + ts) * 2 + half] = s2;
    }
    float* So = W.out + O_GSS + ((size_t)(db * 8 + h) * 128) * 128 + dv;
#pragma unroll
    for (int r = 0; r < 128; ++r) So[(size_t)r * 128] = S[r];
    WG_SYNC();
#pragma unroll
    for (int ts = 0; ts < 4; ++ts) {
        const float rstd = 1.0f / sqrtf((sq[(ik * 4 + ts) * 2] + sq[(ik * 4 + ts) * 2 + 1]) * (1.0f / 128.0f) + NORM_EPS);
        W.OG[(mrow + ts) * 2048 + h * 128 + dv] = (bf16)f2bf(ot[ts] * rstd * gn * silu_f(zz[ts]));
    }
}
struct GdnSPre { float xx[7]; float wq[4]; f32x4 S[8]; };
__device__ __forceinline__ void gdn_sample_load(const GdnS& W, int item, int tid, GdnSPre& P) {
    asm volatile("" : "+v"(tid));
    const int lane = tid & 63, w = __builtin_amdgcn_readfirstlane(tid >> 6);
    const int db = item >> 3, h = item & 7;
    const size_t mrow = (size_t)NPR + 4 * db;
#pragma unroll
    for (int i = 0; i < 7; ++i) P.xx[i] = 0.f;
#pragma unroll
    for (int i = 0; i < 4; ++i) P.wq[i] = 0.f;
    if (tid < 384) {
        const int seg = tid >> 7, col = seg * 1024 + h * 128 + (tid & 127);
#pragma unroll
        for (int i = 0; i < 3; ++i) P.xx[i] = W.state_gconv[(size_t)(db * 3 + i) * 3072 + col];
#pragma unroll
        for (int i = 0; i < 4; ++i) P.xx[3 + i] = bf2f(W.Y1[(mrow + i) * NIN + col]);
#pragma unroll
        for (int i = 0; i < 4; ++i) P.wq[i] = W.w_gconv[i * 3072 + col];
    } else if (tid < 388) {
        const int ts = tid - 384;
        P.xx[0] = bf2f(W.Y1[(mrow + ts) * NIN + C_A + h]); P.xx[1] = bf2f(W.Y1[(mrow + ts) * NIN + C_B + h]);
        P.wq[0] = W.a_log[h]; P.wq[1] = W.dt_bias[h];
    }
    const float* Sg = W.state_gdn + ((size_t)(db * 8 + h) * 128) * 128;
#pragma unroll
    for (int i = 0; i < 8; ++i) P.S[i] = *(const f32x4*)(Sg + (size_t)(16 * w + 2 * i + (lane >> 5)) * 128 + 4 * (lane & 31));
}
__device__ __forceinline__ void gdn_sample_item(Frame& F, const GdnS& W, int item, int nxt, GdnSPre& P) {
    int tid = F.tid; asm volatile("" : "+v"(tid));
    const int lane = tid & 63, w = __builtin_amdgcn_readfirstlane(tid >> 6);
    const int db = item >> 3, h = item & 7;
    LAS float* cv = (LAS float*)(F.lds);
    LAS float* gb = cv + 1536;
    LAS float* part = gb + 8;
    LAS float* opart = part + 2048;
    WG_SYNC();
    const size_t mrow = (size_t)NPR + 4 * db;
    if (tid < 384) {
#pragma unroll
        for (int ts = 0; ts < 4; ++ts) cv[ts * 384 + tid] = silu_f(P.wq[0] * P.xx[ts] + P.wq[1] * P.xx[ts + 1] + P.wq[2] * P.xx[ts + 2] + P.wq[3] * P.xx[ts + 3]);
    } else if (tid < 388) {
        const int ts = tid - 384;
        gb[ts] = -__expf(P.wq[0]) * softplus_f(P.xx[0] + P.wq[1]); gb[4 + ts] = sigm_f(P.xx[1]);
    }
    f32x4 S[8];
#pragma unroll
    for (int i = 0; i < 8; ++i) S[i] = P.S[i];
    float z0 = 0.f, z1 = 0.f, gn0 = 0.f, gn1 = 0.f;
    if (w < 4) {
        const bf16* zr = W.Y1 + (mrow + w) * NIN + C_Z + h * 128;
        z0 = bf2f(zr[lane]); z1 = bf2f(zr[lane + 64]); gn0 = W.g_gnorm[lane]; gn1 = W.g_gnorm[lane + 64];
    }
    if (nxt < 1024) gdn_sample_load(W, nxt, tid, P);
    WG_SYNC();
    {
        const int ts = w >> 1, sg = w & 1;
        LAS float* p = cv + ts * 384 + sg * 128;
        const float a = p[lane], b2 = p[lane + 64];
        const float scl = (1.0f / sqrtf(wave_sum(a * a + b2 * b2) + NORM_EPS)) * (sg == 0 ? 0.08838834764831845f : 1.0f);
        p[lane] = a * scl; p[lane + 64] = b2 * scl;
    }
    WG_SYNC();
#pragma unroll 1
    for (int ts = 0; ts < 4; ++ts) {
        const LAS float* q = cv + ts * 384; const LAS float* k = q + 128; const LAS float* v = q + 256;
        const float al = __expf(gb[ts]), be = gb[4 + ts];
        float kr[8];
        f32x4 p = (f32x4){0.f, 0.f, 0.f, 0.f};
#pragma unroll
        for (int i = 0; i < 8; ++i) { kr[i] = k[16 * w + 2 * i + (lane >> 5)]; p += S[i] * kr[i]; }
        p.x = xh_sum(p.x); p.y = xh_sum(p.y); p.z = xh_sum(p.z); p.w = xh_sum(p.w);
        LAS float* pp = part + (ts & 1) * 1024;
        if (lane < 32) *(LAS f32x4*)(pp + w * 128 + 4 * lane) = p;
        WG_SYNC();
        f32x4 ks = (f32x4){0.f, 0.f, 0.f, 0.f};
#pragma unroll
        for (int ww = 0; ww < 8; ++ww) ks += *(const LAS f32x4*)(pp + ww * 128 + 4 * (lane & 31));
        const f32x4 vv = *(const LAS f32x4*)(v + 4 * (lane & 31));
        const f32x4 dlt = (vv - ks * al) * be;
        f32x4 po = (f32x4){0.f, 0.f, 0.f, 0.f};
#pragma unroll
        for (int i = 0; i < 8; ++i) { S[i] = S[i] * al + dlt * kr[i]; po += S[i] * q[16 * w + 2 * i + (lane >> 5)]; }
        po.x = xh_sum(po.x); po.y = xh_sum(po.y); po.z = xh_sum(po.z); po.w = xh_sum(po.w);
        if (lane < 32) *(LAS f32x4*)(opart + (ts * 8 + w) * 128 + 4 * lane) = po;
    }
    float* So = W.out + O_GSS + ((size_t)(db * 8 + h) * 128) * 128;
#pragma unroll
    for (int i = 0; i < 8; ++i) *(f32x4*)(So + (size_t)(16 * w + 2 * i + (lane >> 5)) * 128 + 4 * (lane & 31)) = S[i];
    WG_SYNC();
    if (w < 4) {
        float o0 = 0.f, o1 = 0.f;
#pragma unroll
        for (int ww = 0; ww < 8; ++ww) { o0 += opart[(w * 8 + ww) * 128 + lane]; o1 += opart[(w * 8 + ww) * 128 + 64 + lane]; }
        const float rstd = 1.0f / sqrtf(wave_sum(o0 * o0 + o1 * o1) * (1.0f / 128.0f) + NORM_EPS);
        bf16* og = W.OG + (mrow + w) * 2048 + h * 128;
        og[lane] = (bf16)f2bf(o0 * rstd * gn0 * silu_f(z0));
        og[lane + 64] = (bf16)f2bf(o1 * rstd * gn1 * silu_f(z1));
    }
}

constexpr int GS_BUF = 34816;
struct GdnP { const unsigned char* gch; const float* GE; bf16* SN; float* out; };
__device__ __forceinline__ bf16x8 permfrag(const LAS bf16* rowp, int k0, int g4) {
    const u32x2v a = *(const LAS u32x2v*)(rowp + k0 + 4 * g4), b = *(const LAS u32x2v*)(rowp + k0 + 16 + 4 * g4);
    return __builtin_bit_cast(bf16x8, (v4u){a.x, a.y, b.x, b.y});
}
__device__ __forceinline__ void gdn_scan_item(Frame& F, const GdnP& W, int bh) {
    int tid = F.tid; asm volatile("" : "+v"(tid));
    const int lane = tid & 63, w = __builtin_amdgcn_readfirstlane(tid >> 6), g4 = lane >> 4, l15 = lane & 15;
    const unsigned char* gb0 = W.gch + (size_t)(bh * 32) * GCH_BYTES;
    f32x4 S[8];
#pragma unroll
    for (int mt = 0; mt < 8; ++mt) S[mt] = (f32x4){0.f, 0.f, 0.f, 0.f};
    const float gev = W.GE[bh * 32 + (lane & 31)];
    WG_SYNC();
    v4u stA[4], stB[4]; u32x2v btA[8], btB[8];
#define GS_LD_MS(set_, n_) do { const unsigned char* g_ = gb0 + (size_t)((n_) < 32 ? (n_) : 31) * GCH_BYTES + GCH_MS + (unsigned)tid * 16u; \
        _Pragma("unroll") for (int i = 0; i < 4; ++i) set_[i] = *(const GAS v4u*)(g_ + (size_t)i * 8192); } while (0)
#define GS_ST_MS(set_, buf_) do { _Pragma("unroll") for (int i = 0; i < 4; ++i) { const int idx = tid + 512 * i, row = idx >> 4, cchunk = idx & 15; *(LAS v4u*)(F.lds + (buf_) * GS_BUF + row * 272 + cchunk * 16) = set_[i]; } } while (0)
#define GS_LD_BT(set_, n_) do { const bf16* b_ = (const bf16*)(gb0 + (size_t)((n_) < 32 ? (n_) : 31) * GCH_BYTES + GCH_BT) + (size_t)(16 * w + l15) * 128 + 4 * g4; \
        _Pragma("unroll") for (int mt = 0; mt < 8; ++mt) set_[mt] = *(const GAS u32x2v*)(b_ + 16 * mt); } while (0)
#define GS_STEP(n_, bt_) do { const int n = (n_); \
        const LAS bf16* MSl = (const LAS bf16*)(F.lds + (n & 1) * GS_BUF); \
        const float ge = __builtin_bit_cast(float, __builtin_amdgcn_readlane(__builtin_bit_cast(int, gev), n)); \
        bf16x8 Sb[4]; \
        { bf16* sn = W.SN + ((size_t)(bh * 32 + n) * 128 + 16 * w + l15) * 128 + 4 * g4; \
          _Pragma("unroll") for (int ks = 0; ks < 4; ++ks) { \
              const u32x2v lo = (u32x2v){pk2(S[2 * ks][0], S[2 * ks][1]), pk2(S[2 * ks][2], S[2 * ks][3])}, hi = (u32x2v){pk2(S[2 * ks + 1][0], S[2 * ks + 1][1]), pk2(S[2 * ks + 1][2], S[2 * ks + 1][3])}; \
              Sb[ks] = __builtin_bit_cast(bf16x8, (v4u){lo.x, lo.y, hi.x, hi.y}); \
              *(GAS u32x2v*)(sn + 32 * ks) = lo; *(GAS u32x2v*)(sn + 32 * ks + 16) = hi; } } \
        _Pragma("unroll") for (int mp = 0; mp < 4; ++mp) { \
            bf16x8 fr[8]; \
            _Pragma("unroll") for (int m2 = 0; m2 < 2; ++m2) _Pragma("unroll") for (int ks = 0; ks < 4; ++ks) fr[m2 * 4 + ks] = permfrag(MSl + (16 * (2 * mp + m2) + l15) * 136, 32 * ks, g4); \
            __builtin_amdgcn_sched_barrier(0); \
            f32x4 acc[2]; \
            _Pragma("unroll") for (int m2 = 0; m2 < 2; ++m2) { const u32x2v bv = bt_[2 * mp + m2]; acc[m2] = S[2 * mp + m2] * ge + (f32x4){bflo(bv.x), bfhi(bv.x), bflo(bv.y), bfhi(bv.y)}; } \
            _Pragma("unroll") for (int ks = 0; ks < 4; ++ks) _Pragma("unroll") for (int m2 = 0; m2 < 2; ++m2) acc[m2] = mfma16(fr[m2 * 4 + ks], Sb[ks], acc[m2]); \
            S[2 * mp] = acc[0]; S[2 * mp + 1] = acc[1]; } \
        asm volatile("" ::: "memory"); } while (0)
    GS_LD_MS(stA, 0); GS_LD_MS(stB, 1); GS_LD_BT(btA, 0); GS_LD_BT(btB, 1);
    GS_ST_MS(stA, 0);
    WG_SYNC();
#pragma unroll 1
    for (int n2 = 0; n2 < 32; n2 += 2) {
        GS_LD_MS(stA, n2 + 2);
        GS_STEP(n2, btA);
        GS_LD_BT(btA, n2 + 2);
        GS_ST_MS(stB, 1);
        WG_SYNC();
        GS_LD_MS(stB, n2 + 3);
        GS_STEP(n2 + 1, btB);
        GS_LD_BT(btB, n2 + 3);
        GS_ST_MS(stA, 0);
        WG_SYNC();
    }
#undef GS_LD_MS
#undef GS_ST_MS
#undef GS_LD_BT
#undef GS_STEP
    float* So = W.out + O_GSP + (size_t)bh * 128 * 128;
#pragma unroll
    for (int mt = 0; mt < 8; ++mt)
#pragma unroll
        for (int r = 0; r < 4; ++r) So[(size_t)(16 * mt + 4 * g4 + r) * 128 + 16 * w + l15] = S[mt][r];
    WG_SYNC();
}
struct GdnO { const bf16* Y1; const float* g_gnorm; const unsigned char* gch; const bf16* SN; bf16* OG; unsigned char* dbg; };
struct GdnOPre { v4u qe[2], zq[2]; bf16x8 fb[4]; u32x2v olv[4]; };
__device__ __forceinline__ void gdn_out_load(const GdnO& W, int ci, int tid, GdnOPre& P) {
    const int lane = tid & 63, w = __builtin_amdgcn_readfirstlane(tid >> 6), g4 = lane >> 4, l15 = lane & 15, bh = ci >> 5, n = ci & 31, b = bh >> 3, h = bh & 7;
    const int row = tid >> 3, cc = (tid & 7) * 16;
    const unsigned char* gb = W.gch + (size_t)ci * GCH_BYTES;
    const bf16* QEg = (const bf16*)(gb + GCH_QE) + (size_t)row * 128 + cc;
    P.qe[0] = *(const GAS v4u*)QEg; P.qe[1] = *(const GAS v4u*)(QEg + 8);
    const bf16* zg = W.Y1 + (size_t)(b * TP + n * 64 + row) * NIN + C_Z + h * 128 + cc;
    P.zq[0] = *(const GAS v4u*)zg; P.zq[1] = *(const GAS v4u*)(zg + 8);
    const bf16* sn = W.SN + ((size_t)ci * 128 + 16 * w + l15) * 128 + 8 * g4;
#pragma unroll
    for (int ks = 0; ks < 4; ++ks) P.fb[ks] = *(const GAS bf16x8*)(sn + 32 * ks);
    const bf16* OLg = (const bf16*)(gb + GCH_OLT) + (size_t)(16 * w + l15) * 64 + 4 * g4;
#pragma unroll
    for (int ct = 0; ct < 4; ++ct) P.olv[ct] = *(const GAS u32x2v*)(OLg + 16 * ct);
}
__device__ __forceinline__ void gdn_out_item(Frame& F, const GdnO& W, int ci, int ci_next, GdnOPre& P) {
    int tid = F.tid; asm volatile("" : "+v"(tid));
    const int lane = tid & 63, w = __builtin_amdgcn_readfirstlane(tid >> 6), g4 = lane >> 4, l15 = lane & 15;
    const int bh = ci >> 5, n = ci & 31, b = bh >> 3, h = bh & 7;
    const int row = tid >> 3, cc = (tid & 7) * 16;
    LAS float* part = (LAS float*)F.lds;
    LAS bf16* QEs = (LAS bf16*)(F.lds + 2048);
    LAS bf16* Zs = QEs + 64 * 136;
    LAS bf16* Os = Zs + 64 * 136;
    const float gdv = W.g_gnorm[16 * w + l15];
    *(LAS v4u*)(QEs + row * 136 + cc) = P.qe[0]; *(LAS v4u*)(QEs + row * 136 + cc + 8) = P.qe[1];
    *(LAS v4u*)(Zs + row * 136 + cc) = P.zq[0]; *(LAS v4u*)(Zs + row * 136 + cc + 8) = P.zq[1];
    f32x4 o[4];
#pragma unroll
    for (int ct = 0; ct < 4; ++ct) o[ct] = (f32x4){bflo(P.olv[ct].x), bfhi(P.olv[ct].x), bflo(P.olv[ct].y), bfhi(P.olv[ct].y)};
    bf16x8 fb[4];
#pragma unroll
    for (int ks = 0; ks < 4; ++ks) fb[ks] = P.fb[ks];
    WG_SYNC();
    if (ci_next < 1024) gdn_out_load(W, ci_next, tid, P);
#pragma unroll
    for (int ks = 0; ks < 4; ++ks) {
        bf16x8 fa[4];
#pragma unroll
        for (int ct = 0; ct < 4; ++ct) fa[ct] = *(const LAS bf16x8*)(QEs + (16 * ct + l15) * 136 + 32 * ks + 8 * g4);
#pragma unroll
        for (int ct = 0; ct < 4; ++ct) o[ct] = mfma16(fa[ct], fb[ks], o[ct]);
    }
#pragma unroll
    for (int ct = 0; ct < 4; ++ct) {
#if defined(MK_DIAG)
        { float* dbg = (float*)(W.dbg) + (size_t)(b * TP + n * 64) * 1024 + h * 128 + 16 * w + l15;
          for (int r = 0; r < 4; ++r) dbg[(size_t)(16 * ct + 4 * g4 + r) * 1024] = o[ct][r]; }
#endif
        f32x4 sq = o[ct] * o[ct];
        sq.x = row16_sum(sq.x); sq.y = row16_sum(sq.y); sq.z = row16_sum(sq.z); sq.w = row16_sum(sq.w);
        if (l15 == 0) *(LAS f32x4*)(part + w * 64 + 16 * ct + 4 * g4) = sq;
    }
    WG_SYNC();
#pragma unroll
    for (int ct = 0; ct < 4; ++ct) {
        f32x4 tot = (f32x4){0.f, 0.f, 0.f, 0.f};
#pragma unroll
        for (int ww = 0; ww < 8; ++ww) tot += *(const LAS f32x4*)(part + ww * 64 + 16 * ct + 4 * g4);
#pragma unroll
        for (int r = 0; r < 4; ++r) { const float rstd = __builtin_amdgcn_rsqf(tot[r] * (1.0f / 128.0f) + NORM_EPS);
            const int c = 16 * ct + 4 * g4 + r; const float zf = bf2f(Zs[c * 136 + 16 * w + l15]);
            Os[c * 136 + 16 * w + l15] = (bf16)f2bf(o[ct][r] * rstd * gdv * silu_f(zf)); }
    }
    WG_SYNC();
    { bf16* og = W.OG + (size_t)(b * TP + n * 64 + row) * 2048 + h * 128 + cc;
      const v4u a0 = *(const LAS v4u*)(Os + row * 136 + cc), a1 = *(const LAS v4u*)(Os + row * 136 + cc + 8);
      *(GAS v4u*)og = a0; *(GAS v4u*)(og + 8) = a1; }
}
typedef float f32x16 __attribute__((ext_vector_type(16)));
__device__ __forceinline__ f32x16 mfma32(bf16x8 a, bf16x8 b, f32x16 c) { return __builtin_amdgcn_mfma_f32_32x32x16_bf16(a, b, c, 0, 0, 0); }
__device__ __forceinline__ unsigned sortkey(float x) { const unsigned u = __float_as_uint(x); return u ^ ((u >> 31) ? 0xFFFFFFFFu : 0x80000000u); }
__device__ __forceinline__ unsigned ld_sc1(const unsigned* p) { return __hip_atomic_load(p, __ATOMIC_RELAXED, __HIP_MEMORY_SCOPE_AGENT); }
constexpr int DSA_TOPK = 256;
constexpr int DL_K = 0;
constexpr int DL_V = 34816;
constexpr int DL_SET = 69632;
constexpr int DL_MASK = 139264;
constexpr int DL_END = 147456;
__device__ __forceinline__ int wave_sum_dpp(int v) {
    v += __builtin_amdgcn_update_dpp(0, v, 0xB1, 0xf, 0xf, false);
    v += __builtin_amdgcn_update_dpp(0, v, 0x4E, 0xf, 0xf, false);
    v += __builtin_amdgcn_update_dpp(0, v, 0x141, 0xf, 0xf, false);
    v += __builtin_amdgcn_update_dpp(0, v, 0x140, 0xf, 0xf, false);
    v += __builtin_amdgcn_update_dpp(0, v, 0x142, 0xa, 0xf, false);
    v += __builtin_amdgcn_update_dpp(0, v, 0x143, 0xc, 0xf, false);
    return __builtin_amdgcn_readlane(v, 63);
}
template <int J, unsigned M> __device__ __forceinline__ void bt_stage(unsigned (&a)[32]) {
#pragma unroll
    for (int base = 0; base < 32; base += 2 * J)
#pragma unroll
        for (int o = 0; o < J; ++o) { const int k = base + o; const unsigned t = (a[k] ^ (a[k + J] >> J)) & M; a[k] ^= t; a[k + J] ^= (t << J); }
}
template <bool EXTRA>
__device__ __forceinline__ unsigned topk_bits(const unsigned (&u)[32], unsigned x, bool& xsel, int lane) {
    unsigned P[32]; unsigned A = 0u;
#pragma unroll
    for (int i = 0; i < 32; ++i) { P[i] = u[i]; A |= (u[i] != 0u) ? (0x80000000u >> i) : 0u; }
    bt_stage<16, 0x0000FFFFu>(P); bt_stage<8, 0x00FF00FFu>(P); bt_stage<4, 0x0F0F0F0Fu>(P); bt_stage<2, 0x33333333u>(P); bt_stage<1, 0x55555555u>(P);
    unsigned G = 0u; int above = 0; bool xa = EXTRA && (x != 0u), xg = false;
#pragma unroll
    for (int b = 31; b >= 0; --b) {
        const unsigned pl = P[31 - b], Mm = A & pl;
        const bool xb = EXTRA && xa && ((x >> b) & 1u);
        const int c1 = wave_sum_dpp(__builtin_popcount(Mm) + (xb ? 1 : 0));
        const bool take = (above + c1) >= DSA_TOPK;
        if (take) { A = Mm; if (EXTRA) xa = xb; }
        else { above += c1; G |= Mm; A &= ~pl; if (EXTRA) { xg = xg || xb; xa = xa && !xb; } }
    }
    const int need = DSA_TOPK - above;
    const int ties = wave_sum_dpp(__builtin_popcount(A) + ((EXTRA && xa) ? 1 : 0));
    unsigned SEL = G | A; xsel = xg || xa;
    if (ties > need) {
        int run = 0; const unsigned long long lt = (1ull << lane) - 1ull;
        SEL = G;
#pragma unroll 1
        for (int i = 0; i < 32; ++i) {
            const bool eq = (A >> (31 - i)) & 1u; const unsigned long long me = __ballot(eq);
            const int pre = run + __builtin_popcountll(me & lt); run += __builtin_popcountll(me);
            if (eq && pre < need) SEL |= (0x80000000u >> i);
        }
        if (EXTRA) { const unsigned long long me = __ballot(xa); const int pre = run + __builtin_popcountll(me & lt); xsel = xg || (xa && pre < need); }
    }
    return SEL;
}
struct DsaP { const bf16 *QB, *KB, *VT, *IQ, *IK; const float* IW; float* SCR; bf16* OD; };
__device__ __forceinline__ void dsa_prompt_item(Frame& F, const DsaP& W, int b, int qb) {
    int tid = F.tid; asm volatile("" : "+v"(tid));
    const int lane = tid & 63, w = __builtin_amdgcn_readfirstlane(tid >> 6), r32 = lane & 31, hh = lane >> 5;
    const int t0 = 32 * qb, m0 = b * TP + t0, nk = t0 + 32, ntile = (nk + 63) >> 6;
    LAS unsigned* maskb = (LAS unsigned*)(F.lds + DL_MASK);
    float* scr = W.SCR + (size_t)F.bid * 32 * 2048;
    WG_SYNC();
    {
        bf16x8 aq[4];
#pragma unroll
        for (int ks = 0; ks < 4; ++ks) aq[ks] = *(const GAS bf16x8*)(W.IQ + (size_t)(m0 + 4 * w + (r32 >> 3)) * 512 + (r32 & 7) * 64 + 16 * ks + 8 * hh);
        float wq[4][4];
#pragma unroll
        for (int g = 0; g < 4; ++g) { const f32x4 t = *(const f32x4*)(W.IW + (size_t)(m0 + 4 * w + g) * 8 + 4 * hh); wq[g][0] = t.x; wq[g][1] = t.y; wq[g][2] = t.z; wq[g][3] = t.w; }
        const int nkt = nk >> 5, nch = (nk + 511) >> 9;
        const bf16* ikb = W.IK + (size_t)(b * TP) * 64 + (size_t)tid * 8;
        LAS unsigned char* ikl = F.lds + ((tid >> 3) * 144 + (tid & 7) * 16);
        v4u pf8[8];
#pragma unroll
        for (int i = 0; i < 8; ++i) pf8[i] = *(const GAS v4u*)(ikb + (size_t)i * 64 * 64);
#pragma unroll 1
        for (int ch = 0; ch < nch; ++ch) {
            WG_SYNC();
#pragma unroll
            for (int i = 0; i < 8; ++i) *(LAS v4u*)(ikl + i * 64 * 144) = pf8[i];
            WG_SYNC();
            if (ch + 1 < nch) {
#pragma unroll
                for (int i = 0; i < 8; ++i) pf8[i] = *(const GAS v4u*)(ikb + (size_t)((ch + 1) * 512 + i * 64) * 64);
            }
            const int t1 = (nkt - 16 * ch) < 16 ? (nkt - 16 * ch) : 16;
#pragma unroll 1
            for (int tp = 0; tp < t1; tp += 2) {
                bf16x8 bk[2][4];
#pragma unroll
                for (int t2 = 0; t2 < 2; ++t2)
#pragma unroll
                    for (int ks = 0; ks < 4; ++ks) bk[t2][ks] = *(const LAS bf16x8*)(F.lds + (32 * (tp + t2) + r32) * 144 + 32 * ks + 16 * hh);
                __builtin_amdgcn_sched_barrier(0);
                f32x16 acc[2] = {{}, {}};
#pragma unroll
                for (int ks = 0; ks < 4; ++ks) { acc[0] = mfma32(aq[ks], bk[0][ks], acc[0]); acc[1] = mfma32(aq[ks], bk[1][ks], acc[1]); }
#pragma unroll
                for (int t2 = 0; t2 < 2; ++t2) {
                    const int kt = 16 * ch + tp + t2;
#pragma unroll
                    for (int g = 0; g < 4; ++g) {
                        float s = wq[g][0] * fmaxf(acc[t2][4 * g], 0.f) + wq[g][1] * fmaxf(acc[t2][4 * g + 1], 0.f) + wq[g][2] * fmaxf(acc[t2][4 * g + 2], 0.f) + wq[g][3] * fmaxf(acc[t2][4 * g + 3], 0.f);
                        s = xh_sum(s);
                        if (hh == (g >> 1) && kt < nkt) scr[(size_t)(4 * w + g) * 2048 + 32 * kt + r32] = s;
                    }
                }
            }
        }
    }
    asm volatile("s_waitcnt vmcnt(0)" ::: "memory");
    unsigned xr[32];
    { const unsigned* srow = (const unsigned*)(scr + (size_t)(4 * w) * 2048);
#pragma unroll
      for (int i = 0; i < 32; ++i) xr[i] = ld_sc1(srow + i * 64 + lane); }
#pragma unroll 1
    for (int g = 0; g < 4; ++g) {
        const int q = 4 * w + g, p = t0 + q;
        unsigned u[32];
#pragma unroll
        for (int i = 0; i < 32; ++i) { const int s = i * 64 + lane; u[i] = (s <= p) ? sortkey(__uint_as_float(xr[i])) : 0u; }
        if (g < 3) { const unsigned* srow = (const unsigned*)(scr + (size_t)(q + 1) * 2048);
#pragma unroll
            for (int i = 0; i < 32; ++i) xr[i] = ld_sc1(srow + i * 64 + lane); }
        unsigned SEL;
        if (p + 1 <= DSA_TOPK) {
            SEL = 0u;
#pragma unroll
            for (int i = 0; i < 32; ++i) SEL |= (u[i] != 0u) ? (0x80000000u >> i) : 0u;
        } else { bool xs_; SEL = topk_bits<false>(u, 0u, xs_, lane); }
#pragma unroll
        for (int i = 0; i < 32; ++i) { const unsigned long long mk = __ballot((SEL >> (31 - i)) & 1u); if (lane == 0) { maskb[(q * 32 + i) * 2] = (unsigned)mk; maskb[(q * 32 + i) * 2 + 1] = (unsigned)(mk >> 32); } }
    }
    const int kvh = w >> 2;
    bf16x8 qf[8];
#pragma unroll
    for (int ks = 0; ks < 8; ++ks) qf[ks] = *(const GAS bf16x8*)(W.QB + (size_t)(m0 + r32) * 1024 + w * 128 + 16 * ks + 8 * hh);
    f32x16 o[4];
#pragma unroll
    for (int d = 0; d < 4; ++d) o[d] = (f32x16){};
    float mrun = -1e30f, lrun = 0.f;
    v4u pre[8];
    const unsigned koff = (unsigned)((tid >> 4) * 256 + (tid & 15) * 8), voff = (unsigned)((tid >> 3) * TP + (tid & 7) * 8);
    const unsigned klds = (unsigned)(DL_K + (tid >> 4) * 272 + (tid & 15) * 16), vlds = (unsigned)(DL_V + (tid >> 3) * 136 + (tid & 7) * 16);
#define DSA_LOAD_TILE(kt_) do { \
        const bf16* kb_ = W.KB + (size_t)(b * TP + 64 * (kt_)) * 256; const bf16* vb_ = W.VT + (size_t)(b * 2) * 128 * TP + 64 * (kt_); \
        _Pragma("unroll") for (int i = 0; i < 4; ++i) { \
            pre[i] = *(const GAS v4u*)(kb_ + ((i & 1) * 32 * 256 + (i >> 1) * 128) + koff); \
            pre[4 + i] = *(const GAS v4u*)(vb_ + (size_t)((i >> 1) * 128 + (i & 1) * 64) * TP + voff); } } while (0)
    DSA_LOAD_TILE(0);
    const LAS bf16* Kl0 = (const LAS bf16*)(F.lds + DL_K) + kvh * 64 * 136;
    const LAS bf16* Vl0 = (const LAS bf16*)(F.lds + DL_V) + kvh * 128 * 68;
#define DSA_STORE_TILE(set_) do { const unsigned so_ = (unsigned)(set_) * DL_SET; \
        _Pragma("unroll") for (int i = 0; i < 4; ++i) { \
            *(LAS v4u*)(F.lds + so_ + klds + ((i >> 1) * 64 + (i & 1) * 32) * 272) = pre[i]; \
            { LAS u32x2v* vd_ = (LAS u32x2v*)(F.lds + so_ + vlds + ((i >> 1) * 128 + (i & 1) * 64) * 136); vd_[0] = (u32x2v){pre[4 + i].x, pre[4 + i].y}; vd_[1] = (u32x2v){pre[4 + i].z, pre[4 + i].w}; } } } while (0)
    WG_SYNC();
    DSA_STORE_TILE(0);
    WG_SYNC();
    if (1 < ntile) DSA_LOAD_TILE(1);
#pragma unroll 1
    for (int kt = 0; kt < ntile; ++kt) {
        const LAS bf16* Kl = Kl0 + (kt & 1) * (DL_SET / 2); const LAS bf16* Vl = Vl0 + (kt & 1) * (DL_SET / 2);
        f32x16 p0 = {}, p1 = {};
#pragma unroll
        for (int kh = 0; kh < 2; ++kh) {
            bf16x8 fr[8];
#pragma unroll
            for (int k4 = 0; k4 < 4; ++k4) { fr[2 * k4] = *(const LAS bf16x8*)(Kl + r32 * 136 + 16 * (4 * kh + k4) + 8 * hh); fr[2 * k4 + 1] = *(const LAS bf16x8*)(Kl + (32 + r32) * 136 + 16 * (4 * kh + k4) + 8 * hh); }
            __builtin_amdgcn_sched_barrier(0);
#pragma unroll
            for (int k4 = 0; k4 < 4; ++k4) { p0 = mfma32(fr[2 * k4], qf[4 * kh + k4], p0); p1 = mfma32(fr[2 * k4 + 1], qf[4 * kh + k4], p1); }
        }
        const unsigned mlo = maskb[(r32 * 32 + kt) * 2] >> (4 * hh), mhi = maskb[(r32 * 32 + kt) * 2 + 1] >> (4 * hh);
        float mx = -INFINITY;
#pragma unroll
        for (int r = 0; r < 16; ++r) { const int pos = (r & 3) + 8 * (r >> 2);
            p0[r] = ((mlo >> pos) & 1u) ? p0[r] : -INFINITY; p1[r] = ((mhi >> pos) & 1u) ? p1[r] : -INFINITY;
            mx = fmaxf(mx, fmaxf(p0[r], p1[r])); }
        mx = xh_max(mx);
        const float mnew = fmaxf(mrun, mx), alpha = __builtin_amdgcn_exp2f(mrun - mnew);
        mrun = mnew;
        float ls = 0.f;
#pragma unroll
        for (int r = 0; r < 16; ++r) { p0[r] = __builtin_amdgcn_exp2f(p0[r] - mnew); p1[r] = __builtin_amdgcn_exp2f(p1[r] - mnew); ls += p0[r] + p1[r]; }
        ls = xh_sum(ls);
        lrun = lrun * alpha + ls;
        if (__builtin_amdgcn_ballot_w64(alpha != 1.0f)) {
#pragma unroll
            for (int d = 0; d < 4; ++d) o[d] = o[d] * alpha;
        }
        bf16x8 pf[4];
        pf[0] = __builtin_bit_cast(bf16x8, (v4u){pk2(p0[0], p0[1]), pk2(p0[2], p0[3]), pk2(p0[4], p0[5]), pk2(p0[6], p0[7])});
        pf[1] = __builtin_bit_cast(bf16x8, (v4u){pk2(p0[8], p0[9]), pk2(p0[10], p0[11]), pk2(p0[12], p0[13]), pk2(p0[14], p0[15])});
        pf[2] = __builtin_bit_cast(bf16x8, (v4u){pk2(p1[0], p1[1]), pk2(p1[2], p1[3]), pk2(p1[4], p1[5]), pk2(p1[6], p1[7])});
        pf[3] = __builtin_bit_cast(bf16x8, (v4u){pk2(p1[8], p1[9]), pk2(p1[10], p1[11]), pk2(p1[12], p1[13]), pk2(p1[14], p1[15])});
#pragma unroll
        for (int dd = 0; dd < 4; ++dd) {
            bf16x8 fr[4];
            const LAS bf16* vr = Vl + (32 * dd + r32) * 68 + 4 * hh;
#pragma unroll
            for (int s = 0; s < 4; ++s) { const u32x2v a = *(const LAS u32x2v*)(vr + 16 * s), c = *(const LAS u32x2v*)(vr + 16 * s + 8); fr[s] = __builtin_bit_cast(bf16x8, (v4u){a.x, a.y, c.x, c.y}); }
            __builtin_amdgcn_sched_barrier(0);
#pragma unroll
            for (int s = 0; s < 4; ++s) o[dd] = mfma32(fr[s], pf[s], o[dd]);
        }
        if (kt + 1 < ntile) DSA_STORE_TILE((kt + 1) & 1);
        WG_SYNC();
        if (kt + 2 < ntile) DSA_LOAD_TILE(kt + 2);
    }
#undef DSA_STORE_TILE
#undef DSA_LOAD_TILE
    const float inv = 1.0f / lrun;
    bf16* od = W.OD + (size_t)(m0 + r32) * 2048 + 1024 + w * 128;
#pragma unroll
    for (int d = 0; d < 4; ++d)
#pragma unroll
        for (int rg = 0; rg < 4; ++rg) gst4bf(od + 32 * d + 8 * rg + 4 * hh, o[d][4 * rg] * inv, o[d][4 * rg + 1] * inv, o[d][4 * rg + 2] * inv, o[d][4 * rg + 3] * inv);
}
struct DsaS { const bf16 *QB, *IQ, *IK; const float* IW; const float *cache_k, *cache_v, *cache_ik; const int* page_table; const float* knew; const float* vnew; bf16* OD; };
constexpr int SL_SC = 0;
constexpr int SL_LIST = 33792;
constexpr int SL_Q = 37888;
constexpr int SL_P = 54272;
constexpr int SL_KT = 87040;
constexpr int SL_SN = 121856;
constexpr int SL_END = 87040;
__device__ __forceinline__ void dsa_sample_item(Frame& F, const DsaS& W, int db) {
    int tid = F.tid; asm volatile("" : "+v"(tid));
    const int lane = tid & 63, w = __builtin_amdgcn_readfirstlane(tid >> 6), r32 = lane & 31, hh = lane >> 5;
    const int m0 = NPR + 4 * db;
    LAS float* sc = (LAS float*)(F.lds + SL_SC);
    LAS unsigned* list = (LAS unsigned*)(F.lds + SL_LIST);
    const int* pt = W.page_table + db * 16;
    WG_SYNC();
    {
        bf16x8 aq[4];
#pragma unroll
        for (int ks = 0; ks < 4; ++ks) aq[ks] = *(const GAS bf16x8*)(W.IQ + (size_t)(m0 + (r32 >> 3)) * 512 + (r32 & 7) * 64 + 16 * ks + 8 * hh);
        float wq[4][4];
#pragma unroll
        for (int g = 0; g < 4; ++g) { const f32x4 t = *(const f32x4*)(W.IW + (size_t)(m0 + g) * 8 + 4 * hh); wq[g][0] = t.x; wq[g][1] = t.y; wq[g][2] = t.z; wq[g][3] = t.w; }
        f32x4 raw[3][8];
        LAS unsigned char* ikt = F.lds + SL_KT + w * 4608;
#define SMP_LOAD(sl_, kt_) do { const float* src_ = W.cache_ik + ((size_t)pt[(32 * (kt_)) >> 7] * 128 + ((32 * (kt_)) & 127) + (lane >> 4)) * 64 + 4 * (lane & 15); \
        _Pragma("unroll") for (int i8 = 0; i8 < 8; ++i8) raw[sl_][i8] = *(const GAS f32x4*)(src_ + (size_t)(4 * i8) * 64); } while (0)
#define SMP_SCORE(kt_) do { f32x16 acc = {}; \
        _Pragma("unroll") for (int ks = 0; ks < 4; ++ks) acc = mfma32(aq[ks], bk[ks], acc); \
        _Pragma("unroll") for (int g = 0; g < 4; ++g) { \
            float v = wq[g][0] * fmaxf(acc[4 * g], 0.f) + wq[g][1] * fmaxf(acc[4 * g + 1], 0.f) + wq[g][2] * fmaxf(acc[4 * g + 2], 0.f) + wq[g][3] * fmaxf(acc[4 * g + 3], 0.f); \
            v = xh_sum(v); \
            if (hh == (g >> 1)) sc[g * 2112 + 32 * (kt_) + r32] = v; } } while (0)
        SMP_LOAD(0, w); SMP_LOAD(1, w + 8); SMP_LOAD(2, w + 16);
#pragma unroll
        for (int i = 0; i < 8; ++i) {
            const int kt = w + 8 * i;
            bf16x8 bk[4];
#pragma unroll
            for (int i8 = 0; i8 < 8; ++i8) *(LAS u32x2v*)(ikt + (4 * i8 + (lane >> 4)) * 144 + 8 * (lane & 15)) = (u32x2v){pk2(raw[i % 3][i8].x, raw[i % 3][i8].y), pk2(raw[i % 3][i8].z, raw[i % 3][i8].w)};
#pragma unroll
            for (int ks = 0; ks < 4; ++ks) bk[ks] = *(const LAS bf16x8*)(ikt + r32 * 144 + 32 * ks + 16 * hh);
            if (i < 5) SMP_LOAD(i % 3, kt + 24);
            SMP_SCORE(kt);
        }
        if (w < 2) {
            const int kt = 64 + w; const int s = 32 * kt + r32;
            bf16x8 bk[4];
#pragma unroll
            for (int ks = 0; ks < 4; ++ks) bk[ks] = (s < 2052) ? *(const GAS bf16x8*)(W.IK + (size_t)(m0 + s - 2048) * 64 + 16 * ks + 8 * hh) : (bf16x8){0, 0, 0, 0, 0, 0, 0, 0};
            SMP_SCORE(kt);
        }
#undef SMP_LOAD
#undef SMP_SCORE
        { const int q = w >> 1, kvh = w & 1; LAS float* qs = (LAS float*)(F.lds + SL_Q) + w * 512;
#pragma unroll
          for (int i = 0; i < 8; ++i) { const int idx = lane + 64 * i; qs[idx] = bf2f(W.QB[(size_t)(m0 + q) * 1024 + kvh * 512 + idx]); } }
    }
    WG_SYNC();
    if (w < 4) {
        const int p = 2048 + w;
        unsigned u[32];
#pragma unroll
        for (int i = 0; i < 32; ++i) u[i] = sortkey(sc[w * 2112 + i * 64 + lane]);
        const unsigned x = (2048 + lane <= p) ? sortkey(sc[w * 2112 + 2048 + lane]) : 0u;
        bool xsel; const unsigned SEL = topk_bits<true>(u, x, xsel, lane);
        int base = 0; const unsigned long long lt = (1ull << lane) - 1ull;
#pragma unroll
        for (int i = 0; i < 32; ++i) {
            const bool sel = (SEL >> (31 - i)) & 1u; const unsigned long long mk = __ballot(sel);
            if (sel) { const int s = i * 64 + lane; list[w * 256 + base + __builtin_popcountll(mk & lt)] = (unsigned)(pt[s >> 7] * 128 + (s & 127)); }
            base += __builtin_popcountll(mk);
        }
        { const unsigned long long mk = __ballot(xsel); if (xsel) list[w * 256 + base + __builtin_popcountll(mk & lt)] = 0x80000000u | (unsigned)lane; }
    }
    WG_SYNC();
    {
        const int q = w >> 1, kvh = w & 1, l15 = lane & 15, g4 = lane >> 4;
        const LAS float* qs = (const LAS float*)(F.lds + SL_Q) + w * 512;
        LAS float* pl = (LAS float*)(F.lds + SL_P) + w * 1024;
        const LAS unsigned* lq = list + q * 256;
        LAS bf16* kt = (LAS bf16*)(F.lds + SL_KT) + w * (16 * 136);
        LAS float* sn = (LAS float*)(F.lds + SL_SN) + w * 32;
        bf16x8 aq[4];
#pragma unroll
        for (int ks = 0; ks < 4; ++ks) aq[ks] = *(const GAS bf16x8*)(W.QB + (size_t)(m0 + q) * 1024 + kvh * 512 + (l15 & 3) * 128 + 32 * ks + 8 * g4);
        f32x4 rg[4][8];
#define G_LD(base_, sl_, b_) do { const v4u e0_ = *(const LAS v4u*)(lq + 16 * (b_) + 8 * hh), e1_ = *(const LAS v4u*)(lq + 16 * (b_) + 8 * hh + 4); \
            const unsigned oo_ = 16u * (unsigned)r32; \
            rg[sl_][0] = *(const GAS f32x4*)((base_) + (((e0_.x & 0x7fffffffu) << 10) + oo_)); rg[sl_][1] = *(const GAS f32x4*)((base_) + (((e0_.y & 0x7fffffffu) << 10) + oo_)); \
            rg[sl_][2] = *(const GAS f32x4*)((base_) + (((e0_.z & 0x7fffffffu) << 10) + oo_)); rg[sl_][3] = *(const GAS f32x4*)((base_) + (((e0_.w & 0x7fffffffu) << 10) + oo_)); \
            rg[sl_][4] = *(const GAS f32x4*)((base_) + (((e1_.x & 0x7fffffffu) << 10) + oo_)); rg[sl_][5] = *(const GAS f32x4*)((base_) + (((e1_.y & 0x7fffffffu) << 10) + oo_)); \
            rg[sl_][6] = *(const GAS f32x4*)((base_) + (((e1_.z & 0x7fffffffu) << 10) + oo_)); rg[sl_][7] = *(const GAS f32x4*)((base_) + (((e1_.w & 0x7fffffffu) << 10) + oo_)); \
            __builtin_amdgcn_sched_barrier(0); } while (0)
        {
            const GAS char* kbase = (const GAS char*)(W.cache_k + kvh * 128);
#define K_USE(sl_, b_) do { _Pragma("unroll") for (int jj = 0; jj < 8; ++jj) *(LAS u32x2v*)(kt + (8 * hh + jj) * 136 + 4 * r32) = (u32x2v){pk2(rg[sl_][jj].x, rg[sl_][jj].y), pk2(rg[sl_][jj].z, rg[sl_][jj].w)}; \
            bf16x8 bk_[4]; _Pragma("unroll") for (int ks = 0; ks < 4; ++ks) bk_[ks] = *(const LAS bf16x8*)(kt + l15 * 136 + 32 * ks + 8 * g4); \
            f32x4 sa_ = (f32x4){0.f, 0.f, 0.f, 0.f}; _Pragma("unroll") for (int ks = 0; ks < 4; ++ks) sa_ = mfma16(aq[ks], bk_[ks], sa_); \
            if (g4 == 0) { pl[16 * (b_) + l15] = sa_.x; pl[256 + 16 * (b_) + l15] = sa_.y; pl[512 + 16 * (b_) + l15] = sa_.z; pl[768 + 16 * (b_) + l15] = sa_.w; } \
            __builtin_amdgcn_sched_barrier(0); } while (0)
            G_LD(kbase, 0, 0); G_LD(kbase, 1, 1); G_LD(kbase, 2, 2);
#pragma unroll 1
            for (int b = 0; b < 16; b += 4) {
                G_LD(kbase, 3, b + 3); K_USE(0, b);
                G_LD(kbase, 0, (b + 4) & 15); K_USE(1, b + 1);
                G_LD(kbase, 1, (b + 5) & 15); K_USE(2, b + 2);
                G_LD(kbase, 2, (b + 6) & 15); K_USE(3, b + 3);
            }
#undef K_USE
        }
        { const int n = lane >> 4; const float* kn = W.knew + (size_t)(4 * db + n) * 256 + kvh * 128 + 8 * l15;
          const f32x4 k0 = *(const GAS f32x4*)kn, k1 = *(const GAS f32x4*)(kn + 4);
          if (lane < 16) sn[16 + lane] = 0.f;
#pragma unroll
          for (int h = 0; h < 4; ++h) { const f32x4 q0 = *(const LAS f32x4*)(qs + h * 128 + 8 * l15), q1 = *(const LAS f32x4*)(qs + h * 128 + 8 * l15 + 4);
              float s = k0.x * q0.x + k0.y * q0.y + k0.z * q0.z + k0.w * q0.w + k1.x * q1.x + k1.y * q1.y + k1.z * q1.z + k1.w * q1.w;
              s = row16_sum(s); if (l15 == 0) sn[h * 4 + n] = s; } }
        { const unsigned ro3 = lq[192 + lane]; const bool fl = (ro3 >> 31) != 0u; const int nn = (int)(ro3 & 3u);
#pragma unroll
          for (int h = 0; h < 4; ++h) {
            const float s0 = pl[h * 256 + lane], s1 = pl[h * 256 + 64 + lane], s2 = pl[h * 256 + 128 + lane]; float s3 = pl[h * 256 + 192 + lane];
            const float sx = sn[h * 4 + nn]; s3 = fl ? sx : s3;
            float mx = fmaxf(fmaxf(s0, s1), fmaxf(s2, s3));
#pragma unroll
            for (int o = 1; o < 64; o <<= 1) mx = fmaxf(mx, __shfl_xor(mx, o));
            const float e0 = __builtin_amdgcn_exp2f(s0 - mx), e1 = __builtin_amdgcn_exp2f(s1 - mx), e2 = __builtin_amdgcn_exp2f(s2 - mx), e3 = __builtin_amdgcn_exp2f(s3 - mx);
            const float inv = 1.0f / wave_sum(e0 + e1 + e2 + e3);
            pl[h * 256 + lane] = e0 * inv; pl[h * 256 + 64 + lane] = e1 * inv; pl[h * 256 + 128 + lane] = e2 * inv; pl[h * 256 + 192 + lane] = fl ? 0.f : e3 * inv;
            if (fl) sn[16 + h * 4 + nn] = e3 * inv;
          } }
        asm volatile("s_waitcnt lgkmcnt(0)" ::: "memory");
        f32x4 o0 = (f32x4){0.f, 0.f, 0.f, 0.f}, o1 = o0, o2 = o0, o3 = o0;
        {
            const GAS char* vbase = (const GAS char*)(W.cache_v + kvh * 128);
#define V_USE(sl_, b_) do { const LAS float* pp_ = pl + 16 * (b_) + 8 * hh; \
            const f32x4 pa0 = *(const LAS f32x4*)pp_, pb0 = *(const LAS f32x4*)(pp_ + 4), pa1 = *(const LAS f32x4*)(pp_ + 256), pb1 = *(const LAS f32x4*)(pp_ + 260); \
            const f32x4 pa2 = *(const LAS f32x4*)(pp_ + 512), pb2 = *(const LAS f32x4*)(pp_ + 516), pa3 = *(const LAS f32x4*)(pp_ + 768), pb3 = *(const LAS f32x4*)(pp_ + 772); \
            _Pragma("unroll") for (int jj = 0; jj < 4; ++jj) { o0 += rg[sl_][jj] * pa0[jj]; o1 += rg[sl_][jj] * pa1[jj]; o2 += rg[sl_][jj] * pa2[jj]; o3 += rg[sl_][jj] * pa3[jj]; } \
            _Pragma("unroll") for (int jj = 0; jj < 4; ++jj) { o0 += rg[sl_][4 + jj] * pb0[jj]; o1 += rg[sl_][4 + jj] * pb1[jj]; o2 += rg[sl_][4 + jj] * pb2[jj]; o3 += rg[sl_][4 + jj] * pb3[jj]; } \
            __builtin_amdgcn_sched_barrier(0); } while (0)
            G_LD(vbase, 0, 0); G_LD(vbase, 1, 1); G_LD(vbase, 2, 2);
#pragma unroll 1
            for (int b = 0; b < 16; b += 4) {
                G_LD(vbase, 3, b + 3); V_USE(0, b);
                G_LD(vbase, 0, (b + 4) & 15); V_USE(1, b + 1);
                G_LD(vbase, 1, (b + 5) & 15); V_USE(2, b + 2);
                G_LD(vbase, 2, (b + 6) & 15); V_USE(3, b + 3);
            }
#undef V_USE
#undef G_LD
#pragma unroll
            for (int t = 0; t < 2; ++t) { const int n = 2 * hh + t; const f32x4 vn = *(const GAS f32x4*)(W.vnew + (size_t)(4 * db + n) * 256 + kvh * 128 + 4 * r32);
                o0 += vn * sn[16 + n]; o1 += vn * sn[16 + 4 + n]; o2 += vn * sn[16 + 8 + n]; o3 += vn * sn[16 + 12 + n]; }
        }
#define XH(v_) do { v_.x = xh_sum(v_.x); v_.y = xh_sum(v_.y); v_.z = xh_sum(v_.z); v_.w = xh_sum(v_.w); } while (0)
        XH(o0); XH(o1); XH(o2); XH(o3);
#undef XH
        bf16* od = W.OD + (size_t)(m0 + q) * 2048 + 1024 + kvh * 512 + 4 * r32;
        if (hh == 0) { gst4bf(od, o0.x, o0.y, o0.z, o0.w); gst4bf(od + 128, o1.x, o1.y, o1.z, o1.w); }
        else { gst4bf(od + 256, o2.x, o2.y, o2.z, o2.w); gst4bf(od + 384, o3.x, o3.y, o3.z, o3.w); }
    }
}
#ifndef MK_N_LAUNCHES
#define MK_N_LAUNCHES 1
#endif
constexpr int N_PHASES = 13;
__global__ void __launch_bounds__(NWAVES * 64, 2) mk_fwd(Args args) {
    extern __shared__ __attribute__((aligned(16))) unsigned char lds[];
    Frame F;
    F.lds = (LAS unsigned char*)lds;
    F.tid = threadIdx.x; F.lane = F.tid & 63; F.wave = __builtin_amdgcn_readfirstlane(F.tid >> 6);
    F.G = gridDim.x; F.bid = blockIdx.x;
    unsigned char* ws = args.ws;
    F.ctl = (gu32*)(ws + WS_CTL);
    volatile LAS unsigned* MISC = (volatile LAS unsigned*)(F.lds + MISC_OFF);
    for (int u = F.tid; u < (LDS_BYTES - LDSCTL_OFF) / 4; u += NWAVES * 64) ((LAS unsigned*)(F.lds + LDSCTL_OFF))[u] = 0u;
    __syncthreads();
    XcdBarrier bar; bar.bar = (unsigned*)(F.ctl + CW_BAR); bar.x = 0; bar.st = nullptr;
    if (MK_N_LAUNCHES == 1) bar = xcd_barrier_post((unsigned*)(F.ctl + CW_BAR), MISC + 8);
    const int lo = args.ph_lo, hi = args.ph_hi;
#if defined(MK_STAMP)
    if (F.bid == 0 && F.tid == 0) ((volatile LAS unsigned long long*)(F.lds + LDSCTL_OFF + 512))[0] = __builtin_amdgcn_s_memrealtime();
#endif
#define IN(k) (lo <= (k) && (k) < hi)
#define PHASE_BEGIN() do { int t_ = F.tid; asm volatile("" : "+v"(t_)); F.tid = t_; F.lane = t_ & 63; } while (0)
#if defined(MK_STAMP)
#define SEAM(k) do { if (IN(k) && IN((k) + 1)) xcd_barrier(bar); if (F.bid == 0 && F.tid == 0) ((volatile LAS unsigned long long*)(F.lds + LDSCTL_OFF + 512))[(k) + 1] = __builtin_amdgcn_s_memrealtime(); } while (0)
#else
#define SEAM(k) do { if (IN(k) && IN((k) + 1)) xcd_barrier(bar); } while (0)
#endif
    const float* x_prompt = args.in[0]; const float* x_sample = args.in[1]; const float* c_prompt = args.in[2]; const float* c_sample = args.in[3];
    const float* cache_k = args.in[4]; const float* cache_v = args.in[5]; const float* cache_ik = args.in[6]; const int* page_table = (const int*)args.in[7];
    const float* state_gdn = args.in[8]; const float* state_gconv = args.in[9]; const float* state_fconv = args.in[10];
    const float* w_ada = args.in[11]; const float* b_ada = args.in[12]; const float* g_norm1 = args.in[13]; const float* w_in = args.in[14];
    const float* w_gconv = args.in[15]; const float* a_log = args.in[16]; const float* dt_bias = args.in[17]; const float* g_gnorm = args.in[18];
    const float* w_gout = args.in[19]; const float* w_dout = args.in[20]; const float* w_o = args.in[21]; const float* g_norm2 = args.in[22];
    const float* w_up = args.in[23]; const float* w_fconv = args.in[24]; const float* b_fconv = args.in[25]; const float* w_down = args.in[26]; const float* g_final = args.in[27];
    float* out = args.out;
    f32x2v* ROPE = (f32x2v*)(ws + WS_ROPE); float* ADA = (float*)(ws + WS_ADA);
    bf16* WIN = (bf16*)(ws + WS_WIN); bf16* WG = (bf16*)(ws + WS_WG); bf16* WD = (bf16*)(ws + WS_WD); bf16* WO = (bf16*)(ws + WS_WO);
    bf16* WUP = (bf16*)(ws + WS_WUP); bf16* WDN = (bf16*)(ws + WS_WDN);
    bf16* H = (bf16*)(ws + WS_H); bf16* Y1 = (bf16*)(ws + WS_Y1);
    bf16* QB = (bf16*)(ws + WS_QB); bf16* KB = (bf16*)(ws + WS_KB); bf16* VT = (bf16*)(ws + WS_VT); bf16* IQ = (bf16*)(ws + WS_IQ); bf16* IK = (bf16*)(ws + WS_IK);
    float* IW = (float*)(ws + WS_IW);
    bf16* OG = (bf16*)(ws + WS_OG); bf16* OD = (bf16*)(ws + WS_OD); bf16* MIX = (bf16*)(ws + WS_MIX); bf16* X1 = (bf16*)(ws + WS_X1);
    bf16* U = (bf16*)(ws + WS_U); bf16* ACT = (bf16*)(ws + WS_ACT);
#if defined(MK_DIAG)
    bf16* H2 = (bf16*)(ws + (size_t)1000 * MiB); bf16* X2 = (bf16*)(ws + (size_t)1040 * MiB);
#else
    bf16* H2 = H; bf16* X2 = (bf16*)(ws + WS_Y1);
#endif
    const int gw = F.bid * NWAVES + F.wave, NGW = F.G * NWAVES;
    (void)cache_k; (void)cache_v; (void)cache_ik; (void)page_table; (void)state_gdn; (void)state_gconv; (void)w_gconv; (void)a_log; (void)dt_bias; (void)g_gnorm;
    (void)QB; (void)KB; (void)VT; (void)IQ; (void)IK; (void)IW;

    if (IN(0)) {
        PHASE_BEGIN();
        SUB0(); p0_silu(F, c_prompt, c_sample, (bf16*)(ws + WS_ABF), (unsigned*)(F.ctl + CW_ABF));
        p0_rope(F, args, ROPE);
        transpose_all(F, w_in, DM, 10328, NIN, WIN, MapIn()); SUB(1);
        p0_ada(F, (const bf16*)(ws + WS_ABF), (unsigned*)(F.ctl + CW_ABF), (unsigned*)(F.ctl + CW_BAR), w_ada, b_ada, ADA); SUB(0);
    }
    SEAM(0);
    if (IN(1)) {
        PHASE_BEGIN();
        SUB0();
        norm_mod_pass<false>(F, [&](int m) { return (const void*)(m < NPR ? x_prompt + (size_t)m * DM : x_sample + (size_t)(m - NPR) * DM); }, g_norm1, ADA, 0, 2048, H);
        SUB(2);
    }
    SEAM(1);
#define WDN_DRAIN(maxp_) do { volatile LAS unsigned* qs_ = (volatile LAS unsigned*)(F.lds + LDSCTL_OFF); LAS float* scr_ = (LAS float*)(F.lds + RING_OFF + F.wave * 16640); \
        for (int np_ = 0; np_ < (maxp_); ++np_) { WG_SYNC(); if (F.tid == 0) qs_[0] = __hip_atomic_fetch_add(F.ctl + CW_QUEUE + 448, 1u, RLX_AGENT); WG_SYNC(); \
            const int it_ = 8 * (int)qs_[0] + F.wave; if (it_ - F.wave >= 2816) break; \
            transpose_item(w_down, FF, DM, WDN, scr_, it_ / 32, it_ % 32, F.lane, MapId()); } } while (0)
    if (IN(2)) {
        PHASE_BEGIN();
        pg8::Gemm g{H, WIN, NTOK, NIN - P2_DEFER, DM}; pg8::StaticOrder S; S.init(NTOK, NIN - P2_DEFER, F.G, F.bid);
        pg8::EpiBf16<0> E{Y1, NIN, nullptr, 0, 0, 1.f};
        GS_ON(1);
        pg8::gemm_phase<pg8::EpiBf16<0>, pg8::StaticOrder, true, true>(F.lds + RING_OFF, g, S, E);
        GS_OFF(1);
        if ((long)(NTOK / 256) * ((NIN - P2_DEFER) / 256) / F.G * F.G + F.bid >= (long)(NTOK / 256) * ((NIN - P2_DEFER) / 256)) WDN_DRAIN(7);
    }
    SEAM(2);
    if (IN(3)) {
        PHASE_BEGIN();
        P3Bufs P{Y1, ROPE, QB, KB, IQ, IK, IW, out};
        SUBL0(); for (int m = gw; m < NTOK; m += NGW) p3_rot_row(P, m, F.lane); SUBL(4);
        p3_vt(F, Y1, VT); SUBL(5);
        { GdnW Wp{Y1, w_gconv, a_log, dt_bias, ws + WS_GCH, (float*)(ws + WS_GE)};
          GdnS Wsm{Y1, w_gconv, a_log, dt_bias, g_gnorm, state_gdn, state_gconv, OG, out};
          if (F.bid & 1) { GdnSPre sp_; gdn_sample_load(Wsm, F.bid, F.tid, sp_); for (int it = F.bid; it < 1024; it += F.G) gdn_sample_item(F, Wsm, it, it + F.G, sp_); }
          { v4u xr_[11]; f32x4 wg_[8]; if (F.bid < 1024) gdn_prep_load(Wp, F.bid, F.wave, F.lane, xr_, wg_);
            for (int ci = F.bid; ci < 1024; ci += F.G) gdn_chunk_prep(F, Wp, ci, ci + F.G, xr_, wg_); }
          if (!(F.bid & 1)) { GdnSPre sp_; gdn_sample_load(Wsm, F.bid, F.tid, sp_); for (int it = F.bid; it < 1024; it += F.G) gdn_sample_item(F, Wsm, it, it + F.G, sp_); } }
    }
    SEAM(3);
    if (IN(4)) {
        PHASE_BEGIN();
        { GdnP Wq{ws + WS_GCH, (const float*)(ws + WS_GE), (bf16*)(ws + WS_SN), out};
          if (F.bid < 32) gdn_scan_item(F, Wq, F.bid); }
        { volatile LAS unsigned* qslot = (volatile LAS unsigned*)(F.lds + LDSCTL_OFF);
          constexpr int QSPLIT = 120;
          if (F.bid >= 32) for (;;) {
              WG_SYNC();
              if (F.tid == 0) qslot[0] = __hip_atomic_fetch_add(F.ctl + CW_QUEUE, 1u, RLX_AGENT);
              WG_SYNC();
              const int item = (int)qslot[0];
              if (item >= 384) break;
              unsigned wlo = (unsigned)(size_t)ws, whi = (unsigned)((size_t)ws >> 32);
              asm volatile("" : "+v"(wlo), "+v"(whi));
              unsigned char* wl = (unsigned char*)(((size_t)(unsigned)__builtin_amdgcn_readfirstlane(whi) << 32) | (unsigned)__builtin_amdgcn_readfirstlane(wlo));
              if (item >= QSPLIT && item < QSPLIT + 128) {
                  DsaS Wsd{(const bf16*)(wl + WS_QB), (const bf16*)(wl + WS_IQ), (const bf16*)(wl + WS_IK), (const float*)(wl + WS_IW), cache_k, cache_v, cache_ik, page_table, out + O_KS, out + O_VS, (bf16*)(wl + WS_OG)};
                  dsa_sample_item(F, Wsd, item - QSPLIT);
              } else {
                  DsaP Wd{(const bf16*)(wl + WS_QB), (const bf16*)(wl + WS_KB), (const bf16*)(wl + WS_VT), (const bf16*)(wl + WS_IQ), (const bf16*)(wl + WS_IK), (const float*)(wl + WS_IW), (float*)(wl + WS_SCR), (bf16*)(wl + WS_OG)};
                  const int k = item < QSPLIT ? item : item - 128; dsa_prompt_item(F, Wd, k & 3, 63 - (k >> 2));
              }
          } }
        { volatile LAS unsigned* qslot = (volatile LAS unsigned*)(F.lds + LDSCTL_OFF);
          LAS float* scr = (LAS float*)(F.lds + RING_OFF + F.wave * 16640);
          constexpr int P2_UNITS = (NTOK / 256) * (P2_DEFER / 256);
          for (;;) {
              WG_SYNC();
              if (F.tid == 0) qslot[0] = __hip_atomic_fetch_add(F.ctl + CW_QUEUE + 192, 1u, RLX_AGENT);
              WG_SYNC();
              const int pop = (int)qslot[0];
              if (pop < P2_UNITS) {
                  pg8::Gemm g{H, WIN + (size_t)(NIN - P2_DEFER) * DM, NTOK, P2_DEFER, DM}; pg8::OneUnit S1{pop % (NTOK / 256), pop / (NTOK / 256)};
                  pg8::EpiBf16<0> E{Y1 + (NIN - P2_DEFER), NIN, nullptr, 0, 0, 1.f};
                  pg8::gemm_phase<pg8::EpiBf16<0>, pg8::OneUnit, true, true>(F.lds + RING_OFF, g, S1, E);
                  continue;
              }
              int it = 8 * (pop - P2_UNITS) + F.wave;
              if (it >= 7680) break;
              if (it < 512) transpose_item(w_gout, DM, DM, WG, scr, it / 32, it % 32, F.lane, MapId());
              else if ((it -= 512) < 512) transpose_item(w_dout, DM, DM, WG + 1024, scr, it / 32, it % 32, F.lane, MapId());
              else if ((it -= 512) < 1024) transpose_item(w_o, DM, DM, WO, scr, it / 32, it % 32, F.lane, MapId());
              else { it -= 1024; transpose_item(w_up, DM, FF2, WUP, scr, it / 176, it % 176, F.lane, MapUp()); }
          } }
    }
    SEAM(4);
#define P6_SMALL() do { const bf16* gq = Y1 + (size_t)NPR * NIN; bf16* mx = MIX + (size_t)NPR * DM; \
          small_gemm<true>(F, OG + (size_t)NPR * DM, DM, WG, DM, [&](int row, int col, f32x4 a0, f32x4 a1, f32x4 b0, f32x4 b1) { \
              const v4u g1 = *(const GAS v4u*)(gq + (size_t)row * NIN + C_G1 + col), g2 = *(const GAS v4u*)(gq + (size_t)row * NIN + C_G2 + col); \
              v4u o; \
              o.x = pk2(sigm_f(bflo(g1.x)) * a0.x + sigm_f(bflo(g2.x)) * b0.x, sigm_f(bfhi(g1.x)) * a0.y + sigm_f(bfhi(g2.x)) * b0.y); \
              o.y = pk2(sigm_f(bflo(g1.y)) * a0.z + sigm_f(bflo(g2.y)) * b0.z, sigm_f(bfhi(g1.y)) * a0.w + sigm_f(bfhi(g2.y)) * b0.w); \
              o.z = pk2(sigm_f(bflo(g1.z)) * a1.x + sigm_f(bflo(g2.z)) * b1.x, sigm_f(bfhi(g1.z)) * a1.y + sigm_f(bfhi(g2.z)) * b1.y); \
              o.w = pk2(sigm_f(bflo(g1.w)) * a1.z + sigm_f(bflo(g2.w)) * b1.z, sigm_f(bfhi(g1.w)) * a1.w + sigm_f(bfhi(g2.w)) * b1.w); \
              *(GAS v4u*)(mx + (size_t)row * DM + col) = o; }); } while (0)
#define P7_SMALL() do { small_gemm(F, MIX + (size_t)NPR * DM, DM, WO, DM, [&](int row, int col, f32x4 s0, f32x4 s1) { \
            const float* xs = x_sample + (size_t)row * DM + col; const float* ga = ADA + (size_t)(4 + (row >> 2)) * ADAW + 4096 + col; \
            const f32x4 y0 = *(const GAS f32x4*)xs + *(const GAS f32x4*)ga * s0, y1 = *(const GAS f32x4*)(xs + 4) + *(const GAS f32x4*)(ga + 4) * s1; \
            *(GAS v4u*)(X1 + (size_t)(NPR + row) * DM + col) = (v4u){pk2(y0.x, y0.y), pk2(y0.z, y0.w), pk2(y1.x, y1.y), pk2(y1.z, y1.w)}; }); } while (0)
    if (IN(5)) {
        PHASE_BEGIN();
        GdnO Wo_{Y1, g_gnorm, ws + WS_GCH, (const bf16*)(ws + WS_SN), OG, ws + (size_t)1120 * MiB};
        if (F.bid & 1) P6_SMALL();
        { GdnOPre Pp; if (F.bid < 1024) gdn_out_load(Wo_, F.bid, F.tid, Pp);
          for (int ci = F.bid; ci < 1024; ci += F.G) gdn_out_item(F, Wo_, ci, ci + F.G, Pp); }
        if (!(F.bid & 1)) P6_SMALL();
    }
    SEAM(5);
    if (IN(6)) {
        PHASE_BEGIN();
#define P6_BIG() do { pg8::Gemm g{OG, WG, NPR, DM, DM}; pg8::StaticOrder S; S.init(NPR, DM, F.G, F.bid);        \
          pg8::EpiGate2 E{MIX, DM, Y1 + C_G1, Y1 + C_G2, NIN}; \
          pg8::gemm_phase<pg8::EpiGate2, pg8::StaticOrder, true, true>(F.lds + RING_OFF, g, S, E); } while (0)
        if (F.bid & 1) { P7_SMALL(); P6_BIG(); } else { P6_BIG(); P7_SMALL(); }
#undef P6_BIG
    }
    SEAM(6);
    if (IN(7)) {
        PHASE_BEGIN();
#define P7_BIG() do { pg8::Gemm g{MIX, WO, NPR, DM, DM}; pg8::StaticOrder S; S.init(NPR, DM, F.G, F.bid); \
          pg8::EpiResid2<false, true> E{x_prompt, X1, ADA + 4096, ADAW}; \
          pg8::gemm_phase<pg8::EpiResid2<false, true>, pg8::StaticOrder, true, true>(F.lds + RING_OFF, g, S, E); } while (0)
        P7_BIG();
#undef P7_BIG
    }
    SEAM(7);
    if (IN(8)) {
        PHASE_BEGIN();
        norm_mod_pass<true>(F, [&](int m) { return (const void*)(X1 + (size_t)m * DM); }, g_norm2, ADA, 6144, 8192, H2);
    }
    SEAM(8);
    if (IN(9)) {
        PHASE_BEGIN();
        pg8::Gemm g{H2, WUP, NTOK, FF2, DM}; pg8::StaticOrder S; S.init(NTOK, FF2, F.G, F.bid);
        pg8::EpiConv E{ACT, U, (bf16*)(ws + WS_HB), w_fconv, b_fconv};
        GS_ON(2);
        pg8::gemm_phase<pg8::EpiConv, pg8::StaticOrder, true, true>(F.lds + RING_OFF, g, S, E);
        if ((long)(NTOK / 256) * (FF2 / 256) / F.G * F.G + F.bid >= (long)(NTOK / 256) * (FF2 / 256)) WDN_DRAIN(7);
        GS_OFF(2);
    }
    SEAM(9);
    if (IN(10)) { PHASE_BEGIN(); WDN_DRAIN(1 << 20); p9_conv(F, U, state_fconv, w_fconv, b_fconv, ACT, out); p10_fixup(F, (const bf16*)(ws + WS_HB), w_fconv, b_fconv, ACT, out); }
    SEAM(10);
    if (IN(11)) {
        PHASE_BEGIN();
#define P11_BIG() do { pg8::Gemm g{ACT, WDN, NPR, DM, FF}; pg8::StaticOrder S; S.init(NPR, DM, F.G, F.bid); \
          pg8::EpiResid2<true, true> E{X1, X2, ADA + 10240, ADAW}; \
          pg8::gemm_phase<pg8::EpiResid2<true, true>, pg8::StaticOrder, true, true>(F.lds + RING_OFF, g, S, E); } while (0)
#define P11_SMALL() do { small_gemm(F, ACT + (size_t)NPR * FF, FF, WDN, FF, [&](int row, int col, f32x4 s0, f32x4 s1) { \
            const size_t o_ = (size_t)(NPR + row) * DM + col; const float* ga = ADA + (size_t)(4 + (row >> 2)) * ADAW + 10240 + col; \
            const v4u xb = *(const GAS v4u*)(X1 + o_); \
            const f32x4 y0 = (f32x4){bflo(xb.x), bfhi(xb.x), bflo(xb.y), bfhi(xb.y)} + *(const GAS f32x4*)ga * s0, y1 = (f32x4){bflo(xb.z), bfhi(xb.z), bflo(xb.w), bfhi(xb.w)} + *(const GAS f32x4*)(ga + 4) * s1; \
            *(GAS v4u*)(X2 + o_) = (v4u){pk2(y0.x, y0.y), pk2(y0.z, y0.w), pk2(y1.x, y1.y), pk2(y1.z, y1.w)}; }); } while (0)
        if (F.bid & 1) { P11_SMALL(); P11_BIG(); } else { P11_BIG(); P11_SMALL(); }
#undef P11_BIG
#undef P11_SMALL
    }
    SEAM(11);
    if (IN(12)) {
        PHASE_BEGIN();
        for (int m = gw; m < NTOK; m += NGW) final_norm_row_bf(X2 + (size_t)m * DM, g_final, out + O_Y + (size_t)m * DM, F.lane);
    }
#undef IN
#undef SEAM
}

extern "C" void kernel_launch(void* const* d_in, const int* in_sizes, int n_in, void* d_out, int out_size, void* d_ws, size_t ws_size, hipStream_t stream) {
    static int grid = 0;
    if (grid == 0) {
        if (n_in != 28 || (size_t)out_size != O_END || ws_size < WS_END) { fprintf(stderr, "kernel_launch: unexpected sizes n_in %d out %d ws %zu (need %zu)\n", n_in, out_size, ws_size, (size_t)WS_END); grid = -1; return; }
        int dev = 0, cus = 0, per_cu = 0;
        if (hipGetDevice(&dev) != hipSuccess || hipDeviceGetAttribute(&cus, hipDeviceAttributeMultiprocessorCount, dev) != hipSuccess) { grid = -1; return; }
        if (hipFuncSetAttribute((const void*)mk_fwd, hipFuncAttributeMaxDynamicSharedMemorySize, LDS_BYTES) != hipSuccess) { fprintf(stderr, "kernel_launch: hipFuncSetAttribute failed\n"); grid = -1; return; }
        if (hipOccupancyMaxActiveBlocksPerMultiprocessor(&per_cu, (const void*)mk_fwd, NWAVES * 64, LDS_BYTES) != hipSuccess || per_cu < 1)
            fprintf(stderr, "kernel_launch: occupancy query reports %d\n", per_cu);
        (void)hipGetLastError();
        grid = cus;
    }
    if (grid < 0) return;
    if (hipMemsetAsync((char*)d_ws + WS_CTL, 0, CTL_ZERO_BYTES, stream) != hipSuccess) return;
    Args a{};
    for (int i = 0; i < 28; ++i) a.in[i] = (const float*)d_in[i];
    a.out = (float*)d_out; a.ws = (unsigned char*)d_ws;
    for (int i = 0; i < 16; ++i) a.invf[i] = pow(500000.0, -(double)i / 16.0);
    for (int i = 0; i < 8; ++i) a.invf[16 + i] = pow(500000.0, -(double)i / 8.0);
    if (MK_N_LAUNCHES == 1) {
        a.ph_lo = 0; a.ph_hi = N_PHASES;
        hipLaunchKernelGGL(mk_fwd, dim3(grid), dim3(NWAVES * 64), LDS_BYTES, stream, a);
    } else {
        for (int p = 0; p < N_PHASES; ++p) { a.ph_lo = p; a.ph_hi = p + 1; hipLaunchKernelGGL(mk_fwd, dim3(grid), dim3(NWAVES * 64), LDS_BYTES, stream, a); }
    }
}
```
